# Optimizing an MI355X kernel written in HIP

```python
import math
import jax, jax.numpy as jnp
from jax import lax
import numpy as np

D_MODEL = 2048
BATCH = 4
SEQ = 2048
DEPTH = 2

GRID_W = 64
CTX_LEN = 256
MIX_WIDTH = D_MODEL
RET_WIDTH = MIX_WIDTH // 2
S5_WIDTH = MIX_WIDTH - RET_WIDTH
RET_HEADS = 8
RET_HEAD_DIM = RET_WIDTH // RET_HEADS
RET_CHUNK = 128
S5_GROUP = 16
S5_GROUPS = S5_WIDTH // S5_GROUP
S5_STATE = 64
IN_WIDTH = 4 * RET_WIDTH + S5_WIDTH
N_EXPERT_GROUPS = 4
EXPERTS_PER_GROUP = 8
N_EXPERTS = N_EXPERT_GROUPS * EXPERTS_PER_GROUP
FINE_TOP_K = 2
EXPERT_FF = D_MODEL // 4
MOE_BLOCK = 128
ROPE_BASE = 10000.0
NORM_EPS = 1e-6
GN_EPS = 1e-5
N_MOD = 6

kernel_name = 'hymba_retnet_s5_hmoe_prefix_dit'


def rms_norm(x, g):
    xf = x.astype(jnp.float32)
    y = xf * lax.rsqrt(jnp.mean(xf * xf, axis=-1, keepdims=True) + NORM_EPS)
    return (y * g.astype(jnp.float32)).astype(x.dtype)


def adaln(cond, w, b):
    return jax.nn.silu(cond) @ w + b


def modulate(h, shift, scale):
    return h * (1.0 + scale) + shift


def rope_2d(n_tok):
    rows = n_tok // GRID_W
    row = jnp.repeat(jnp.arange(rows, dtype=jnp.float32), GRID_W)
    col = jnp.tile(jnp.arange(GRID_W, dtype=jnp.float32), rows)
    n_freq = RET_HEAD_DIM // 4
    inv = ROPE_BASE ** (-jnp.arange(n_freq, dtype=jnp.float32) / n_freq)
    ang = jnp.concatenate([row[:, None] * inv, col[:, None] * inv], axis=-1)
    return jnp.cos(ang), jnp.sin(ang)


def apply_rope(t, cos, sin):
    tp = t.reshape(*t.shape[:-1], -1, 2)
    t0, t1 = tp[..., 0], tp[..., 1]
    return jnp.stack([t0 * cos - t1 * sin, t0 * sin + t1 * cos], axis=-1).reshape(t.shape)


def split_heads(t):
    b, l, _ = t.shape
    return t.astype(jnp.float32).reshape(b, l, RET_HEADS, -1).transpose(0, 2, 1, 3)


def head_group_norm(y):
    mu = jnp.mean(y, axis=-1, keepdims=True)
    var = jnp.mean(jnp.square(y - mu), axis=-1, keepdims=True)
    y = (y - mu) * lax.rsqrt(var + GN_EPS)
    b, h, l, dv = y.shape
    return y.transpose(0, 2, 1, 3).reshape(b, l, h * dv)


def retention_direction(q, k, v, log_g, state0, inclusive, need_out):
    b, h, l, dk = q.shape
    dv = v.shape[-1]
    n = l // RET_CHUNK
    kc = k.reshape(b, h, n, RET_CHUNK, dk)
    vc = v.reshape(b, h, n, RET_CHUNK, dv)
    pos = jnp.arange(RET_CHUNK, dtype=jnp.float32)
    k_w = jnp.exp(log_g[:, None] * (RET_CHUNK - 1.0 - pos)[None])
    chunk_kv = jnp.einsum('bhncd,bhnce->nbhde', kc * k_w[None, :, None, :, None], vc)
    chunk_decay = jnp.exp(log_g * RET_CHUNK)[None, :, None, None]

    def step(s, kv):
        return chunk_decay * s + kv, s

    final, prev = lax.scan(step, state0, chunk_kv)
    if not need_out:
        return None, final
    qc = q.reshape(b, h, n, RET_CHUNK, dk)
    diff = pos[:, None] - pos[None, :]
    mask = (diff >= 0) if inclusive else (diff > 0)
    decay = jnp.where(mask[None], jnp.exp(log_g[:, None, None] * jnp.where(mask, diff, 0.0)[None]), 0.0)
    scores = jnp.einsum('bhnid,bhnjd->bhnij', qc, kc) * decay[None, :, None]
    inner = jnp.einsum('bhnij,bhnje->bhnie', scores, vc)
    q_w = jnp.exp(log_g[:, None] * (pos + 1.0)[None])
    cross = jnp.einsum('bhnid,nbhde->bhnie', qc * q_w[None, :, None, :, None], prev)
    return (inner + cross).reshape(b, h, l, dv), final


def retention_mixer(q_c, k_c, v_c, q_l, k_l, v_l, decay_param, need_ctx_out):
    log_g = -jnp.exp(decay_param.astype(jnp.float32))
    b, h, _, dk = q_c.shape
    dv = v_c.shape[-1]
    zero = jnp.zeros((b, h, dk, dv), jnp.float32)
    rev = lambda t: jnp.flip(t, axis=2)
    ctx_f, s_f = retention_direction(q_c, k_c, v_c, log_g[0], zero, True, need_ctx_out)
    lat_f, _ = retention_direction(q_l, k_l, v_l, log_g[0], s_f, True, True)
    ctx_b, s_b = retention_direction(rev(q_c), rev(k_c), rev(v_c), log_g[1], zero, False, need_ctx_out)
    lat_b, _ = retention_direction(rev(q_l), rev(k_l), rev(v_l), log_g[1], s_b, False, True)
    lat = head_group_norm(lat_f + rev(lat_b))
    ctx_o = head_group_norm(ctx_f + rev(ctx_b)) if need_ctx_out else None
    return ctx_o, lat


def s5_discretize(a_re, a_im, log_step, b_re, b_im):
    dt = jnp.exp(log_step)[:, None]
    mag = jnp.exp(a_re * dt)
    ang = a_im * dt
    abar_re = mag * jnp.cos(ang)
    abar_im = mag * jnp.sin(ang)
    den = a_re * a_re + a_im * a_im
    nr = abar_re - 1.0
    fr = (nr * a_re + abar_im * a_im) / den
    fi = (abar_im * a_re - nr * a_im) / den
    bbar_re = fr[..., None] * b_re - fi[..., None] * b_im
    bbar_im = fr[..., None] * b_im + fi[..., None] * b_re
    return abar_re, abar_im, bbar_re, bbar_im


def complex_linear_combine(left, right):
    a1r, a1i, b1r, b1i = left
    a2r, a2i, b2r, b2i = right
    return (a1r * a2r - a1i * a2i,
            a1r * a2i + a1i * a2r,
            a2r * b1r - a2i * b1i + b2r,
            a2r * b1i + a2i * b1r + b2i)


def s5_direction(u, disc, c_re, c_im, h0, reverse, need_out):
    abar_re, abar_im, bbar_re, bbar_im = disc
    l = u.shape[0]
    bu_re = jnp.einsum('lbgc,gpc->lbgp', u, bbar_re)
    bu_im = jnp.einsum('lbgc,gpc->lbgp', u, bbar_im)
    shape = (l, 1) + abar_re.shape
    a_re = jnp.broadcast_to(abar_re, shape)
    a_im = jnp.broadcast_to(abar_im, shape)
    acum_re, acum_im, h_re, h_im = lax.associative_scan(
        complex_linear_combine, (a_re, a_im, bu_re, bu_im), reverse=reverse, axis=0)
    if h0 is not None:
        h0_re, h0_im = h0
        h_re, h_im = (h_re + acum_re * h0_re - acum_im * h0_im,
                      h_im + acum_re * h0_im + acum_im * h0_re)
    end = 0 if reverse else l - 1
    final = (h_re[end], h_im[end])
    if not need_out:
        return None, final
    y = jnp.einsum('lbgp,gcp->lbgc', h_re, c_re) - jnp.einsum('lbgp,gcp->lbgc', h_im, c_im)
    return y, final


def s5_mixer(u_ctx, u_lat, a_re, a_im, log_step, b_re, b_im, c_re, c_im, d_skip, glu_w, glu_b, need_ctx_out):
    f32 = jnp.float32

    def to_scan(u):
        b, l, _ = u.shape
        return u.astype(f32).reshape(b, l, S5_GROUPS, S5_GROUP).transpose(1, 0, 2, 3)

    uc, ul = to_scan(u_ctx), to_scan(u_lat)
    d = d_skip.astype(f32)
    y_lat = d * ul
    y_ctx = d * uc if need_ctx_out else None
    for direction, reverse in ((0, False), (1, True)):
        disc = s5_discretize(a_re[direction].astype(f32), a_im[direction].astype(f32),
                             log_step[direction].astype(f32), b_re[direction].astype(f32),
                             b_im[direction].astype(f32))
        cr, ci = c_re[direction].astype(f32), c_im[direction].astype(f32)
        yc, h_end = s5_direction(uc, disc, cr, ci, None, reverse, need_ctx_out)
        yl, _ = s5_direction(ul, disc, cr, ci, h_end, reverse, True)
        y_lat = y_lat + yl
        if need_ctx_out:
            y_ctx = y_ctx + yc

    def glu_out(y):
        l, b = y.shape[0], y.shape[1]
        z = jax.nn.gelu(y.transpose(1, 0, 2, 3).reshape(b, l, S5_WIDTH))
        return z * jax.nn.sigmoid(z @ glu_w + glu_b)

    return (glu_out(y_ctx) if need_ctx_out else None), glu_out(y_lat)


def hierarchical_moe(h, grp_w, grp_b, exp_w, exp_b, w_gate, w_up, w_down):
    n, d = h.shape
    f32 = jnp.float32
    hf = h.astype(f32)
    grp_logits = hf @ grp_w.astype(f32) + grp_b.astype(f32)
    grp_prob = jax.nn.softmax(grp_logits, axis=-1)
    grp = jnp.argmax(grp_logits, axis=-1).astype(jnp.int32)
    grp_gate = jnp.take_along_axis(grp_prob, grp[:, None], axis=-1)
    exp_logits = (hf @ exp_w.astype(f32) + exp_b.astype(f32)).reshape(n, N_EXPERT_GROUPS, EXPERTS_PER_GROUP)
    in_group = jnp.take_along_axis(exp_logits, grp[:, None, None], axis=1)[:, 0]
    top_logit, top_idx = lax.top_k(in_group, FINE_TOP_K)
    gate = grp_gate * jax.nn.softmax(top_logit, axis=-1)
    expert = grp[:, None] * EXPERTS_PER_GROUP + top_idx

    n_slots = n * FINE_TOP_K
    slot_expert = expert.reshape(-1)
    slot_token = jnp.repeat(jnp.arange(n, dtype=jnp.int32), FINE_TOP_K)
    slot_gate = gate.reshape(-1)
    order = jnp.argsort(slot_expert)
    sorted_expert = slot_expert[order]
    counts = jnp.bincount(slot_expert, length=N_EXPERTS)
    padded = (counts + MOE_BLOCK - 1) // MOE_BLOCK * MOE_BLOCK
    starts = jnp.cumsum(counts) - counts
    padded_end = jnp.cumsum(padded)
    padded_start = padded_end - padded
    dest = padded_start[sorted_expert] + jnp.arange(n_slots) - starts[sorted_expert]
    n_blocks = (n_slots + N_EXPERTS * (MOE_BLOCK - 1)) // MOE_BLOCK
    cap = n_blocks * MOE_BLOCK
    buf_token = jnp.full((cap,), n, jnp.int32).at[dest].set(slot_token[order])
    buf_gate = jnp.zeros((cap,), f32).at[dest].set(slot_gate[order])
    block_expert = jnp.minimum(
        jnp.searchsorted(padded_end, jnp.arange(n_blocks) * MOE_BLOCK, side='right'), N_EXPERTS - 1)
    h_pad = jnp.concatenate([h, jnp.zeros((1, d), h.dtype)], axis=0)

    def expert_block(args):
        tok, e = args
        xb = h_pad[tok]
        return (jax.nn.silu(xb @ w_gate[e]) * (xb @ w_up[e])) @ w_down[e]

    y = lax.map(expert_block, (buf_token.reshape(n_blocks, MOE_BLOCK), block_expert))
    y = y.reshape(cap, d).astype(f32) * buf_gate[:, None]
    out = jnp.zeros((n + 1, d), f32).at[buf_token].add(y)
    return out[:n]


def setup_inputs(seed: int = 0) -> dict:
    key = jax.random.key(seed)
    ks = jax.random.split(key, 32)
    f32 = jnp.float32
    d = D_MODEL

    def nrm(i, shape, std):
        return jax.random.normal(ks[i], shape, f32) * std

    h_idx = jnp.arange(RET_HEADS, dtype=f32)
    decay_init = jnp.log(-jnp.log1p(-(2.0 ** (-5.0 - h_idx))))
    n_idx = jnp.arange(S5_STATE, dtype=f32)
    return {
        'x': nrm(0, (BATCH, SEQ, d), 1.0),
        'c': nrm(1, (BATCH, d), 1.0),
        'ctx': nrm(2, (BATCH, CTX_LEN, d), 1.0),
        'c_ctx': nrm(3, (d,), 1.0),
        'ada_w': nrm(4, (DEPTH, d, N_MOD * d), 0.5 * d ** -0.5),
        'ada_b': nrm(5, (DEPTH, N_MOD * d), 0.02),
        'norm1_g': 1.0 + nrm(6, (DEPTH, d), 0.02),
        'w_in': nrm(7, (DEPTH, d, IN_WIDTH), d ** -0.5),
        'ret_decay': decay_init + nrm(8, (DEPTH, 2, RET_HEADS), 0.01),
        's5_a_re': -0.5 + nrm(9, (DEPTH, 2, S5_GROUPS, S5_STATE), 0.01),
        's5_a_im': math.pi * n_idx + nrm(10, (DEPTH, 2, S5_GROUPS, S5_STATE), 0.01),
        's5_log_step': jax.random.uniform(ks[11], (DEPTH, 2, S5_GROUPS), f32, math.log(1e-3), math.log(1e-1)),
        's5_b_re': nrm(12, (DEPTH, 2, S5_GROUPS, S5_STATE, S5_GROUP), (2 * S5_GROUP) ** -0.5),
        's5_b_im': nrm(13, (DEPTH, 2, S5_GROUPS, S5_STATE, S5_GROUP), (2 * S5_GROUP) ** -0.5),
        's5_c_re': nrm(14, (DEPTH, 2, S5_GROUPS, S5_GROUP, S5_STATE), 0.5),
        's5_c_im': nrm(15, (DEPTH, 2, S5_GROUPS, S5_GROUP, S5_STATE), 0.5),
        's5_d': nrm(16, (DEPTH, S5_GROUPS, S5_GROUP), 1.0),
        's5_glu_w': nrm(17, (DEPTH, S5_WIDTH, S5_WIDTH), S5_WIDTH ** -0.5),
        's5_glu_b': nrm(18, (DEPTH, S5_WIDTH), 0.02),
        'w_out': nrm(19, (DEPTH, MIX_WIDTH, d), MIX_WIDTH ** -0.5),
        'norm2_g': 1.0 + nrm(20, (DEPTH, d), 0.02),
        'router_grp_w': nrm(21, (DEPTH, d, N_EXPERT_GROUPS), d ** -0.5),
        'router_grp_b': nrm(22, (DEPTH, N_EXPERT_GROUPS), 0.01),
        'router_exp_w': nrm(23, (DEPTH, d, N_EXPERTS), d ** -0.5),
        'router_exp_b': nrm(24, (DEPTH, N_EXPERTS), 0.01),
        'exp_w_gate': nrm(25, (DEPTH, N_EXPERTS, d, EXPERT_FF), d ** -0.5),
        'exp_w_up': nrm(26, (DEPTH, N_EXPERTS, d, EXPERT_FF), d ** -0.5),
        'exp_w_down': nrm(27, (DEPTH, N_EXPERTS, EXPERT_FF, d), EXPERT_FF ** -0.5),
        'final_g': 1.0 + nrm(28, (d,), 0.02),
    }


def reference(x, c, ctx, c_ctx, ada_w, ada_b, norm1_g, w_in, ret_decay,
              s5_a_re, s5_a_im, s5_log_step, s5_b_re, s5_b_im, s5_c_re, s5_c_im,
              s5_d, s5_glu_w, s5_glu_b, w_out, norm2_g,
              router_grp_w, router_grp_b, router_exp_w, router_exp_b,
              exp_w_gate, exp_w_up, exp_w_down, final_g):
    bsz, n_lat, d = x.shape
    n_ctx = ctx.shape[1]
    cos, sin = rope_2d(n_lat)
    k_scale = RET_HEAD_DIM ** -0.5
    split_at = [RET_WIDTH, 2 * RET_WIDTH, 3 * RET_WIDTH, 4 * RET_WIDTH]
    x_lat, x_ctx = x, ctx
    for layer in range(DEPTH):
        ctx_out = layer < DEPTH - 1
        mod_lat = jnp.split(adaln(c, ada_w[layer], ada_b[layer])[:, None, :], N_MOD, axis=-1)
        mod_ctx = jnp.split(adaln(c_ctx, ada_w[layer], ada_b[layer])[None, None, :], N_MOD, axis=-1)

        h_lat = modulate(rms_norm(x_lat, norm1_g[layer]), mod_lat[0], mod_lat[1])
        h_ctx = modulate(rms_norm(x_ctx, norm1_g[layer]), mod_ctx[0], mod_ctx[1])
        q_l, k_l, v_l, gate_l, u_l = jnp.split(h_lat @ w_in[layer], split_at, axis=-1)
        q_c, k_c, v_c, gate_c, u_c = jnp.split(h_ctx @ w_in[layer], split_at, axis=-1)
        ret_ctx, ret_lat = retention_mixer(
            split_heads(q_c), split_heads(k_c) * k_scale, split_heads(v_c),
            apply_rope(split_heads(q_l), cos, sin), apply_rope(split_heads(k_l), cos, sin) * k_scale,
            split_heads(v_l), ret_decay[layer], ctx_out)
        s5_ctx, s5_lat = s5_mixer(u_c, u_l, s5_a_re[layer], s5_a_im[layer], s5_log_step[layer],
                                  s5_b_re[layer], s5_b_im[layer], s5_c_re[layer], s5_c_im[layer],
                                  s5_d[layer], s5_glu_w[layer], s5_glu_b[layer], ctx_out)
        mix_lat = jnp.concatenate([ret_lat * jax.nn.silu(gate_l), s5_lat], axis=-1) @ w_out[layer]
        x_lat = x_lat + mod_lat[2] * mix_lat
        if ctx_out:
            mix_ctx = jnp.concatenate([ret_ctx * jax.nn.silu(gate_c), s5_ctx], axis=-1) @ w_out[layer]
            x_ctx = x_ctx + mod_ctx[2] * mix_ctx

        h2_lat = modulate(rms_norm(x_lat, norm2_g[layer]), mod_lat[3], mod_lat[4])
        if ctx_out:
            h2_ctx = modulate(rms_norm(x_ctx, norm2_g[layer]), mod_ctx[3], mod_ctx[4])
            tokens = jnp.concatenate([h2_ctx.reshape(-1, d), h2_lat.reshape(-1, d)], axis=0)
        else:
            tokens = h2_lat.reshape(-1, d)
        ffn = hierarchical_moe(tokens, router_grp_w[layer], router_grp_b[layer],
                               router_exp_w[layer], router_exp_b[layer],
                               exp_w_gate[layer], exp_w_up[layer], exp_w_down[layer])
        x_lat = x_lat + mod_lat[5] * ffn[ffn.shape[0] - bsz * n_lat:].reshape(bsz, n_lat, d)
        if ctx_out:
            x_ctx = x_ctx + mod_ctx[5] * ffn[:bsz * n_ctx].reshape(bsz, n_ctx, d)
    return rms_norm(x_lat, final_g)
```

```cpp
#ifdef HOST_EMU
#include <cstdio>
#include <cstdlib>
#include <cstring>
#include <cmath>
#include <cstdint>
#define __global__
#define __device__
#define __host__
#define __forceinline__ inline
#define __launch_bounds__(...)
struct emu_dim3 { unsigned x, y, z; };
static emu_dim3 threadIdx = {0, 0, 0}, blockIdx = {0, 0, 0}, blockDim = {1, 1, 1}, gridDim = {1, 1, 1};
static inline int atomicAdd(int* p, int v) { int o = *p; *p += v; return o; }
typedef void* hipStream_t;
static inline void __syncthreads() {}
#else
#include <hip/hip_runtime.h>
#include <cstdio>
#include <cstdint>
#endif

#ifndef D_MODEL
#define D_MODEL 2048
#define BATCH 4
#define SEQ 2048
#define DEPTH 2
#define GRID_W 64
#define CTX_LEN 256
#define RET_HEADS 8
#define RET_CHUNK 128
#define S5_GROUP 16
#define S5_STATE 64
#define N_EXPERT_GROUPS 4
#define EXPERTS_PER_GROUP 8
#define EXPERT_FF 512
#endif

namespace nv {
constexpr int DM = D_MODEL, NB = BATCH, SQ = SEQ, CTXL = CTX_LEN, NL = DEPTH, GW = GRID_W;
constexpr int RW = DM / 2, SW = DM - RW, NH = RET_HEADS, HD = RW / NH, RC = RET_CHUNK;
constexpr int SG = S5_GROUP, NG = SW / SG, SP = S5_STATE;
constexpr int INW = 4 * RW + SW;
constexpr int NEG = N_EXPERT_GROUPS, EPG = EXPERTS_PER_GROUP, NE = NEG * EPG, EFF = EXPERT_FF;
constexpr int NMOD = 6;
constexpr int NCTX = NB * CTXL, NLAT = NB * SQ, NTOK = NCTX + NLAT;
constexpr int CC = CTXL / RC, LC = SQ / RC, NCH = CC + LC;
constexpr int NCOND = NB + 1;
constexpr float NORM_EPS = 1e-6f, GN_EPS = 1e-5f;
constexpr int MOE_TILE = 128;
constexpr int MOE_CAP = ((2 * NTOK + NE * (MOE_TILE - 1)) / MOE_TILE) * MOE_TILE;

struct In {
    const float *x, *c, *ctx, *c_ctx, *ada_w, *ada_b, *norm1_g, *w_in, *ret_decay, *s5_a_re, *s5_a_im, *s5_log_step, *s5_b_re, *s5_b_im,
        *s5_c_re, *s5_c_im, *s5_d, *s5_glu_w, *s5_glu_b, *w_out, *norm2_g, *router_grp_w, *router_grp_b, *router_exp_w, *router_exp_b,
        *exp_w_gate, *exp_w_up, *exp_w_down, *final_g;
};

__device__ __forceinline__ float silu_f(float v) { return v / (1.0f + expf(-v)); }
__device__ __forceinline__ float sigmoid_f(float v) { return 1.0f / (1.0f + expf(-v)); }
__device__ __forceinline__ float gelu_tanh_f(float v) { return 0.5f * v * (1.0f + tanhf(0.7978845608028654f * (v + 0.044715f * v * v * v))); }
__device__ __forceinline__ int cond_of_row(int r) { return r < NCTX ? NB : (r - NCTX) / SQ; }
__device__ __forceinline__ int row_of(int b, int n, int p) { return n < CC ? b * CTXL + n * RC + p : NCTX + b * SQ + (n - CC) * RC + p; }
__device__ __forceinline__ void bnp_of_row(int r, int& b, int& n, int& p) {
    if (r < NCTX) { b = r / CTXL; const int t = r % CTXL; n = t / RC; p = t % RC; }
    else { const int q = r - NCTX; b = q / SQ; const int t = q % SQ; n = CC + t / RC; p = t % RC; }
}
#define MODV(MOD, l, j, m) ((MOD) + ((size_t)((l) * NCOND + (j)) * NMOD + (m)) * DM)

__device__ void d_adaln(const In& I, float* MOD, long gtid, long gstride) {
    for (long idx = gtid; idx < (long)NL * NMOD * DM; idx += gstride) {
        const int l = (int)(idx / (NMOD * DM)), n = (int)(idx % (NMOD * DM));
        float acc[NCOND];
#pragma unroll
        for (int j = 0; j < NCOND; ++j) acc[j] = 0.f;
        const float* w = I.ada_w + (size_t)l * DM * NMOD * DM + n;
        for (int k = 0; k < DM; ++k) {
            const float wv = w[(size_t)k * NMOD * DM];
#pragma unroll
            for (int j = 0; j < NB; ++j) acc[j] += silu_f(I.c[j * DM + k]) * wv;
            acc[NB] += silu_f(I.c_ctx[k]) * wv;
        }
        const float bv = I.ada_b[(size_t)l * NMOD * DM + n];
#pragma unroll
        for (int j = 0; j < NCOND; ++j) MOD[(size_t)(l * NCOND + j) * NMOD * DM + n] = acc[j] + bv;
    }
}
__device__ void d_copy_x(const In& I, float* X, long gtid, long gstride) {
    for (long idx = gtid; idx < (long)NTOK * DM; idx += gstride) {
        const int r = (int)(idx / DM), j = (int)(idx % DM);
        X[idx] = r < NCTX ? I.ctx[(size_t)r * DM + j] : I.x[(size_t)(r - NCTX) * DM + j];
    }
}
__device__ void d_norm_mod(const float* X, const float* g, const float* MOD, int l, int mshift, int mscale, float* H, long gtid, long gstride) {
    for (long r = gtid; r < NTOK; r += gstride) {
        const float* xr = X + (size_t)r * DM; float ss = 0.f;
        for (int j = 0; j < DM; ++j) ss += xr[j] * xr[j];
        const float rs = 1.0f / sqrtf(ss / DM + NORM_EPS);
        const int cj = cond_of_row((int)r);
        const float* sh = MODV(MOD, l, cj, mshift); const float* sc = MODV(MOD, l, cj, mscale);
        for (int j = 0; j < DM; ++j) H[(size_t)r * DM + j] = xr[j] * rs * g[j] * (1.0f + sc[j]) + sh[j];
    }
}
__device__ void d_rope(float* QKV, long gtid, long gstride) {
    const float kscale = 1.0f / sqrtf((float)HD);
    constexpr int NF = HD / 4;
    for (long idx = gtid; idx < (long)NTOK * 2 * NH * (HD / 2); idx += gstride) {
        const int i = (int)(idx % (HD / 2)); long t = idx / (HD / 2);
        const int h = (int)(t % NH); t /= NH; const int which = (int)(t % 2); const int r = (int)(t / 2);
        float* p = QKV + (size_t)r * INW + which * RW + h * HD + 2 * i;
        float t0 = p[0], t1 = p[1];
        if (r >= NCTX) {
            const int pos = (r - NCTX) % SQ, rowp = pos / GW, colp = pos % GW;
            const int f = i < NF ? i : i - NF;
            const float inv = powf(10000.0f, -(float)f / (float)NF);
            const float ang = (i < NF ? (float)rowp : (float)colp) * inv;
            const float cs = cosf(ang), sn = sinf(ang);
            const float a = t0 * cs - t1 * sn, b = t0 * sn + t1 * cs; t0 = a; t1 = b;
        }
        if (which == 1) { t0 *= kscale; t1 *= kscale; }
        p[0] = t0; p[1] = t1;
    }
}
__device__ __forceinline__ float logg(const In& I, int l, int dir, int h) { return -expf(I.ret_decay[(l * 2 + dir) * NH + h]); }
__device__ void d_ret_kv(const In& I, int l, const float* QKV, float* KV, long gtid, long gstride) {
    for (long idx = gtid; idx < (long)2 * NB * NH * NCH * HD * HD; idx += gstride) {
        const int e = (int)(idx % HD); long t = idx / HD; const int d = (int)(t % HD); t /= HD; const int n = (int)(t % NCH); t /= NCH;
        const int h = (int)(t % NH); t /= NH; const int b = (int)(t % NB); const int dir = (int)(t / NB);
        const float lg = logg(I, l, dir, h); float acc = 0.f;
        for (int p = 0; p < RC; ++p) {
            const int row = row_of(b, n, p);
            const float w = expf(lg * (float)(dir == 0 ? RC - 1 - p : p));
            acc += w * QKV[(size_t)row * INW + RW + h * HD + d] * QKV[(size_t)row * INW + 2 * RW + h * HD + e];
        }
        KV[idx] = acc;
    }
}
__device__ __forceinline__ int chain_chunk(int dir, int step) { return dir == 0 ? step : (step < CC ? CC - 1 - step : NCH - 1 - (step - CC)); }
__device__ void d_ret_scan(const In& I, int l, const float* KV, float* ST, long gtid, long gstride) {
    for (long idx = gtid; idx < (long)2 * NB * NH * HD * HD; idx += gstride) {
        const int de = (int)(idx % (HD * HD)); long t = idx / (HD * HD); const int h = (int)(t % NH); t /= NH; const int b = (int)(t % NB); const int dir = (int)(t / NB);
        const float dec = expf(logg(I, l, dir, h) * (float)RC); float s = 0.f;
        for (int step = 0; step < NCH; ++step) {
            const int n = chain_chunk(dir, step);
            const size_t o = ((((size_t)dir * NB + b) * NH + h) * NCH + n) * HD * HD + de;
            ST[o] = s; s = dec * s + KV[o];
        }
    }
}
__device__ void d_ret_scores(const In& I, int l, const float* QKV, float* SC, long gtid, long gstride) {
    for (long idx = gtid; idx < (long)NTOK * NH * RC; idx += gstride) {
        const int j = (int)(idx % RC); long t = idx / RC; const int h = (int)(t % NH); const int r = (int)(t / NH);
        int b, n, p; bnp_of_row(r, b, n, p);
        const int rj = row_of(b, n, j);
        const float* q = QKV + (size_t)r * INW + h * HD; const float* k = QKV + (size_t)rj * INW + RW + h * HD;
        float dot = 0.f;
        for (int d = 0; d < HD; ++d) dot += q[d] * k[d];
        const float D = j <= p ? expf(logg(I, l, 0, h) * (float)(p - j)) : expf(logg(I, l, 1, h) * (float)(j - p));
        SC[idx] = dot * D;
    }
}
__device__ void d_ret_out(const In& I, int l, const float* QKV, const float* SC, const float* ST, float* RO, long gtid, long gstride) {
    for (long idx = gtid; idx < (long)NTOK * NH * HD; idx += gstride) {
        const int e = (int)(idx % HD); long t = idx / HD; const int h = (int)(t % NH); const int r = (int)(t / NH);
        int b, n, p; bnp_of_row(r, b, n, p);
        float acc = 0.f;
        const float* sc = SC + ((size_t)r * NH + h) * RC;
        for (int j = 0; j < RC; ++j) acc += sc[j] * QKV[(size_t)row_of(b, n, j) * INW + 2 * RW + h * HD + e];
        const float qwf = expf(logg(I, l, 0, h) * (float)(p + 1)), qwb = expf(logg(I, l, 1, h) * (float)(RC - p));
        const float* sf = ST + ((((size_t)0 * NB + b) * NH + h) * NCH + n) * HD * HD + e;
        const float* sb = ST + ((((size_t)1 * NB + b) * NH + h) * NCH + n) * HD * HD + e;
        const float* q = QKV + (size_t)r * INW + h * HD;
        for (int d = 0; d < HD; ++d) acc += q[d] * (qwf * sf[(size_t)d * HD] + qwb * sb[(size_t)d * HD]);
        RO[(size_t)r * RW + h * HD + e] = acc;
    }
}
__device__ void d_ret_norm(const float* RO, const float* QKV, float* MIX, long gtid, long gstride) {
    for (long idx = gtid; idx < (long)NTOK * NH; idx += gstride) {
        const int h = (int)(idx % NH), r = (int)(idx / NH);
        const float* o = RO + (size_t)r * RW + h * HD; float mu = 0.f;
        for (int e = 0; e < HD; ++e) mu += o[e];
        mu /= HD; float var = 0.f;
        for (int e = 0; e < HD; ++e) var += (o[e] - mu) * (o[e] - mu);
        var /= HD; const float rs = 1.0f / sqrtf(var + GN_EPS);
        for (int e = 0; e < HD; ++e) MIX[(size_t)r * DM + h * HD + e] = (o[e] - mu) * rs * silu_f(QKV[(size_t)r * INW + 3 * RW + h * HD + e]);
    }
}
__device__ void d_s5_disc(const In& I, int l, float* ABAR, float* BBAR, long gtid, long gstride) {
    for (long idx = gtid; idx < (long)2 * NG * SP; idx += gstride) {
        const int p = (int)(idx % SP); long t = idx / SP; const int g = (int)(t % NG); const int dir = (int)(t / NG);
        const size_t ia = (((size_t)l * 2 + dir) * NG + g) * SP + p;
        const float are = I.s5_a_re[ia], aim = I.s5_a_im[ia], dt = expf(I.s5_log_step[((size_t)l * 2 + dir) * NG + g]);
        const float mag = expf(are * dt), ang = aim * dt;
        const float abr = mag * cosf(ang), abi = mag * sinf(ang);
        const float den = are * are + aim * aim, nr = abr - 1.0f;
        const float fr = (nr * are + abi * aim) / den, fi = (abi * are - nr * aim) / den;
        ABAR[idx * 2] = abr; ABAR[idx * 2 + 1] = abi;
#pragma unroll
        for (int c = 0; c < SG; ++c) {
            const float br = I.s5_b_re[ia * SG + c], bi = I.s5_b_im[ia * SG + c];
            BBAR[(idx * SG + c) * 2] = fr * br - fi * bi; BBAR[(idx * SG + c) * 2 + 1] = fr * bi + fi * br;
        }
    }
}
__device__ __forceinline__ int chain_row(int dir, int b, int step) {
    if (dir == 0) return step < CTXL ? b * CTXL + step : NCTX + b * SQ + (step - CTXL);
    return step < CTXL ? b * CTXL + (CTXL - 1 - step) : NCTX + b * SQ + (SQ - 1 - (step - CTXL));
}
__device__ void d_s5_scan(const float* QKV, const float* ABAR, const float* BBAR, float* HS, long gtid, long gstride) {
    for (long idx = gtid; idx < (long)2 * NB * NG * SP; idx += gstride) {
        const int p = (int)(idx % SP); long t = idx / SP; const int g = (int)(t % NG); t /= NG; const int b = (int)(t % NB); const int dir = (int)(t / NB);
        const size_t ip = ((size_t)dir * NG + g) * SP + p;
        const float ar = ABAR[ip * 2], ai = ABAR[ip * 2 + 1];
        float br[SG], bi[SG];
#pragma unroll
        for (int c = 0; c < SG; ++c) { br[c] = BBAR[(ip * SG + c) * 2]; bi[c] = BBAR[(ip * SG + c) * 2 + 1]; }
        float hr = 0.f, hi = 0.f;
        for (int step = 0; step < CTXL + SQ; ++step) {
            const int row = chain_row(dir, b, step);
            const float* u = QKV + (size_t)row * INW + 4 * RW + g * SG;
            float ur = 0.f, ui = 0.f;
#pragma unroll
            for (int c = 0; c < SG; ++c) { ur += br[c] * u[c]; ui += bi[c] * u[c]; }
            const float nr = ar * hr - ai * hi + ur, ni = ar * hi + ai * hr + ui; hr = nr; hi = ni;
            float* o = HS + ((((size_t)dir * NTOK + row) * NG + g) * SP + p) * 2; o[0] = hr; o[1] = hi;
        }
    }
}
__device__ void d_s5_y(const In& I, int l, const float* QKV, const float* HS, float* Z, long gtid, long gstride) {
    for (long idx = gtid; idx < (long)NTOK * SW; idx += gstride) {
        const int ch = (int)(idx % SW), row = (int)(idx / SW), g = ch / SG, c = ch % SG;
        float y = I.s5_d[((size_t)l * NG + g) * SG + c] * QKV[(size_t)row * INW + 4 * RW + ch];
        for (int dir = 0; dir < 2; ++dir) {
            const float* cr = I.s5_c_re + ((((size_t)l * 2 + dir) * NG + g) * SG + c) * SP;
            const float* ci = I.s5_c_im + ((((size_t)l * 2 + dir) * NG + g) * SG + c) * SP;
            const float* h = HS + (((size_t)dir * NTOK + row) * NG + g) * SP * 2;
            for (int p = 0; p < SP; ++p) y += cr[p] * h[2 * p] - ci[p] * h[2 * p + 1];
        }
        Z[idx] = gelu_tanh_f(y);
    }
}
__device__ void d_glu_ep(const In& I, int l, const float* Z, const float* T, float* MIX, long gtid, long gstride) {
    for (long idx = gtid; idx < (long)NTOK * SW; idx += gstride) {
        const int j = (int)(idx % SW), r = (int)(idx / SW);
        MIX[(size_t)r * DM + RW + j] = Z[idx] * sigmoid_f(T[idx] + I.s5_glu_b[(size_t)l * SW + j]);
    }
}
__device__ void d_resid(float* X, const float* T2, const float* MOD, int l, int m, long gtid, long gstride) {
    for (long idx = gtid; idx < (long)NTOK * DM; idx += gstride) {
        const int j = (int)(idx % DM), r = (int)(idx / DM);
        X[idx] += MODV(MOD, l, cond_of_row(r), m)[j] * T2[idx];
    }
}
__device__ void d_route(const In& I, int l, const float* H2, int* TE, int* TP, float* TG, int* CNT, int row_lo, long gtid, long gstride) {
    for (long r = row_lo + gtid; r < NTOK; r += gstride) {
        float gl[NEG], el[NE];
#pragma unroll
        for (int j = 0; j < NEG; ++j) gl[j] = 0.f;
#pragma unroll
        for (int j = 0; j < NE; ++j) el[j] = 0.f;
        const float* h = H2 + (size_t)r * DM;
        const float* gw = I.router_grp_w + (size_t)l * DM * NEG; const float* ew = I.router_exp_w + (size_t)l * DM * NE;
        for (int k = 0; k < DM; ++k) {
            const float hv = h[k];
#pragma unroll
            for (int j = 0; j < NEG; ++j) gl[j] += hv * gw[(size_t)k * NEG + j];
#pragma unroll
            for (int j = 0; j < NE; ++j) el[j] += hv * ew[(size_t)k * NE + j];
        }
#pragma unroll
        for (int j = 0; j < NEG; ++j) gl[j] += I.router_grp_b[l * NEG + j];
#pragma unroll
        for (int j = 0; j < NE; ++j) el[j] += I.router_exp_b[l * NE + j];
        int grp = 0; float gmax = gl[0];
#pragma unroll
        for (int j = 1; j < NEG; ++j) if (gl[j] > gmax) { gmax = gl[j]; grp = j; }
        float den = 0.f;
#pragma unroll
        for (int j = 0; j < NEG; ++j) den += expf(gl[j] - gmax);
        const float gprob = 1.0f / den;
        float sel[EPG];
#pragma unroll
        for (int j = 0; j < EPG; ++j) { float v = el[j];
#pragma unroll
            for (int g2 = 1; g2 < NEG; ++g2) v = (grp == g2) ? el[g2 * EPG + j] : v;
            sel[j] = v; }
        int i0 = 0; float l0 = sel[0];
#pragma unroll
        for (int j = 1; j < EPG; ++j) if (sel[j] > l0) { l0 = sel[j]; i0 = j; }
        int i1 = -1; float l1 = -3.0e38f;
#pragma unroll
        for (int j = 0; j < EPG; ++j) if (j != i0 && sel[j] > l1) { l1 = sel[j]; i1 = j; }
        const float e1 = expf(l1 - l0), g0 = gprob / (1.0f + e1), g1 = gprob * e1 / (1.0f + e1);
        const int ex0 = grp * EPG + i0, ex1 = grp * EPG + i1;
        TE[r * 2] = ex0; TE[r * 2 + 1] = ex1; TG[r * 2] = g0; TG[r * 2 + 1] = g1;
        TP[r * 2] = atomicAdd(&CNT[ex0], 1); TP[r * 2 + 1] = atomicAdd(&CNT[ex1], 1);
    }
}
__device__ void d_moe_offsets(const int* CNT, int* META, int tile, long gtid) {
    if (gtid == 0) {
        int off = 0, nt = 0;
        for (int e = 0; e < NE; ++e) {
            META[1 + e] = off; const int t = (CNT[e] + tile - 1) / tile;
            for (int k = 0; k < t; ++k) META[64 + nt + k] = e;
            nt += t; off += t * tile;
        }
        META[0] = nt;
    }
}
__device__ void d_moe_scatter(const int* TE, const int* TP, const int* META, int* SLOT_TOK, int* TS, int row_lo, long gtid, long gstride) {
    for (long idx = (long)row_lo * 2 + gtid; idx < (long)NTOK * 2; idx += gstride) {
        const int slot = META[1 + TE[idx]] + TP[idx];
        SLOT_TOK[slot] = (int)(idx / 2); TS[idx] = slot;
    }
}
__device__ void d_moe_act(const float* GU, float* ACT, const int* META, int tile, long gtid, long gstride) {
    const long nrows = (long)META[0] * tile;
    for (long idx = gtid; idx < nrows * EFF; idx += gstride) {
        const int j = (int)(idx % EFF); const long s = idx / EFF;
        ACT[idx] = silu_f(GU[s * 2 * EFF + j]) * GU[s * 2 * EFF + EFF + j];
    }
}
__device__ void d_moe_combine(float* X, const float* Y, const int* TS, const float* TG, const float* MOD, int l, int row_lo, long gtid, long gstride) {
    for (long idx = (long)row_lo * DM + gtid; idx < (long)NTOK * DM; idx += gstride) {
        const int j = (int)(idx % DM), r = (int)(idx / DM);
        const float v = TG[r * 2] * Y[(size_t)TS[r * 2] * DM + j] + TG[r * 2 + 1] * Y[(size_t)TS[r * 2 + 1] * DM + j];
        X[idx] += MODV(MOD, l, cond_of_row(r), 5)[j] * v;
    }
}
__device__ void d_final(const In& I, const float* X, float* out, long gtid, long gstride) {
    for (long r = NCTX + gtid; r < NTOK; r += gstride) {
        const float* xr = X + (size_t)r * DM; float ss = 0.f;
        for (int j = 0; j < DM; ++j) ss += xr[j] * xr[j];
        const float rs = 1.0f / sqrtf(ss / DM + NORM_EPS);
        for (int j = 0; j < DM; ++j) out[(size_t)(r - NCTX) * DM + j] = xr[j] * rs * I.final_g[j];
    }
}

struct GemmArgs { const float* A; int lda; const int* gather; const float* B; int ldb; size_t strideB; float* C; int ldc; int M, N, K; const int* META; };
#ifdef HOST_EMU
__device__ void d_gemm(const GemmArgs& g, void* smem, int bid, int nblk) {
    (void)smem; (void)bid; (void)nblk;
    const int M = g.META ? g.META[0] * MOE_TILE : g.M;
    for (int m = 0; m < M; ++m) {
        const float* B = g.B + (g.META ? (size_t)g.META[64 + m / MOE_TILE] * g.strideB : 0);
        const int src = g.gather ? g.gather[m] : m;
        for (int n = 0; n < g.N; ++n) { double acc = 0;
            if (src >= 0) for (int k = 0; k < g.K; ++k) acc += (double)g.A[(size_t)src * g.lda + k] * B[(size_t)k * g.ldb + n];
            g.C[(size_t)m * g.ldc + n] = (float)acc; }
    }
}
#else
__device__ void d_gemm(const GemmArgs& g, void* smem, int bid, int nblk) {
    float* As = (float*)smem;
    float* Bs = As + 16 * 132;
    const int tid = threadIdx.x, tx = tid % 16, ty = tid / 16;
    const int M = g.META ? g.META[0] * MOE_TILE : g.M;
    const int ntm = (M + 127) / 128, ntn = (g.N + 63) / 64;
    for (int tile = bid; tile < ntm * ntn; tile += nblk) {
        const int tm = tile / ntn, tn = tile % ntn, m0 = tm * 128, n0 = tn * 64;
        const float* B = g.B + (g.META ? (size_t)g.META[64 + tm] * g.strideB : 0);
        float acc[4][4];
        for (int i = 0; i < 4; ++i) for (int j = 0; j < 4; ++j) acc[i][j] = 0.f;
        for (int k0 = 0; k0 < g.K; k0 += 16) {
            for (int q = tid; q < 128 * 16; q += 512) { const int mm = q / 16, kk = q % 16; const int m = m0 + mm; float v = 0.f;
                if (m < M && k0 + kk < g.K) { const int src = g.gather ? g.gather[m] : m; if (src >= 0) v = g.A[(size_t)src * g.lda + k0 + kk]; }
                As[kk * 132 + mm] = v; }
            for (int q = tid; q < 16 * 64; q += 512) { const int kk = q / 64, nn = q % 64; float v = 0.f;
                if (k0 + kk < g.K && n0 + nn < g.N) v = B[(size_t)(k0 + kk) * g.ldb + n0 + nn];
                Bs[kk * 64 + nn] = v; }
            __syncthreads();
#pragma unroll
            for (int kk = 0; kk < 16; ++kk) { float a[4], b[4];
#pragma unroll
                for (int i = 0; i < 4; ++i) a[i] = As[kk * 132 + ty * 4 + i];
#pragma unroll
                for (int j = 0; j < 4; ++j) b[j] = Bs[kk * 64 + tx * 4 + j];
#pragma unroll
                for (int i = 0; i < 4; ++i)
#pragma unroll
                    for (int j = 0; j < 4; ++j) acc[i][j] += a[i] * b[j]; }
            __syncthreads();
        }
        for (int i = 0; i < 4; ++i) { const int m = m0 + ty * 4 + i; if (m >= M) continue;
            for (int j = 0; j < 4; ++j) { const int n = n0 + tx * 4 + j; if (n < g.N) g.C[(size_t)m * g.ldc + n] = acc[i][j]; } }
    }
}
#endif
}
namespace nv {
constexpr size_t al256(size_t x) { return (x + 255) & ~(size_t)255; }
constexpr size_t SZ_CTL_L = 8192;
constexpr size_t OFF_CTL = 0, SZ_CTL = al256(NL * SZ_CTL_L);
constexpr size_t OFF_SLOT = OFF_CTL + SZ_CTL, SZ_SLOT = al256((size_t)NL * MOE_CAP * 4);
constexpr size_t OFF_MOD = OFF_SLOT + SZ_SLOT, SZ_MOD = al256((size_t)NL * NCOND * NMOD * DM * 4);
constexpr size_t OFF_ABAR = OFF_MOD + SZ_MOD, SZ_ABAR = al256((size_t)2 * NG * SP * 2 * 4);
constexpr size_t OFF_BBAR = OFF_ABAR + SZ_ABAR, SZ_BBAR = al256((size_t)2 * NG * SP * SG * 2 * 4);
constexpr size_t OFF_TE = OFF_BBAR + SZ_BBAR, SZ_T2I = al256((size_t)NTOK * 2 * 4);
constexpr size_t OFF_TP = OFF_TE + SZ_T2I, OFF_TG = OFF_TP + SZ_T2I, OFF_TS = OFF_TG + SZ_T2I;
constexpr size_t OFF_X = OFF_TS + SZ_T2I, SZ_X = al256((size_t)NTOK * DM * 4);
constexpr size_t OFF_QKV = OFF_X + SZ_X, SZ_QKV = al256((size_t)NTOK * INW * 4);
constexpr size_t OFF_MIX = OFF_QKV + SZ_QKV, SZ_MIX = SZ_X;
constexpr size_t OFF_Z = OFF_MIX + SZ_MIX, SZ_Z = al256((size_t)NTOK * SW * 4);
constexpr size_t OFF_BIG = OFF_Z + SZ_Z;
constexpr size_t SZ_KV = al256((size_t)2 * NB * NH * NCH * HD * HD * 4);
constexpr size_t OFF_H = OFF_BIG;
constexpr size_t OFF_ST = OFF_BIG + SZ_KV, OFF_SC = OFF_ST + SZ_KV, SZ_SC = al256((size_t)NTOK * NH * RC * 4);
constexpr size_t OFF_RO = OFF_SC + SZ_SC, SZ_RO = al256((size_t)NTOK * RW * 4);
constexpr size_t SZ_HS = al256((size_t)2 * NTOK * NG * SP * 2 * 4);
constexpr size_t OFF_GU = OFF_BIG + SZ_X, SZ_GU = al256((size_t)MOE_CAP * 2 * EFF * 4);
constexpr size_t OFF_ACT = OFF_GU + SZ_GU, SZ_ACT = al256((size_t)MOE_CAP * EFF * 4);
constexpr size_t OFF_Y = OFF_ACT + SZ_ACT, SZ_Y = al256((size_t)MOE_CAP * DM * 4);
constexpr size_t cmax(size_t a, size_t b) { return a > b ? a : b; }
constexpr size_t WS_NEED = cmax(cmax(OFF_BIG + SZ_HS, OFF_RO + SZ_RO), OFF_Y + SZ_Y);

struct Params { In I; float* out; unsigned char* ws; };

enum Stage { S_ADALN = 0, S_COPYX, S_DISC, S_NORM1, S_GEMM_IN, S_ROPE, S_RET_KV, S_RET_SCAN, S_RET_SCORES, S_RET_OUT, S_RET_NORM, S_S5_SCAN, S_S5_Y,
             S_GEMM_GLU, S_GLU_EP, S_GEMM_OUT, S_RESID1, S_NORM2, S_ROUTE, S_MOE_OFF, S_MOE_SCATTER, S_GEMM_G, S_GEMM_U, S_MOE_ACT, S_GEMM_D, S_MOE_COMBINE, S_FINAL };

__device__ __forceinline__ void run_stage(const Params& p, int stage, int l, void* smem, int bid, int nblk, long gtid, long gstride) {
    const In& I = p.I; unsigned char* ws = p.ws;
    float* MOD = (float*)(ws + OFF_MOD); float* X = (float*)(ws + OFF_X); float* QKV = (float*)(ws + OFF_QKV); float* MIX = (float*)(ws + OFF_MIX);
    float* Z = (float*)(ws + OFF_Z); float* H = (float*)(ws + OFF_H); float* KV = (float*)(ws + OFF_BIG); float* ST = (float*)(ws + OFF_ST);
    float* SC = (float*)(ws + OFF_SC); float* RO = (float*)(ws + OFF_RO); float* HS = (float*)(ws + OFF_BIG); float* T = (float*)(ws + OFF_BIG);
    float* ABAR = (float*)(ws + OFF_ABAR); float* BBAR = (float*)(ws + OFF_BBAR);
    int* CNT = (int*)(ws + OFF_CTL + (size_t)l * SZ_CTL_L); int* META = CNT + 256;
    int* SLOT_TOK = (int*)(ws + OFF_SLOT) + (size_t)l * MOE_CAP;
    int* TE = (int*)(ws + OFF_TE); int* TP = (int*)(ws + OFF_TP); float* TG = (float*)(ws + OFF_TG); int* TS = (int*)(ws + OFF_TS);
    float* GU = (float*)(ws + OFF_GU); float* ACT = (float*)(ws + OFF_ACT); float* Y = (float*)(ws + OFF_Y);
    const int row_lo = (l == NL - 1) ? NCTX : 0;
    switch (stage) {
    case S_ADALN: d_adaln(I, MOD, gtid, gstride); break;
    case S_COPYX: d_copy_x(I, X, gtid, gstride); break;
    case S_DISC: d_s5_disc(I, l, ABAR, BBAR, gtid, gstride); break;
    case S_NORM1: d_norm_mod(X, I.norm1_g + (size_t)l * DM, MOD, l, 0, 1, H, gtid, gstride); break;
    case S_GEMM_IN: { GemmArgs g{H, DM, nullptr, I.w_in + (size_t)l * DM * INW, INW, 0, QKV, INW, NTOK, INW, DM, nullptr}; d_gemm(g, smem, bid, nblk); } break;
    case S_ROPE: d_rope(QKV, gtid, gstride); break;
    case S_RET_KV: d_ret_kv(I, l, QKV, KV, gtid, gstride); break;
    case S_RET_SCAN: d_ret_scan(I, l, KV, ST, gtid, gstride); break;
    case S_RET_SCORES: d_ret_scores(I, l, QKV, SC, gtid, gstride); break;
    case S_RET_OUT: d_ret_out(I, l, QKV, SC, ST, RO, gtid, gstride); break;
    case S_RET_NORM: d_ret_norm(RO, QKV, MIX, gtid, gstride); break;
    case S_S5_SCAN: d_s5_scan(QKV, ABAR, BBAR, HS, gtid, gstride); break;
    case S_S5_Y: d_s5_y(I, l, QKV, HS, Z, gtid, gstride); break;
    case S_GEMM_GLU: { GemmArgs g{Z, SW, nullptr, I.s5_glu_w + (size_t)l * SW * SW, SW, 0, T, SW, NTOK, SW, SW, nullptr}; d_gemm(g, smem, bid, nblk); } break;
    case S_GLU_EP: d_glu_ep(I, l, Z, T, MIX, gtid, gstride); break;
    case S_GEMM_OUT: { GemmArgs g{MIX, DM, nullptr, I.w_out + (size_t)l * DM * DM, DM, 0, T, DM, NTOK, DM, DM, nullptr}; d_gemm(g, smem, bid, nblk); } break;
    case S_RESID1: d_resid(X, T, MOD, l, 2, gtid, gstride); break;
    case S_NORM2: d_norm_mod(X, I.norm2_g + (size_t)l * DM, MOD, l, 3, 4, H, gtid, gstride); break;
    case S_ROUTE: d_route(I, l, H, TE, TP, TG, CNT, row_lo, gtid, gstride); break;
    case S_MOE_OFF: d_moe_offsets(CNT, META, MOE_TILE, gtid); break;
    case S_MOE_SCATTER: d_moe_scatter(TE, TP, META, SLOT_TOK, TS, row_lo, gtid, gstride); break;
    case S_GEMM_G: { GemmArgs g{H, DM, SLOT_TOK, I.exp_w_gate + (size_t)l * NE * DM * EFF, EFF, (size_t)DM * EFF, GU, 2 * EFF, 0, EFF, DM, META}; d_gemm(g, smem, bid, nblk); } break;
    case S_GEMM_U: { GemmArgs g{H, DM, SLOT_TOK, I.exp_w_up + (size_t)l * NE * DM * EFF, EFF, (size_t)DM * EFF, GU + EFF, 2 * EFF, 0, EFF, DM, META}; d_gemm(g, smem, bid, nblk); } break;
    case S_MOE_ACT: d_moe_act(GU, ACT, META, MOE_TILE, gtid, gstride); break;
    case S_GEMM_D: { GemmArgs g{ACT, EFF, nullptr, I.exp_w_down + (size_t)l * NE * EFF * DM, DM, (size_t)EFF * DM, Y, DM, 0, DM, EFF, META}; d_gemm(g, smem, bid, nblk); } break;
    case S_MOE_COMBINE: d_moe_combine(X, Y, TS, TG, MOD, l, row_lo, gtid, gstride); break;
    case S_FINAL: d_final(I, X, p.out, gtid, gstride); break;
    default: break;
    }
}
}

#ifndef HOST_EMU
__global__ void __launch_bounds__(512) k_stage(nv::Params p, int stage, int l) {
    __shared__ float smem[16 * 132 + 16 * 64];
    nv::run_stage(p, stage, l, smem, blockIdx.x, gridDim.x, (long)blockIdx.x * blockDim.x + threadIdx.x, (long)gridDim.x * blockDim.x);
}
#endif

static void naive_launch(const nv::Params& p, int stage, int l, hipStream_t stream) {
#ifdef HOST_EMU
    (void)stream; nv::run_stage(p, stage, l, nullptr, 0, 1, 0, 1);
#else
    hipLaunchKernelGGL(k_stage, dim3(1024), dim3(512), 0, stream, p, stage, l);
#endif
}

static nv::Params make_params(void* const* d_in, void* d_out, void* d_ws) {
    nv::Params p{};
    const float** f = (const float**)&p.I;
    for (int i = 0; i < 29; ++i) f[i] = (const float*)d_in[i];
    p.out = (float*)d_out; p.ws = (unsigned char*)d_ws;
    return p;
}

extern "C" void kernel_launch(void* const* d_in, const int* in_sizes, int n_in, void* d_out, int out_size, void* d_ws, size_t ws_size, hipStream_t stream) {
    using namespace nv;
    (void)in_sizes; (void)out_size;
    if (n_in != 29 || ws_size < WS_NEED) { fprintf(stderr, "kernel_launch: n_in %d ws %zu need %zu\n", n_in, ws_size, (size_t)WS_NEED); return; }
    Params p = make_params(d_in, d_out, d_ws);
#ifdef HOST_EMU
    memset((char*)d_ws + OFF_CTL, 0, SZ_CTL); memset((char*)d_ws + OFF_SLOT, 0xFF, SZ_SLOT);
#else
    hipMemsetAsync((char*)d_ws + OFF_CTL, 0, SZ_CTL, stream); hipMemsetAsync((char*)d_ws + OFF_SLOT, 0xFF, SZ_SLOT, stream);
#endif
    naive_launch(p, S_ADALN, 0, stream); naive_launch(p, S_COPYX, 0, stream);
    for (int l = 0; l < NL; ++l) {
        static const int prog[] = { S_DISC, S_NORM1, S_GEMM_IN, S_ROPE, S_RET_KV, S_RET_SCAN, S_RET_SCORES, S_RET_OUT, S_RET_NORM, S_S5_SCAN, S_S5_Y, S_GEMM_GLU, S_GLU_EP,
                                    S_GEMM_OUT, S_RESID1, S_NORM2, S_ROUTE, S_MOE_OFF, S_MOE_SCATTER, S_GEMM_G, S_GEMM_U, S_MOE_ACT, S_GEMM_D, S_MOE_COMBINE };
        for (unsigned i = 0; i < sizeof(prog) / sizeof(prog[0]); ++i) naive_launch(p, prog[i], l, stream);
    }
    naive_launch(p, S_FINAL, 0, stream);
}
```

```cpp
#ifdef HOST_EMU
#include <cstdio>
#include <cstdlib>
#include <cstring>
#include <cmath>
#include <vector>
#include <cstdint>
#define __global__
#define __device__
#define __host__
#define __forceinline__ inline
#define __launch_bounds__(...)
struct emu_dim3 { unsigned x, y, z; };
static emu_dim3 threadIdx = {0, 0, 0}, blockIdx = {0, 0, 0}, blockDim = {1, 1, 1}, gridDim = {1, 1, 1};
static inline int atomicAdd(int* p, int v) { int o = *p; *p += v; return o; }
typedef void* hipStream_t;
static inline void __syncthreads() {}
#else
#include <hip/hip_runtime.h>
#include <cstdio>
#include <cstdint>
#endif

#ifndef D_MODEL
#define D_MODEL 2048
#define BATCH 4
#define SEQ 2048
#define DEPTH 2
#define GRID_W 64
#define CTX_LEN 256
#define RET_HEADS 8
#define RET_CHUNK 128
#define S5_GROUP 16
#define S5_STATE 64
#define N_EXPERT_GROUPS 4
#define EXPERTS_PER_GROUP 8
#define EXPERT_FF 512
#endif

namespace nv {
constexpr int DM = D_MODEL, NB = BATCH, SQ = SEQ, CTXL = CTX_LEN, NL = DEPTH, GW = GRID_W;
constexpr int RW = DM / 2, SW = DM - RW, NH = RET_HEADS, HD = RW / NH, RC = RET_CHUNK;
constexpr int SG = S5_GROUP, NG = SW / SG, SP = S5_STATE;
constexpr int INW = 4 * RW + SW;
constexpr int NEG = N_EXPERT_GROUPS, EPG = EXPERTS_PER_GROUP, NE = NEG * EPG, EFF = EXPERT_FF;
constexpr int NMOD = 6;
constexpr int NCTX = NB * CTXL, NLAT = NB * SQ, NTOK = NCTX + NLAT;
constexpr int CC = CTXL / RC, LC = SQ / RC, NCH = CC + LC;
constexpr int NCOND = NB + 1;
constexpr float NORM_EPS = 1e-6f, GN_EPS = 1e-5f;
constexpr int MOE_TILE = 128;
constexpr int MOE_CAP = ((2 * NTOK + NE * (MOE_TILE - 1)) / MOE_TILE) * MOE_TILE + MOE_TILE;

struct In {
    const float *x, *c, *ctx, *c_ctx, *ada_w, *ada_b, *norm1_g, *w_in, *ret_decay, *s5_a_re, *s5_a_im, *s5_log_step, *s5_b_re, *s5_b_im,
        *s5_c_re, *s5_c_im, *s5_d, *s5_glu_w, *s5_glu_b, *w_out, *norm2_g, *router_grp_w, *router_grp_b, *router_exp_w, *router_exp_b,
        *exp_w_gate, *exp_w_up, *exp_w_down, *final_g;
};

typedef unsigned short bf16_t;
__device__ __forceinline__ bf16_t f2bf(float f) { unsigned u; __builtin_memcpy(&u, &f, 4); u = (u + 0x7fffu + ((u >> 16) & 1u)) >> 16; return (bf16_t)u; }
__device__ __forceinline__ float nbf2f(bf16_t b) { unsigned u = ((unsigned)b) << 16; float f; __builtin_memcpy(&f, &u, 4); return f; }
__device__ __forceinline__ float silu_f(float v) { return v / (1.0f + expf(-v)); }
__device__ __forceinline__ float sigmoid_f(float v) { return 1.0f / (1.0f + expf(-v)); }
__device__ __forceinline__ float gelu_tanh_f(float v) { return 0.5f * v * (1.0f + tanhf(0.7978845608028654f * (v + 0.044715f * v * v * v))); }
__device__ __forceinline__ int cond_of_row(int r) { return r < NCTX ? NB : (r - NCTX) / SQ; }
__device__ __forceinline__ int row_of(int b, int n, int p) { return n < CC ? b * CTXL + n * RC + p : NCTX + b * SQ + (n - CC) * RC + p; }
__device__ __forceinline__ void bnp_of_row(int r, int& b, int& n, int& p) {
    if (r < NCTX) { b = r / CTXL; const int t = r % CTXL; n = t / RC; p = t % RC; }
    else { const int q = r - NCTX; b = q / SQ; const int t = q % SQ; n = CC + t / RC; p = t % RC; }
}
#define MODV(MOD, l, j, m) ((MOD) + ((size_t)((l) * NCOND + (j)) * NMOD + (m)) * DM)

__device__ __forceinline__ void d_adaln(const In& I, float* MOD, long gtid, long gstride) {
    for (long idx = gtid; idx < (long)NL * NMOD * DM; idx += gstride) {
        const int l = (int)(idx / (NMOD * DM)), n = (int)(idx % (NMOD * DM));
        float acc[NCOND];
#pragma unroll
        for (int j = 0; j < NCOND; ++j) acc[j] = 0.f;
        const float* w = I.ada_w + (size_t)l * DM * NMOD * DM + n;
        for (int k = 0; k < DM; ++k) {
            const float wv = w[(size_t)k * NMOD * DM];
#pragma unroll
            for (int j = 0; j < NB; ++j) acc[j] += silu_f(I.c[j * DM + k]) * wv;
            acc[NB] += silu_f(I.c_ctx[k]) * wv;
        }
        const float bv = I.ada_b[(size_t)l * NMOD * DM + n];
#pragma unroll
        for (int j = 0; j < NCOND; ++j) MOD[(size_t)(l * NCOND + j) * NMOD * DM + n] = acc[j] + bv;
    }
}
__device__ __forceinline__ void d_copy_x(const In& I, float* X, long gtid, long gstride) {
    for (long idx = gtid; idx < (long)NTOK * DM; idx += gstride) {
        const int r = (int)(idx / DM), j = (int)(idx % DM);
        X[idx] = r < NCTX ? I.ctx[(size_t)r * DM + j] : I.x[(size_t)(r - NCTX) * DM + j];
    }
}
__device__ __forceinline__ void d_norm_mod(const float* X, const float* g, const float* MOD, int l, int mshift, int mscale, float* H, bf16_t* Hb, long gtid, long gstride) {
    for (long r = gtid; r < NTOK; r += gstride) {
        const float* xr = X + (size_t)r * DM; float ss = 0.f;
        for (int j = 0; j < DM; ++j) ss += xr[j] * xr[j];
        const float rs = 1.0f / sqrtf(ss / DM + NORM_EPS);
        const int cj = cond_of_row((int)r);
        const float* sh = MODV(MOD, l, cj, mshift); const float* sc = MODV(MOD, l, cj, mscale);
        for (int j = 0; j < DM; ++j) { const float v = xr[j] * rs * g[j] * (1.0f + sc[j]) + sh[j]; H[(size_t)r * DM + j] = v; if (Hb) Hb[(size_t)r * DM + j] = f2bf(v); }
    }
}
__device__ __forceinline__ void d_rope(float* QKV, long gtid, long gstride) {
    const float kscale = 1.0f / sqrtf((float)HD);
    constexpr int NF = HD / 4;
    for (long idx = gtid; idx < (long)NTOK * 2 * NH * (HD / 2); idx += gstride) {
        const int i = (int)(idx % (HD / 2)); long t = idx / (HD / 2);
        const int h = (int)(t % NH); t /= NH; const int which = (int)(t % 2); const int r = (int)(t / 2);
        float* p = QKV + (size_t)r * INW + which * RW + h * HD + 2 * i;
        float t0 = p[0], t1 = p[1];
        if (r >= NCTX) {
            const int pos = (r - NCTX) % SQ, rowp = pos / GW, colp = pos % GW;
            const int f = i < NF ? i : i - NF;
            const float inv = powf(10000.0f, -(float)f / (float)NF);
            const float ang = (i < NF ? (float)rowp : (float)colp) * inv;
            const float cs = cosf(ang), sn = sinf(ang);
            const float a = t0 * cs - t1 * sn, b = t0 * sn + t1 * cs; t0 = a; t1 = b;
        }
        if (which == 1) { t0 *= kscale; t1 *= kscale; }
        p[0] = t0; p[1] = t1;
    }
}
__device__ __forceinline__ float logg(const In& I, int l, int dir, int h) { return -expf(I.ret_decay[(l * 2 + dir) * NH + h]); }
__device__ __forceinline__ void d_ret_kv(const In& I, int l, const float* QKV, float* KV, long gtid, long gstride) {
    for (long idx = gtid; idx < (long)2 * NB * NH * NCH * HD * HD; idx += gstride) {
        const int e = (int)(idx % HD); long t = idx / HD; const int d = (int)(t % HD); t /= HD; const int n = (int)(t % NCH); t /= NCH;
        const int h = (int)(t % NH); t /= NH; const int b = (int)(t % NB); const int dir = (int)(t / NB);
        const float lg = logg(I, l, dir, h); float acc = 0.f;
        for (int p = 0; p < RC; ++p) {
            const int row = row_of(b, n, p);
            const float w = expf(lg * (float)(dir == 0 ? RC - 1 - p : p));
            acc += w * QKV[(size_t)row * INW + RW + h * HD + d] * QKV[(size_t)row * INW + 2 * RW + h * HD + e];
        }
        KV[idx] = acc;
    }
}
__device__ __forceinline__ int chain_chunk(int dir, int step) { return dir == 0 ? step : (step < CC ? CC - 1 - step : NCH - 1 - (step - CC)); }
__device__ __forceinline__ void d_ret_scan(const In& I, int l, const float* KV, float* ST, long gtid, long gstride) {
    for (long idx = gtid; idx < (long)2 * NB * NH * HD * HD; idx += gstride) {
        const int de = (int)(idx % (HD * HD)); long t = idx / (HD * HD); const int h = (int)(t % NH); t /= NH; const int b = (int)(t % NB); const int dir = (int)(t / NB);
        const float dec = expf(logg(I, l, dir, h) * (float)RC); float s = 0.f;
        for (int step = 0; step < NCH; ++step) {
            const int n = chain_chunk(dir, step);
            const size_t o = ((((size_t)dir * NB + b) * NH + h) * NCH + n) * HD * HD + de;
            ST[o] = s; s = dec * s + KV[o];
        }
    }
}
__device__ __forceinline__ void d_ret_scores(const In& I, int l, const float* QKV, float* SC, long gtid, long gstride) {
    for (long idx = gtid; idx < (long)NTOK * NH * RC; idx += gstride) {
        const int j = (int)(idx % RC); long t = idx / RC; const int h = (int)(t % NH); const int r = (int)(t / NH);
        int b, n, p; bnp_of_row(r, b, n, p);
        const int rj = row_of(b, n, j);
        const float* q = QKV + (size_t)r * INW + h * HD; const float* k = QKV + (size_t)rj * INW + RW + h * HD;
        float dot = 0.f;
        for (int d = 0; d < HD; ++d) dot += q[d] * k[d];
        const float D = j <= p ? expf(logg(I, l, 0, h) * (float)(p - j)) : expf(logg(I, l, 1, h) * (float)(j - p));
        SC[idx] = dot * D;
    }
}
__device__ __forceinline__ void d_ret_out(const In& I, int l, const float* QKV, const float* SC, const float* ST, float* RO, long gtid, long gstride) {
    for (long idx = gtid; idx < (long)NTOK * NH * HD; idx += gstride) {
        const int e = (int)(idx % HD); long t = idx / HD; const int h = (int)(t % NH); const int r = (int)(t / NH);
        int b, n, p; bnp_of_row(r, b, n, p);
        float acc = 0.f;
        const float* sc = SC + ((size_t)r * NH + h) * RC;
        for (int j = 0; j < RC; ++j) acc += sc[j] * QKV[(size_t)row_of(b, n, j) * INW + 2 * RW + h * HD + e];
        const float qwf = expf(logg(I, l, 0, h) * (float)(p + 1)), qwb = expf(logg(I, l, 1, h) * (float)(RC - p));
        const float* sf = ST + ((((size_t)0 * NB + b) * NH + h) * NCH + n) * HD * HD + e;
        const float* sb = ST + ((((size_t)1 * NB + b) * NH + h) * NCH + n) * HD * HD + e;
        const float* q = QKV + (size_t)r * INW + h * HD;
        for (int d = 0; d < HD; ++d) acc += q[d] * (qwf * sf[(size_t)d * HD] + qwb * sb[(size_t)d * HD]);
        RO[(size_t)r * RW + h * HD + e] = acc;
    }
}
__device__ __forceinline__ void d_ret_norm(const float* RO, const float* QKV, float* MIX, bf16_t* MIXb, long gtid, long gstride) {
    for (long idx = gtid; idx < (long)NTOK * NH; idx += gstride) {
        const int h = (int)(idx % NH), r = (int)(idx / NH);
        const float* o = RO + (size_t)r * RW + h * HD; float mu = 0.f;
        for (int e = 0; e < HD; ++e) mu += o[e];
        mu /= HD; float var = 0.f;
        for (int e = 0; e < HD; ++e) var += (o[e] - mu) * (o[e] - mu);
        var /= HD; const float rs = 1.0f / sqrtf(var + GN_EPS);
        for (int e = 0; e < HD; ++e) { const float v = (o[e] - mu) * rs * silu_f(QKV[(size_t)r * INW + 3 * RW + h * HD + e]); MIX[(size_t)r * DM + h * HD + e] = v; if (MIXb) MIXb[(size_t)r * DM + h * HD + e] = f2bf(v); }
    }
}
__device__ __forceinline__ void d_s5_disc(const In& I, int l, float* ABAR, float* BBAR, long gtid, long gstride) {
    for (long idx = gtid; idx < (long)2 * NG * SP; idx += gstride) {
        const int p = (int)(idx % SP); long t = idx / SP; const int g = (int)(t % NG); const int dir = (int)(t / NG);
        const size_t ia = (((size_t)l * 2 + dir) * NG + g) * SP + p;
        const float are = I.s5_a_re[ia], aim = I.s5_a_im[ia], dt = expf(I.s5_log_step[((size_t)l * 2 + dir) * NG + g]);
        const float mag = expf(are * dt), ang = aim * dt;
        const float abr = mag * cosf(ang), abi = mag * sinf(ang);
        const float den = are * are + aim * aim, nr = abr - 1.0f;
        const float fr = (nr * are + abi * aim) / den, fi = (abi * are - nr * aim) / den;
        ABAR[idx * 2] = abr; ABAR[idx * 2 + 1] = abi;
#pragma unroll
        for (int c = 0; c < SG; ++c) {
            const float br = I.s5_b_re[ia * SG + c], bi = I.s5_b_im[ia * SG + c];
            BBAR[(idx * SG + c) * 2] = fr * br - fi * bi; BBAR[(idx * SG + c) * 2 + 1] = fr * bi + fi * br;
        }
    }
}
__device__ __forceinline__ int chain_row(int dir, int b, int step) {
    if (dir == 0) return step < CTXL ? b * CTXL + step : NCTX + b * SQ + (step - CTXL);
    return step < CTXL ? b * CTXL + (CTXL - 1 - step) : NCTX + b * SQ + (SQ - 1 - (step - CTXL));
}
__device__ __forceinline__ void d_s5_scan(int dir, const bf16_t* QKV, const float* ABAR, const float* BBAR, float* HS, long gtid, long gstride) {
    for (long idx = gtid; idx < (long)NB * NG * SP; idx += gstride) {
        const int p = (int)(idx % SP); long t = idx / SP; const int g = (int)(t % NG); const int b = (int)(t / NG);
        const size_t ip = ((size_t)dir * NG + g) * SP + p;
        const float ar = ABAR[ip * 2], ai = ABAR[ip * 2 + 1];
        float br[SG], bi[SG];
#pragma unroll
        for (int c = 0; c < SG; ++c) { br[c] = BBAR[(ip * SG + c) * 2]; bi[c] = BBAR[(ip * SG + c) * 2 + 1]; }
        float hr = 0.f, hi = 0.f;
        for (int step = 0; step < CTXL + SQ; ++step) {
            const int row = chain_row(dir, b, step);
            const bf16_t* u = QKV + (size_t)row * INW + 4 * RW + g * SG;
            float ur = 0.f, ui = 0.f;
#pragma unroll
            for (int c = 0; c < SG; ++c) { const float uv = nbf2f(u[c]); ur += br[c] * uv; ui += bi[c] * uv; }
            const float nr = ar * hr - ai * hi + ur, ni = ar * hi + ai * hr + ui; hr = nr; hi = ni;
            float* o = HS + (((size_t)row * NG + g) * SP + p) * 2; o[0] = hr; o[1] = hi;
        }
    }
}
__device__ __forceinline__ void d_s5_y(const In& I, int l, int dir, const bf16_t* QKV, const float* HS, float* Z, bf16_t* Zb, long gtid, long gstride) {
    for (long idx = gtid; idx < (long)NTOK * SW; idx += gstride) {
        const int ch = (int)(idx % SW), row = (int)(idx / SW), g = ch / SG, c = ch % SG;
        float y = dir == 0 ? I.s5_d[((size_t)l * NG + g) * SG + c] * nbf2f(QKV[(size_t)row * INW + 4 * RW + ch]) : Z[idx];
        const float* cr = I.s5_c_re + ((((size_t)l * 2 + dir) * NG + g) * SG + c) * SP;
        const float* ci = I.s5_c_im + ((((size_t)l * 2 + dir) * NG + g) * SG + c) * SP;
        const float* h = HS + ((size_t)row * NG + g) * SP * 2;
        for (int p = 0; p < SP; ++p) y += cr[p] * h[2 * p] - ci[p] * h[2 * p + 1];
        if (dir == 1) { y = gelu_tanh_f(y); if (Zb) Zb[idx] = f2bf(y); }
        Z[idx] = y;
    }
}
__device__ __forceinline__ void d_glu_ep(const In& I, int l, const float* Z, const float* T, float* MIX, bf16_t* MIXb, long gtid, long gstride) {
    for (long idx = gtid; idx < (long)NTOK * SW; idx += gstride) {
        const int j = (int)(idx % SW), r = (int)(idx / SW);
        const float v = Z[idx] * sigmoid_f(T[idx] + I.s5_glu_b[(size_t)l * SW + j]); MIX[(size_t)r * DM + RW + j] = v; if (MIXb) MIXb[(size_t)r * DM + RW + j] = f2bf(v);
    }
}
__device__ __forceinline__ void d_resid(float* X, const float* T2, const float* MOD, int l, int m, long gtid, long gstride) {
    for (long idx = gtid; idx < (long)NTOK * DM; idx += gstride) {
        const int j = (int)(idx % DM), r = (int)(idx / DM);
        X[idx] += MODV(MOD, l, cond_of_row(r), m)[j] * T2[idx];
    }
}
__device__ __forceinline__ void d_route(const In& I, int l, const float* H2, int* TE, int* TP, float* TG, int* CNT, int row_lo, long gtid, long gstride) {
    for (long r = row_lo + gtid; r < NTOK; r += gstride) {
        float gl[NEG], el[NE];
#pragma unroll
        for (int j = 0; j < NEG; ++j) gl[j] = 0.f;
#pragma unroll
        for (int j = 0; j < NE; ++j) el[j] = 0.f;
        const float* h = H2 + (size_t)r * DM;
        const float* gw = I.router_grp_w + (size_t)l * DM * NEG; const float* ew = I.router_exp_w + (size_t)l * DM * NE;
        for (int k = 0; k < DM; ++k) {
            const float hv = h[k];
#pragma unroll
            for (int j = 0; j < NEG; ++j) gl[j] += hv * gw[(size_t)k * NEG + j];
#pragma unroll
            for (int j = 0; j < NE; ++j) el[j] += hv * ew[(size_t)k * NE + j];
        }
#pragma unroll
        for (int j = 0; j < NEG; ++j) gl[j] += I.router_grp_b[l * NEG + j];
#pragma unroll
        for (int j = 0; j < NE; ++j) el[j] += I.router_exp_b[l * NE + j];
        int grp = 0; float gmax = gl[0];
#pragma unroll
        for (int j = 1; j < NEG; ++j) if (gl[j] > gmax) { gmax = gl[j]; grp = j; }
        float den = 0.f;
#pragma unroll
        for (int j = 0; j < NEG; ++j) den += expf(gl[j] - gmax);
        const float gprob = 1.0f / den;
        float sel[EPG];
#pragma unroll
        for (int j = 0; j < EPG; ++j) { float v = el[j];
#pragma unroll
            for (int g2 = 1; g2 < NEG; ++g2) v = (grp == g2) ? el[g2 * EPG + j] : v;
            sel[j] = v; }
        int i0 = 0; float l0 = sel[0];
#pragma unroll
        for (int j = 1; j < EPG; ++j) if (sel[j] > l0) { l0 = sel[j]; i0 = j; }
        int i1 = -1; float l1 = -3.0e38f;
#pragma unroll
        for (int j = 0; j < EPG; ++j) if (j != i0 && sel[j] > l1) { l1 = sel[j]; i1 = j; }
        const float e1 = expf(l1 - l0), g0 = gprob / (1.0f + e1), g1 = gprob * e1 / (1.0f + e1);
        const int ex0 = grp * EPG + i0, ex1 = grp * EPG + i1;
        TE[r * 2] = ex0; TE[r * 2 + 1] = ex1; TG[r * 2] = g0; TG[r * 2 + 1] = g1;
        TP[r * 2] = atomicAdd(&CNT[ex0], 1); TP[r * 2 + 1] = atomicAdd(&CNT[ex1], 1);
    }
}
__device__ __forceinline__ void d_moe_offsets(const int* CNT, int* META, int tile, long gtid) {
    if (gtid == 0) {
        int off = 0, nt = 0;
        for (int e = 0; e < NE; ++e) {
            META[1 + e] = off; const int t = (CNT[e] + tile - 1) / tile;
            for (int k = 0; k < t; ++k) META[64 + nt + k] = e;
            nt += t; off += t * tile;
        }
        META[0] = nt;
    }
}
__device__ __forceinline__ void d_moe_scatter(const int* TE, const int* TP, const int* META, int* SLOT_TOK, int* TS, int row_lo, long gtid, long gstride) {
    for (long idx = (long)row_lo * 2 + gtid; idx < (long)NTOK * 2; idx += gstride) {
        const int slot = META[1 + TE[idx]] + TP[idx];
        SLOT_TOK[slot] = (int)(idx / 2); TS[idx] = slot;
    }
}
__device__ __forceinline__ void d_moe_gather(const float* H2, const int* SLOT_TOK, bf16_t* Xg, const int* META, int tile, long gtid, long gstride) {
    const long nrows = (long)META[0] * tile;
    for (long idx = gtid; idx < nrows * (DM / 4); idx += gstride) {
        const int j = (int)(idx % (DM / 4)) * 4; const long s = idx / (DM / 4); const int tok = SLOT_TOK[s];
        for (int q = 0; q < 4; ++q) Xg[s * DM + j + q] = tok >= 0 ? f2bf(H2[(size_t)tok * DM + j + q]) : (bf16_t)0;
    }
}
__device__ __forceinline__ void d_moe_act(const float* GU, float* ACT, bf16_t* ACTb, const int* META, int tile, long gtid, long gstride) {
    const long nrows = (long)META[0] * tile;
    for (long idx = gtid; idx < nrows * EFF; idx += gstride) {
        const int j = (int)(idx % EFF); const long s = idx / EFF;
        const float v = silu_f(GU[s * 2 * EFF + j]) * GU[s * 2 * EFF + EFF + j]; if (ACT) ACT[idx] = v; if (ACTb) ACTb[idx] = f2bf(v);
    }
}
__device__ __forceinline__ void d_moe_combine(float* X, const float* Y, const int* TS, const float* TG, const float* MOD, int l, int row_lo, long gtid, long gstride) {
    for (long idx = (long)row_lo * DM + gtid; idx < (long)NTOK * DM; idx += gstride) {
        const int j = (int)(idx % DM), r = (int)(idx / DM);
        const float v = TG[r * 2] * Y[(size_t)TS[r * 2] * DM + j] + TG[r * 2 + 1] * Y[(size_t)TS[r * 2 + 1] * DM + j];
        X[idx] += MODV(MOD, l, cond_of_row(r), 5)[j] * v;
    }
}
__device__ __forceinline__ void d_final(const In& I, const float* X, float* out, long gtid, long gstride) {
    for (long r = NCTX + gtid; r < NTOK; r += gstride) {
        const float* xr = X + (size_t)r * DM; float ss = 0.f;
        for (int j = 0; j < DM; ++j) ss += xr[j] * xr[j];
        const float rs = 1.0f / sqrtf(ss / DM + NORM_EPS);
        for (int j = 0; j < DM; ++j) out[(size_t)(r - NCTX) * DM + j] = xr[j] * rs * I.final_g[j];
    }
}

struct GemmArgs { const float* A; int lda; const int* gather; const float* B; int ldb; size_t strideB; float* C; int ldc; int M, N, K; const int* META; };
#ifdef HOST_EMU
__device__ __forceinline__ void d_gemm(const GemmArgs& g, void* smem, int bid, int nblk) {
    (void)smem; (void)bid; (void)nblk;
    const int M = g.META ? g.META[0] * MOE_TILE : g.M;
    for (int m = 0; m < M; ++m) {
        const float* B = g.B + (g.META ? (size_t)g.META[64 + m / MOE_TILE] * g.strideB : 0);
        const int src = g.gather ? g.gather[m] : m;
        for (int n = 0; n < g.N; ++n) { double acc = 0;
            if (src >= 0) for (int k = 0; k < g.K; ++k) acc += (double)g.A[(size_t)src * g.lda + k] * B[(size_t)k * g.ldb + n];
            g.C[(size_t)m * g.ldc + n] = (float)acc; }
    }
}
#else
__device__ __forceinline__ void d_gemm(const GemmArgs& g, void* smem, int bid, int nblk) {
    float* As = (float*)smem;
    float* Bs = As + 16 * 132;
    const int tid = threadIdx.x, tx = tid % 16, ty = tid / 16;
    const int M = g.META ? g.META[0] * MOE_TILE : g.M;
    const int ntm = (M + 127) / 128, ntn = (g.N + 63) / 64;
    for (int tile = bid; tile < ntm * ntn; tile += nblk) {
        const int tm = tile / ntn, tn = tile % ntn, m0 = tm * 128, n0 = tn * 64;
        const float* B = g.B + (g.META ? (size_t)g.META[64 + tm] * g.strideB : 0);
        float acc[4][4];
        for (int i = 0; i < 4; ++i) for (int j = 0; j < 4; ++j) acc[i][j] = 0.f;
        for (int k0 = 0; k0 < g.K; k0 += 16) {
            for (int q = tid; q < 128 * 16; q += 512) { const int mm = q / 16, kk = q % 16; const int m = m0 + mm; float v = 0.f;
                if (m < M && k0 + kk < g.K) { const int src = g.gather ? g.gather[m] : m; if (src >= 0) v = g.A[(size_t)src * g.lda + k0 + kk]; }
                As[kk * 132 + mm] = v; }
            for (int q = tid; q < 16 * 64; q += 512) { const int kk = q / 64, nn = q % 64; float v = 0.f;
                if (k0 + kk < g.K && n0 + nn < g.N) v = B[(size_t)(k0 + kk) * g.ldb + n0 + nn];
                Bs[kk * 64 + nn] = v; }
            __syncthreads();
#pragma unroll
            for (int kk = 0; kk < 16; ++kk) { float a[4], b[4];
#pragma unroll
                for (int i = 0; i < 4; ++i) a[i] = As[kk * 132 + ty * 4 + i];
#pragma unroll
                for (int j = 0; j < 4; ++j) b[j] = Bs[kk * 64 + tx * 4 + j];
#pragma unroll
                for (int i = 0; i < 4; ++i)
#pragma unroll
                    for (int j = 0; j < 4; ++j) acc[i][j] += a[i] * b[j]; }
            __syncthreads();
        }
        for (int i = 0; i < 4; ++i) { const int m = m0 + ty * 4 + i; if (m >= M) continue;
            for (int j = 0; j < 4; ++j) { const int n = n0 + tx * 4 + j; if (n < g.N) g.C[(size_t)m * g.ldc + n] = acc[i][j]; } }
    }
}
#endif
}

#ifndef PR_GEMM
#define PR_GEMM 1
#endif
#ifndef PR_WCVT
#define PR_WCVT 1
#endif
#ifndef PR_RET
#define PR_RET 1
#endif
#ifndef PR_S5
#define PR_S5 1
#endif
#ifndef PR_ROUTE
#define PR_ROUTE 1
#endif
#ifndef PR_NORM
#define PR_NORM 1
#endif
#ifndef PR_BAR
#define PR_BAR 0
#endif
#ifndef PR_PREP
#define PR_PREP 1
#endif
#ifndef PR_FIN
#define PR_FIN 1
#endif
namespace nv {
constexpr size_t al256(size_t x) { return (x + 255) & ~(size_t)255; }
constexpr size_t cmax(size_t a, size_t b) { return a > b ? a : b; }
constexpr int NRLc = NEG + NE;
constexpr size_t OFF_CTL = 0, SZ_CTL = 4096;
constexpr size_t OFF_BAR = OFF_CTL + SZ_CTL, SZ_BAR = 16384;
constexpr size_t OFF_MOD = OFF_BAR + SZ_BAR, SZ_MOD = al256((size_t)NL * NCOND * NMOD * DM * 4);
constexpr size_t OFF_PART = OFF_MOD + SZ_MOD, SZ_PART = al256((size_t)(DM / 128) * NL * NCOND * NMOD * DM * 4);
constexpr size_t OFF_RWT = OFF_PART + SZ_PART, SZ_RWT = al256((size_t)NL * NRLc * DM * 4);
constexpr size_t OFF_LAMP = OFF_RWT + SZ_RWT, SZ_LAMP = al256((size_t)NL * 2 * NG * 17 * SP * 2 * 4);
constexpr size_t OFF_BBC = OFF_LAMP + SZ_LAMP, SZ_BBC = al256((size_t)NL * 2 * NG * SP * SG * 2 * 4);
constexpr size_t OFF_KTAU = OFF_BBC + SZ_BBC, SZ_KTAU = al256((size_t)NL * 2 * NG * 16 * SG * SG * 4);
constexpr size_t OFF_MINT = OFF_KTAU + SZ_KTAU, SZ_MINT = al256((size_t)NL * 2 * NG * 128 * 256 * 2);
constexpr size_t OFF_MOUT = OFF_MINT + SZ_MINT, SZ_MOUT = SZ_MINT;
constexpr size_t OFF_KTOT = OFF_MOUT + SZ_MOUT, SZ_KTOT = al256((size_t)NL * NG * 256 * 256 * 2);
constexpr size_t OFF_TE = OFF_KTOT + SZ_KTOT, SZ_T2I = al256((size_t)NTOK * 2 * 4);
constexpr size_t OFF_TP = OFF_TE + SZ_T2I, OFF_TG = OFF_TP + SZ_T2I, OFF_TS = OFF_TG + SZ_T2I, OFF_RSTD = OFF_TS + SZ_T2I;
constexpr size_t OFF_HIST = OFF_RSTD + SZ_T2I, SZ_HIST = al256((size_t)1024 * NE * 4);
constexpr size_t OFF_X = OFF_HIST + SZ_HIST, SZ_X = al256((size_t)NTOK * DM * 4);
constexpr size_t OFF_QKVB = OFF_X + SZ_X, SZ_QKVB = al256((size_t)NTOK * INW * 2);
constexpr size_t OFF_ROPE = OFF_QKVB + SZ_QKVB, SZ_ROPE = al256((size_t)SQ * (HD / 2) * 2 * 4);
constexpr size_t OFF_MIXB = OFF_ROPE + SZ_ROPE, SZ_MIXB = al256((size_t)NTOK * DM * 2);
constexpr size_t OFF_ZB = OFF_MIXB + SZ_MIXB, SZ_ZB = al256((size_t)NTOK * SW * 2);
constexpr size_t OFF_HB = OFF_ZB + SZ_ZB, SZ_HB = SZ_MIXB;
constexpr size_t OFF_WIN = OFF_HB + SZ_HB, SZ_WIN = al256((size_t)INW * DM * 2);
constexpr size_t OFF_WGLU = OFF_WIN + SZ_WIN, SZ_WGLU = al256((size_t)SW * SW * 2);
constexpr size_t OFF_WOUT = OFF_WGLU + SZ_WGLU, SZ_WOUT = al256((size_t)DM * DM * 2);
constexpr size_t OFF_WGU = OFF_WOUT + SZ_WOUT, SZ_WGU = al256((size_t)NE * 2 * EFF * DM * 2);
constexpr size_t OFF_WD = OFF_WGU + SZ_WGU, SZ_WD = al256((size_t)NE * DM * EFF * 2);
constexpr size_t OFF_BIG = OFF_WD + SZ_WD;
constexpr size_t SZ_KV = al256((size_t)2 * NB * NH * NCH * HD * HD * 4);
constexpr size_t OFF_KVT = OFF_BIG, OFF_STT = OFF_KVT + SZ_KV, SZ_STT = al256((size_t)2 * NB * NH * NCH * HD * HD * 2);
constexpr size_t OFF_XG = OFF_BIG, SZ_XG = al256((size_t)MOE_CAP * DM * 2);
constexpr size_t OFF_ACTB = OFF_XG + SZ_XG, SZ_ACTB = al256((size_t)MOE_CAP * EFF * 2);
constexpr size_t OFF_YB = OFF_ACTB + SZ_ACTB, SZ_YB = al256((size_t)MOE_CAP * DM * 2);
constexpr size_t WS_NEED = cmax(OFF_STT + SZ_STT, OFF_YB + SZ_YB);

struct Params { In I; float* out; unsigned char* ws; };
}

#ifndef HOST_EMU
#ifdef HOST_EMU2
#define LAS
#endif
#define XB_TMO      128
#define XB_XCNT(j)  (256  + 64 * (j))
#define XB_XSUB(j)  (1280 + 64 * (j))
#define XB_XGEN(j)  (2304 + 64 * (j))
#define XB_TOP      3328
#define XB_TOPGEN   3392
#define XCD_BAR_WORDS 3456
#define XB_SPIN_CAP (1u << 18)
#ifndef LAS
#define LAS __attribute__((address_space(3)))
#endif

__device__ __forceinline__ unsigned xb_ld(unsigned* p)              { return __hip_atomic_load(p, __ATOMIC_RELAXED, __HIP_MEMORY_SCOPE_AGENT); }
__device__ __forceinline__ unsigned xb_add(unsigned* p, unsigned v) { return __hip_atomic_fetch_add(p, v, __ATOMIC_RELAXED, __HIP_MEMORY_SCOPE_AGENT); }
__device__ __forceinline__ unsigned xb_xcc_id() { return (unsigned)__builtin_amdgcn_s_getreg((3 << 11) | 20) & 0xFu; }
#define XB_SPIN(cond, bar) do { unsigned _sp = 0; while (cond) { __builtin_amdgcn_s_sleep(1); \
    if ((++_sp & 255u) == 0u) { if (xb_ld(&(bar)[XB_TMO])) break; if (_sp > XB_SPIN_CAP) { atomicAdd(&(bar)[XB_TMO], 1u); break; } } } } while (0)

struct XcdBarrier {
    unsigned* bar; unsigned x;
    volatile LAS unsigned* st;
};

__device__ __forceinline__ XcdBarrier xcd_barrier_post(unsigned* bar, volatile LAS unsigned* st) {
    XcdBarrier b; b.bar = bar; b.x = xb_xcc_id(); b.st = st;
    if (threadIdx.x == 0) (void)xb_add(&bar[XB_XCNT(b.x)], 1u);
    return b;
}
__device__ __forceinline__ void xcd_barrier_complete(unsigned* bar, unsigned x, unsigned& nloc, unsigned& nx) {
    const unsigned G = gridDim.x * gridDim.y * gridDim.z;
    unsigned sum, cnt, mine, sp = 0u;
    for (;;) {
        sum = 0u; cnt = 0u; mine = 0u;
#pragma unroll
        for (unsigned j = 0; j < 16; ++j) { const unsigned c = xb_ld(&bar[XB_XCNT(j)]); sum += c; cnt += (c > 0u) ? 1u : 0u; mine = (j == x) ? c : mine; }
        if (sum == G) break;
        __builtin_amdgcn_s_sleep(1);
        if ((++sp & 255u) == 0u) { if (xb_ld(&bar[XB_TMO])) break; if (sp > XB_SPIN_CAP) { atomicAdd(&bar[XB_TMO], 1u); break; } }
    }
    nloc = mine > 0u ? mine : 1u; nx = cnt > 0u ? cnt : 1u;
}

__device__ __forceinline__ void xcd_barrier(const XcdBarrier& b) {
    asm volatile("s_waitcnt vmcnt(0)" ::: "memory");
    __syncthreads();
    if (threadIdx.x == 0) {
        unsigned* bar = b.bar;
        __builtin_amdgcn_s_waitcnt(0);
        unsigned nloc = b.st[0], nx = b.st[1];
        if (nloc == 0u) { xcd_barrier_complete(bar, b.x, nloc, nx); b.st[0] = nloc; b.st[1] = nx; }
        const unsigned old = xb_add(&bar[XB_XSUB(b.x)], 1u);
        const unsigned gen = old / nloc;
        if (old + 1u == (gen + 1u) * nloc) {
            __builtin_amdgcn_fence(__ATOMIC_RELEASE, "agent");
            asm volatile("s_waitcnt vmcnt(0)" ::: "memory");
            const unsigned og = xb_add(&bar[XB_TOP], 1u);
            const unsigned tg = og / nx;
            if (og + 1u == (tg + 1u) * nx) xb_add(&bar[XB_TOPGEN], 1u);
            else XB_SPIN(xb_ld(&bar[XB_TOPGEN]) == tg, bar);
            __builtin_amdgcn_fence(__ATOMIC_ACQUIRE, "agent");
            xb_add(&bar[XB_XGEN(b.x)], 1u);
            asm volatile("s_waitcnt vmcnt(0)" ::: "memory");
        } else {
            XB_SPIN(xb_ld(&bar[XB_XGEN(b.x)]) == gen, bar);
            __builtin_amdgcn_fence(__ATOMIC_ACQUIRE, "agent");
            asm volatile("s_waitcnt vmcnt(0)" ::: "memory");
        }
    }
    __syncthreads();
}


#ifndef HOST_EMU2
#define GAS __attribute__((address_space(1)))
#else
#define GAS
#endif
typedef unsigned short bf16;
typedef unsigned v4u __attribute__((ext_vector_type(4)));
#ifdef HOST_EMU2
#define LDS_WAIT() do { emu::wave_sync(); emu::set_ids(); } while (0)
#else
#define LDS_WAIT() asm volatile("s_waitcnt lgkmcnt(0)" ::: "memory")
#endif
__device__ __forceinline__ unsigned f2bf_u(float f) { unsigned u = __builtin_bit_cast(unsigned, f); return (u + 0x7fffu + ((u >> 16) & 1u)) >> 16; }
__device__ __forceinline__ unsigned pk2(float lo, float hi) { return f2bf_u(lo) | (f2bf_u(hi) << 16); }
namespace pg8 {
#define PG8_LAS __attribute__((address_space(3)))
typedef unsigned short bf16_t;
typedef short bf16x8 __attribute__((ext_vector_type(8)));
typedef float f32x4 __attribute__((ext_vector_type(4)));
typedef unsigned u32x4 __attribute__((ext_vector_type(4)));
constexpr int BM = 256, BK = 64, HALF = 128, HTB = HALF * BK * 2  , STAGE_BYTES = 8 * HTB, NXCD = 8, WGM = 8;

__host__ __device__ __forceinline__ int lds_byte(int r, int c) { const int st = (r >> 4) * 2 + (c >> 5), rr = r & 15, cc = c & 31, ob = rr * 64 + cc * 2; return st * 1024 + (ob ^ (((ob >> 9) & 1) << 5)); }
__host__ __device__ __forceinline__ void stage_rc(int b, int& R, int& C) { const int st = b / 1024, sb = b % 1024, swz = sb ^ (((sb >> 9) & 1) << 5); R = (st >> 1) * 16 + swz / 64; C = (st & 1) * 32 + (swz % 64) / 2; }
__host__ __device__ __forceinline__ int perm32(int rho) { const int n = rho >> 4, i = rho & 15; return 8 * (i >> 2) + 4 * n + (i & 3); }

struct Unit { int pm, pn, half; };
struct Gemm { const bf16_t* A; const bf16_t* Bt; int M, N, K; };

struct StaticOrder {
    int nM, nN, nwg, G, c, rep;
    __host__ __device__ void init(int M, int N, int G_, int c_) { nM = M / BM; nN = N / BM; nwg = nM * nN; G = G_; c = c_; rep = PR_GEMM; }
    __host__ __device__ bool next(int i, Unit& u) const {
        long L = (long)i * G + c; int part = -1;
        if (rep == 1) { const int nfull = (nwg / G) * G, r = nwg - nfull;
            if (r > 0 && 2 * r <= G && L >= nfull) { if (L >= nfull + 2 * r) return false; part = (int)((L - nfull) & 1); L = nfull + (L - nfull) / 2; } }
        if (L >= (long)nwg * rep) return false;
        int wgid = (int)(L % nwg); { const int q = nwg / NXCD, r = nwg % NXCD, xcd = wgid % NXCD, off = wgid / NXCD; wgid = (xcd < r ? xcd * (q + 1) : r * (q + 1) + (xcd - r) * q) + off; }
        const int nig = WGM * nN, gid = wgid / nig, fm = gid * WGM, gsz = (nM - fm) < WGM ? (nM - fm) : WGM;
        u.pm = 2 * (fm + ((wgid % nig) % gsz)) + (part > 0 ? 1 : 0); u.pn = (wgid % nig) / gsz; u.half = part >= 0 ? 1 : 0; return true;
    }
    __device__ __forceinline__ void a_ready(const Unit&) const {}
    __device__ __forceinline__ void done(const Unit&) const {}
};

#ifdef HOST_EMU2
__device__ __forceinline__ unsigned cvt_pk_bf16(float lo, float hi) { return pk2(lo, hi); }
#else
__device__ __forceinline__ unsigned cvt_pk_bf16(float lo, float hi) { unsigned r; asm volatile("v_cvt_pk_bf16_f32 %0, %1, %2" : "=v"(r) : "v"(lo), "v"(hi)); return r; }
#endif
template <class Epi, class Sched, bool ALIGN_EPI = false, bool SP2 = false>
__device__ __forceinline__ void gemm_phase(PG8_LAS unsigned char* lds, const Gemm g, const Sched& S, const Epi& E, const int tid) {
    const int wid = __builtin_amdgcn_readfirstlane(tid >> 6), lane = tid & 63, wr = wid >> 2, wc = wid & 3, fr = lane & 15, fq = lane >> 4;
    const int K = g.K, nt = K / BK;
    unsigned voffA[2], voffB[2];
#pragma unroll
    for (int i = 0; i < 2; ++i) { int R, C; stage_rc(tid * 16 + i * 8192, R, C); const int Rb = Epi::PERM ? ((R & ~31) + perm32(R & 31)) : R;
        voffA[i] = (unsigned)(R * K + C) * 2u; voffB[i] = (unsigned)(Rb * K + C) * 2u; }
    const size_t kstep = (size_t)(BK * 2);
    const size_t hstep = (size_t)HALF * K * 2;
    const size_t tstep = 2 * hstep;
    const unsigned ldsw = (unsigned)wid * 1024u;
    const int aoff = lds_byte(wr * 64 + fr, fq * 8), boff = lds_byte(wc * 32 + fr, fq * 8);
#define PG8_SA(b, h) (((b) * 2 + (h)) * HTB)
#define PG8_SB(b, h) ((4 + (b) * 2 + (h)) * HTB)
#define PG8_STAGE(bufoff, gbase, voff) do { _Pragma("unroll") for (int _i = 0; _i < 2; ++_i) \
        __builtin_amdgcn_global_load_lds((const unsigned*)((const char*)(gbase) + (voff)[_i]), (PG8_LAS unsigned*)(lds + (bufoff) + ldsw + _i * 8192), 16, 0, 0); } while (0)
#define PG8_LDA(dst, b, h) do { _Pragma("unroll") for (int m = 0; m < 4; ++m) _Pragma("unroll") for (int k = 0; k < 2; ++k) dst[m][k] = *(const PG8_LAS bf16x8*)(lds + PG8_SA(b, h) + aoff + m * 2048 + k * 1024); } while (0)
#define PG8_LDB(dst, b, h) do { _Pragma("unroll") for (int n = 0; n < 2; ++n) _Pragma("unroll") for (int k = 0; k < 2; ++k) dst[n][k] = *(const PG8_LAS bf16x8*)(lds + PG8_SB(b, h) + boff + n * 2048 + k * 1024); } while (0)
#define PG8_MMA(ai, bj, At, Bt) do { __builtin_amdgcn_s_setprio(1); _Pragma("unroll") for (int m = 0; m < 4; ++m) _Pragma("unroll") for (int n = 0; n < 2; ++n) _Pragma("unroll") for (int k = 0; k < 2; ++k) \
        acc[ai][bj][m][n] = __builtin_amdgcn_mfma_f32_16x16x32_bf16(Bt[n][k], At[m][k], acc[ai][bj][m][n], 0, 0, 0); __builtin_amdgcn_s_setprio(0); } while (0)
#define PG8_WAIT_V(n) asm volatile("s_waitcnt vmcnt(" #n ")" ::: "memory")
#define PG8_WAIT_L(n) asm volatile("s_waitcnt lgkmcnt(" #n ")" ::: "memory")
#define PG8_BAR __builtin_amdgcn_s_barrier()
#define PG8_SCHED __builtin_amdgcn_sched_barrier(0)
    Unit cur, nxt; int ui = 0;
    if (!S.next(0, cur)) return;
    f32x4 acc[2][2][4][2];
#pragma unroll
    for (int a = 0; a < 2; ++a)
#pragma unroll
        for (int b = 0; b < 2; ++b)
#pragma unroll
            for (int m = 0; m < 4; ++m)
#pragma unroll
                for (int n = 0; n < 2; ++n) acc[a][b][m][n] = (f32x4){0.f, 0.f, 0.f, 0.f};
    bf16x8 At[4][2], B0[2][2], B1[2][2];
    const char* cA = (const char*)g.A + (size_t)cur.pm * hstep; const char* cB = (const char*)g.Bt + (size_t)cur.pn * tstep;
    S.a_ready(cur);
    if constexpr (SP2) {
        PG8_STAGE(PG8_SB(0, 0), cB, voffB); PG8_STAGE(PG8_SB(0, 1), cB + hstep, voffB); PG8_STAGE(PG8_SA(0, 0), cA, voffA); PG8_STAGE(PG8_SA(0, 1), cA + hstep, voffA);
        if (wr == 1) PG8_BAR;
        PG8_WAIT_V(2); PG8_BAR;
        PG8_STAGE(PG8_SB(1, 0), cB + kstep, voffB); PG8_STAGE(PG8_SA(1, 0), cA + kstep, voffA); PG8_STAGE(PG8_SB(1, 1), cB + hstep + kstep, voffB);
        PG8_WAIT_V(6); PG8_BAR;
    } else {
        PG8_STAGE(PG8_SB(0, 0), cB, voffB); PG8_STAGE(PG8_SA(0, 0), cA, voffA); PG8_STAGE(PG8_SB(0, 1), cB + hstep, voffB); PG8_STAGE(PG8_SA(0, 1), cA + hstep, voffA);
        if (wr == 1) PG8_BAR;
        PG8_WAIT_V(4); PG8_BAR;
        PG8_STAGE(PG8_SB(1, 0), cB + kstep, voffB); PG8_STAGE(PG8_SA(1, 0), cA + kstep, voffA); PG8_STAGE(PG8_SB(1, 1), cB + hstep + kstep, voffB);
        PG8_WAIT_V(6); PG8_BAR;
    }
    for (;;) {
        const bool has_next = S.next(ui + 1, nxt);
        const char* nA = has_next ? (const char*)g.A + (size_t)nxt.pm * hstep : cA; const char* nB = has_next ? (const char*)g.Bt + (size_t)nxt.pn * tstep : cB;
        for (int t = 0; t < nt; t += 2) {
            const bool last = (t == nt - 2);
            const char* a1 = cA + (size_t)(t + 1) * kstep;
            const char* a2 = last ? nA : cA + (size_t)(t + 2) * kstep; const char* b2 = last ? nB : cB + (size_t)(t + 2) * kstep;
            const char* a3 = a2 + kstep; const char* b3 = b2 + kstep;
            if (last && has_next) S.a_ready(nxt);
            if constexpr (SP2) {
            PG8_LDB(B0, 0, 0); PG8_LDB(B1, 0, 1); PG8_SCHED; PG8_LDA(At, 0, 0); PG8_STAGE(PG8_SA(1, 1), a1 + hstep, voffA);
            PG8_WAIT_V(8); PG8_WAIT_L(0); PG8_BAR; PG8_MMA(0, 0, At, B0); PG8_MMA(0, 1, At, B1); PG8_BAR; PG8_SCHED;
            PG8_LDA(At, 0, 1); PG8_STAGE(PG8_SB(0, 0), b2, voffB); PG8_STAGE(PG8_SB(0, 1), b2 + hstep, voffB); PG8_STAGE(PG8_SA(0, 0), a2, voffA);
            PG8_WAIT_V(8); PG8_WAIT_L(0); PG8_BAR; if (!cur.half) { PG8_MMA(1, 0, At, B0); PG8_MMA(1, 1, At, B1); } PG8_BAR; PG8_SCHED;
            PG8_LDB(B0, 1, 0); PG8_LDB(B1, 1, 1); PG8_SCHED; PG8_LDA(At, 1, 0); PG8_STAGE(PG8_SA(0, 1), a2 + hstep, voffA);
            PG8_WAIT_V(8); PG8_WAIT_L(0); PG8_BAR; PG8_MMA(0, 0, At, B0); PG8_MMA(0, 1, At, B1); PG8_BAR; PG8_SCHED;
            PG8_LDA(At, 1, 1); PG8_STAGE(PG8_SB(1, 0), b3, voffB); PG8_STAGE(PG8_SB(1, 1), b3 + hstep, voffB); PG8_STAGE(PG8_SA(1, 0), a3, voffA);
            PG8_WAIT_V(8); PG8_WAIT_L(0); PG8_BAR; if (!cur.half) { PG8_MMA(1, 0, At, B0); PG8_MMA(1, 1, At, B1); } PG8_BAR; PG8_SCHED;
            } else {
            PG8_LDB(B0, 0, 0); PG8_SCHED; PG8_LDA(At, 0, 0); PG8_STAGE(PG8_SA(1, 1), a1 + hstep, voffA);
            PG8_WAIT_L(8); PG8_BAR; PG8_WAIT_L(0); PG8_MMA(0, 0, At, B0); PG8_BAR; PG8_SCHED;
            PG8_LDB(B1, 0, 1); PG8_STAGE(PG8_SB(0, 0), b2, voffB);
            PG8_BAR; PG8_WAIT_L(0); PG8_MMA(0, 1, At, B1); PG8_BAR;
            PG8_LDA(At, 0, 1); PG8_STAGE(PG8_SA(0, 0), a2, voffA);
            PG8_BAR; PG8_WAIT_L(0); PG8_MMA(1, 0, At, B0); PG8_BAR; PG8_SCHED;
            PG8_STAGE(PG8_SB(0, 1), b2 + hstep, voffB);
            PG8_WAIT_V(6); PG8_BAR; PG8_MMA(1, 1, At, B1); PG8_BAR;
            PG8_LDB(B0, 1, 0); PG8_SCHED; PG8_LDA(At, 1, 0); PG8_STAGE(PG8_SA(0, 1), a2 + hstep, voffA);
            PG8_WAIT_L(8); PG8_BAR; PG8_WAIT_L(0); PG8_MMA(0, 0, At, B0); PG8_BAR; PG8_SCHED;
            PG8_LDB(B1, 1, 1); PG8_STAGE(PG8_SB(1, 0), b3, voffB);
            PG8_BAR; PG8_WAIT_L(0); PG8_MMA(0, 1, At, B1); PG8_BAR;
            PG8_LDA(At, 1, 1); PG8_STAGE(PG8_SA(1, 0), a3, voffA);
            PG8_BAR; PG8_WAIT_L(0); PG8_MMA(1, 0, At, B0); PG8_BAR; PG8_SCHED;
            PG8_STAGE(PG8_SB(1, 1), b3 + hstep, voffB);
            PG8_WAIT_V(6); PG8_BAR; PG8_MMA(1, 1, At, B1); PG8_BAR;
            }
        }
        if constexpr (ALIGN_EPI) { if (wr == 0) PG8_BAR; }
        if constexpr (!Epi::AFTER_DRAIN) { E(acc, cur, wr, wc, fr, fq); S.done(cur); }
        if (!has_next) break;
#pragma unroll
        for (int a = 0; a < 2; ++a)
#pragma unroll
            for (int b = 0; b < 2; ++b)
#pragma unroll
                for (int m = 0; m < 4; ++m)
#pragma unroll
                    for (int n = 0; n < 2; ++n) acc[a][b][m][n] = (f32x4){0.f, 0.f, 0.f, 0.f};
        cur = nxt; cA = nA; cB = nB; ++ui;
        if constexpr (ALIGN_EPI) { if (wr == 1) PG8_BAR; }
    }
    PG8_WAIT_V(0);
    if constexpr (!ALIGN_EPI) { if (wr == 0) PG8_BAR; }
    PG8_BAR;
    if constexpr (Epi::AFTER_DRAIN) { E.fused(acc, cur, wr, wc, fr, fq, lds, wid, lane); S.done(cur); }
#undef PG8_SA
#undef PG8_SB
#undef PG8_STAGE
#undef PG8_LDA
#undef PG8_LDB
#undef PG8_MMA
#undef PG8_WAIT_V
#undef PG8_WAIT_L
#undef PG8_BAR
#undef PG8_SCHED
}
}
__device__ __forceinline__ void p0_transpose_item(const float* W, int K, int N, bf16* WT, int row_off, LAS float* scr, int item, int lane) {
    const int nblk = N / 32, kb = item / nblk, nb = item % nblk, k0 = 64 * kb, n0 = 32 * nb;
#pragma unroll 8
    for (int i = 0; i < 32; ++i) { const int kk = 2 * i + (lane >> 5); scr[kk * 33 + (lane & 31)] = W[(size_t)(k0 + kk) * N + n0 + (lane & 31)]; }
    LDS_WAIT(); asm volatile("" ::: "memory");
    const int c = lane & 7;
#pragma unroll
    for (int j = 0; j < 4; ++j) { const int n = (lane >> 3) + 8 * j; const LAS float* s = scr + (8 * c) * 33 + n;
        v4u o; o.x = pk2(s[0 * 33], s[1 * 33]); o.y = pk2(s[2 * 33], s[3 * 33]); o.z = pk2(s[4 * 33], s[5 * 33]); o.w = pk2(s[6 * 33], s[7 * 33]);
        *(GAS v4u*)(WT + (size_t)(row_off + n0 + n) * K + k0 + 8 * c) = o; }
    LDS_WAIT(); asm volatile("" ::: "memory");
}
namespace nv {
typedef float f4 __attribute__((ext_vector_type(4)));
typedef unsigned u2v __attribute__((ext_vector_type(2)));
typedef unsigned u4v __attribute__((ext_vector_type(4)));
constexpr int ROWV = DM / 256;
constexpr int NRL = NEG + NE;
constexpr int AD_KS = 128;
constexpr int AD_NKS = DM / AD_KS;
#ifdef HOST_EMU2
#define WAVE_SYNC() do { emu::wave_sync(); emu::set_ids(); } while (0)
#else
#define WAVE_SYNC() __builtin_amdgcn_wave_barrier()
#endif
template <int CTRL> __device__ __forceinline__ float dpp_f(float v) { return __builtin_bit_cast(float, __builtin_amdgcn_update_dpp(0, __builtin_bit_cast(int, v), CTRL, 0xf, 0xf, true)); }
__device__ __forceinline__ float wave_sum(float v) {
    v += dpp_f<0xB1>(v); v += dpp_f<0x4E>(v); v += dpp_f<0x141>(v); v += dpp_f<0x140>(v);
    const int iv = __builtin_bit_cast(int, v);
    return (__builtin_bit_cast(float, __builtin_amdgcn_readlane(iv, 0)) + __builtin_bit_cast(float, __builtin_amdgcn_readlane(iv, 16))) +
           (__builtin_bit_cast(float, __builtin_amdgcn_readlane(iv, 32)) + __builtin_bit_cast(float, __builtin_amdgcn_readlane(iv, 48)));
}
__device__ __forceinline__ float bf2f(unsigned short b) { return __builtin_bit_cast(float, ((unsigned)b) << 16); }
__device__ __forceinline__ float bflo(unsigned w) { return __builtin_bit_cast(float, w << 16); }
__device__ __forceinline__ float bfhi(unsigned w) { return __builtin_bit_cast(float, w & 0xffff0000u); }
__device__ __forceinline__ void row_load(const float* p, int lane, f4 (&v)[ROWV]) {
#pragma unroll
    for (int j = 0; j < ROWV; ++j) v[j] = *(const f4*)(p + 4 * lane + 256 * j);
}
__device__ __forceinline__ float row_ss(const f4 (&v)[ROWV]) { float s = 0.f;
#pragma unroll
    for (int j = 0; j < ROWV; ++j) s += (v[j].x * v[j].x + v[j].y * v[j].y) + (v[j].z * v[j].z + v[j].w * v[j].w);
    return s; }
__device__ __forceinline__ void row_modulate(f4 (&v)[ROWV], float rstd, const float* g, const float* sc, const float* sh, int lane) {
#pragma unroll
    for (int j = 0; j < ROWV; ++j) { const int c = 4 * lane + 256 * j; const f4 gg = *(const f4*)(g + c), ss = *(const f4*)(sc + c), hh = *(const f4*)(sh + c);
        v[j] = v[j] * rstd * gg * (ss + 1.0f) + hh; }
}
__device__ __forceinline__ void row_store_bf16(bf16_t* o, const f4 (&v)[ROWV], int lane) {
#pragma unroll
    for (int j = 0; j < ROWV; ++j) { u2v w; w.x = pk2(v[j].x, v[j].y); w.y = pk2(v[j].z, v[j].w); *(u2v*)(o + 4 * lane + 256 * j) = w; }
}

__device__ __forceinline__ void ph_prep(const In& I, float* RWT, int gtid, int gstride) {
    for (int idx_ = gtid; idx_ < (NL * NRL * DM) * PR_PREP; idx_ += gstride) { const int idx = idx_ % (NL * NRL * DM);
        const int k = idx % DM, jj = (idx / DM) % NRL, l = idx / (DM * NRL);
        RWT[idx] = jj < NEG ? I.router_grp_w[((size_t)l * DM + k) * NEG + jj] : I.router_exp_w[((size_t)l * DM + k) * NE + (jj - NEG)];
    }
}
__device__ __forceinline__ void ph_adaln_part(const In& I, float* PART, const LAS float* scond, int gw, int ngw, int lane) {
    constexpr int NCH = NMOD * DM / 256;
    for (int it_ = gw; it_ < NL * NCH * AD_NKS * PR_WCVT; it_ += ngw) { const int it = it_ % (NL * NCH * AD_NKS);
        const int ks = it % AD_NKS, ch = (it / AD_NKS) % NCH, l = it / (AD_NKS * NCH);
        const float* w = I.ada_w + ((size_t)l * DM + (size_t)ks * AD_KS) * (NMOD * DM) + ch * 256 + 4 * lane;
        f4 acc[NCOND];
#pragma unroll
        for (int j = 0; j < NCOND; ++j) acc[j] = (f4){0.f, 0.f, 0.f, 0.f};
#pragma unroll 8
        for (int k = 0; k < AD_KS; ++k) { const f4 wv = *(const f4*)(w + (size_t)k * (NMOD * DM));
#pragma unroll
            for (int j = 0; j < NCOND; ++j) acc[j] += wv * scond[j * DM + ks * AD_KS + k]; }
#pragma unroll
        for (int j = 0; j < NCOND; ++j) *(f4*)(PART + (((size_t)ks * NL + l) * NCOND + j) * (NMOD * DM) + ch * 256 + 4 * lane) = acc[j];
    }
}
__device__ __forceinline__ void ph_adaln_reduce(const In& I, const float* PART, float* MOD, int gtid, int gstride) {
    for (int idx_ = gtid; idx_ < (NL * NCOND * NMOD * DM) * PR_PREP; idx_ += gstride) { const int idx = idx_ % (NL * NCOND * NMOD * DM);
        const int n = idx % (NMOD * DM), l = idx / (NCOND * NMOD * DM);
        float s = I.ada_b[(size_t)l * NMOD * DM + n];
        for (int ks = 0; ks < AD_NKS; ++ks) s += PART[(size_t)ks * NL * NCOND * NMOD * DM + idx];
        MOD[idx] = s;
    }
}

__device__ __forceinline__ void row_combine(f4 (&v)[ROWV], const bf16_t* Yb, const int* TS, const float* TG, const float* mod5, int r, int lane) {
    const int s0 = TS[2 * r], s1 = TS[2 * r + 1]; const float g0 = TG[2 * r], g1 = TG[2 * r + 1];
#pragma unroll
    for (int j = 0; j < ROWV; ++j) { const int c = 4 * lane + 256 * j;
        const u2v a = *(const u2v*)(Yb + (size_t)s0 * DM + c), b = *(const u2v*)(Yb + (size_t)s1 * DM + c); const f4 m = *(const f4*)(mod5 + c);
        f4 y; y.x = g0 * bflo(a.x) + g1 * bflo(b.x); y.y = g0 * bfhi(a.x) + g1 * bfhi(b.x); y.z = g0 * bflo(a.y) + g1 * bflo(b.y); y.w = g0 * bfhi(a.y) + g1 * bfhi(b.y);
        v[j] += m * y; }
}

template <int MODE>
__device__ __forceinline__ void ph_norm1(const In& I, int l, const float* MOD, float* X, const bf16_t* Yb, const int* TS, const float* TG, bf16_t* Hb, float* out, int gw, int ngw, int lane) {
    const int r0 = MODE == 2 ? NCTX : 0;
    for (int r_ = gw; r_ < (NTOK - r0) * (MODE == 0 ? PR_NORM : (MODE == 2 ? PR_FIN : 1)); r_ += ngw) { const int r = r0 + r_ % (NTOK - r0);
        f4 v[ROWV];
        const float* src = MODE == 0 ? (r < NCTX ? I.ctx + (size_t)r * DM : I.x + (size_t)(r - NCTX) * DM) : X + (size_t)r * DM;
        row_load(src, lane, v);
        const int cj = cond_of_row(r);
        if (MODE >= 1) {
            row_combine(v, Yb, TS, TG, MODV(MOD, (MODE == 1 ? l - 1 : NL - 1), cj, 5), r, lane);
            if (MODE == 1) {
#pragma unroll
                for (int j = 0; j < ROWV; ++j) *(f4*)(X + (size_t)r * DM + 4 * lane + 256 * j) = v[j]; }
        }
        const float rstd = 1.0f / sqrtf(wave_sum(row_ss(v)) * (1.0f / DM) + NORM_EPS);
        if (MODE == 2) {
#pragma unroll
            for (int j = 0; j < ROWV; ++j) { const int c = 4 * lane + 256 * j; *(f4*)(out + (size_t)(r - NCTX) * DM + c) = v[j] * rstd * *(const f4*)(I.final_g + c); }
        } else {
            row_modulate(v, rstd, I.norm1_g + (size_t)l * DM, MODV(MOD, l, cj, 1), MODV(MOD, l, cj, 0), lane);
            row_store_bf16(Hb + (size_t)r * DM, v, lane);
        }
    }
}
constexpr int RT_LDS_W = 0;
constexpr int RT_LDS_LG = 2 * 6 * DM * 4;
constexpr int RT_LDS_SE = RT_LDS_LG + 40 * 40 * 4;
__device__ __forceinline__ void route_rows(int nblk, int bid, int row_lo, int& rb0, int& rb1) {
    const int per = (NTOK - row_lo + nblk - 1) / nblk; rb0 = row_lo + bid * per; rb1 = rb0 + per < NTOK ? rb0 + per : NTOK; if (rb0 > NTOK) rb0 = NTOK;
}
__device__ __forceinline__ void ph_route(const In& I, int l, const float* MOD, const float* X, const float* RWT, int* TE, float* TG, float* RSTD, int* TP, int* HIST, LAS unsigned char* lds,
                         int row_lo, int bid, int nblk, int tid, int lane, int wave) {
    LAS float* wbuf = (LAS float*)(lds + RT_LDS_W); LAS float* lgs = (LAS float*)(lds + RT_LDS_LG); LAS int* sexp = (LAS int*)(lds + RT_LDS_SE);
    int rb0, rb1; route_rows(nblk, bid, row_lo, rb0, rb1);
    const float* wl = RWT + (size_t)l * NRL * DM;
    constexpr int RR = 5, RCH = 3;
    for (int rp_ = 0; rp_ < PR_ROUTE; ++rp_)
    for (int g0 = rb0; g0 < rb1; g0 += 8 * RR) {
        f4 v[RR][ROWV]; float rs[RR];
#pragma unroll
        for (int i = 0; i < RR; ++i) { const int r = g0 + RR * wave + i; rs[i] = 0.f;
#pragma unroll
            for (int j = 0; j < ROWV; ++j) v[i][j] = (f4){0.f, 0.f, 0.f, 0.f};
            if (r < rb1) { row_load(X + (size_t)r * DM, lane, v[i]); rs[i] = 1.0f / sqrtf(wave_sum(row_ss(v[i])) * (1.0f / DM) + NORM_EPS); const int cj = cond_of_row(r);
                row_modulate(v[i], rs[i], I.norm2_g + (size_t)l * DM, MODV(MOD, l, cj, 4), MODV(MOD, l, cj, 3), lane); } }
        f4 wn[RCH];
#pragma unroll
        for (int c = 0; c < RCH; ++c) { wn[c] = (f4){0.f, 0.f, 0.f, 0.f}; if (tid < DM / 4 && c < NRL) wn[c] = *(const f4*)(wl + (size_t)c * DM + 4 * tid); }
#pragma unroll 1
        for (int j0 = 0; j0 < NRL; j0 += RCH) { const int buf = (j0 / RCH) & 1;
            if (tid < DM / 4) {
#pragma unroll
                for (int c = 0; c < RCH; ++c) *(LAS f4*)(wbuf + (buf * RCH + c) * DM + 4 * tid) = wn[c];
#pragma unroll
                for (int c = 0; c < RCH; ++c) if (j0 + RCH + c < NRL) wn[c] = *(const f4*)(wl + (size_t)(j0 + RCH + c) * DM + 4 * tid); }
            __syncthreads();
#pragma unroll 1
            for (int c = 0; c < RCH; ++c) { const int jj = j0 + c; if (jj >= NRL) break;
                const LAS float* w = wbuf + (buf * RCH + c) * DM + 4 * lane; float s[RR];
#pragma unroll
                for (int i = 0; i < RR; ++i) s[i] = 0.f;
#pragma unroll
                for (int j = 0; j < ROWV; ++j) { const f4 wv = *(const LAS f4*)(w + 256 * j);
#pragma unroll
                    for (int i = 0; i < RR; ++i) s[i] += (v[i][j].x * wv.x + v[i][j].y * wv.y) + (v[i][j].z * wv.z + v[i][j].w * wv.w); }
                const float bias = jj < NEG ? I.router_grp_b[l * NEG + jj] : I.router_exp_b[l * NE + (jj - NEG)];
#pragma unroll
                for (int i = 0; i < RR; ++i) { const float t = wave_sum(s[i]); if (lane == 0) lgs[(RR * wave + i) * 40 + jj] = t + bias; } }
        }
        WAVE_SYNC();
#pragma unroll
        for (int i = 0; i < RR; ++i) { const int r = g0 + RR * wave + i; const bool valid = r < rb1;
            float lg[NRL];
#pragma unroll
            for (int jj = 0; jj < NRL; ++jj) lg[jj] = lgs[(RR * wave + i) * 40 + jj];
            int grp = 0; float gmax = lg[0];
#pragma unroll
            for (int j = 1; j < NEG; ++j) if (lg[j] > gmax) { gmax = lg[j]; grp = j; }
            float den = 0.f;
#pragma unroll
            for (int j = 0; j < NEG; ++j) den += expf(lg[j] - gmax);
            const float gprob = 1.0f / den;
            float sel[EPG];
#pragma unroll
            for (int j = 0; j < EPG; ++j) { float x = lg[NEG + j];
#pragma unroll
                for (int g2 = 1; g2 < NEG; ++g2) x = (grp == g2) ? lg[NEG + g2 * EPG + j] : x;
                sel[j] = x; }
            int i0 = 0; float l0 = sel[0];
#pragma unroll
            for (int j = 1; j < EPG; ++j) if (sel[j] > l0) { l0 = sel[j]; i0 = j; }
            int i1 = -1; float l1 = -3.0e38f;
#pragma unroll
            for (int j = 0; j < EPG; ++j) if (j != i0 && sel[j] > l1) { l1 = sel[j]; i1 = j; }
            const float e1 = expf(l1 - l0), g0v = gprob / (1.0f + e1), g1v = gprob * e1 / (1.0f + e1);
            if (valid && lane == 0) { const int ex0 = grp * EPG + i0, ex1 = grp * EPG + i1; TE[2 * r] = ex0; TE[2 * r + 1] = ex1; TG[2 * r] = g0v; TG[2 * r + 1] = g1v; RSTD[r] = rs[i];
                sexp[2 * (r - rb0)] = ex0; sexp[2 * (r - rb0) + 1] = ex1; } }
        WAVE_SYNC();
    }
    __syncthreads();
    const int ns = 2 * (rb1 - rb0);
    for (int t = tid; t < ns; t += 512) { const int e = sexp[t]; int rank = 0; for (int q = 0; q < t; ++q) rank += (sexp[q] == e) ? 1 : 0; TP[2 * rb0 + t] = rank; }
    if (tid < NE) { int c = 0; for (int q = 0; q < ns; ++q) c += (sexp[q] == tid) ? 1 : 0; HIST[bid * NE + tid] = c; }
    __syncthreads();
}
constexpr int GA_LDS_PS = 0;
constexpr int GA_LDS_BASE = 2 * 512 * 4;
__device__ __forceinline__ void ph_gather(const In& I, int l, const float* MOD, const float* X, const float* RSTD, const int* TE, const int* TP, const int* HIST, int* TS, bf16_t* Xg,
                          LAS unsigned char* lds, LAS int* tab, LAS int* pst, int row_lo, int bid, int nblk, int tid, int lane, int wave) {
    LAS int* psum = (LAS int*)(lds + GA_LDS_PS); LAS int* base = (LAS int*)(lds + GA_LDS_BASE); LAS int* tot = base + NE;
    int rb0, rb1; route_rows(nblk, bid, row_lo, rb0, rb1);
    f4 v[ROWV];
    { const int r = rb0 + wave < rb1 ? rb0 + wave : (rb1 > rb0 ? rb1 - 1 : rb0); row_load(X + (size_t)(r < NTOK ? r : NTOK - 1) * DM, lane, v); }
    { constexpr int PARTS = 512 / NE; const int e = tid % NE, part = tid / NE; const int per = (nblk + PARTS - 1) / PARTS; int sb = 0, st = 0;
        for (int k = 0; k < per; k += 4) { int h[4];
#pragma unroll
            for (int q = 0; q < 4; ++q) { const int bb = part * per + k + q; h[q] = HIST[(bb < nblk ? bb : nblk - 1) * NE + e]; }
#pragma unroll
            for (int q = 0; q < 4; ++q) { const int bb = part * per + k + q; if (k + q < per && bb < nblk) { st += h[q]; if (bb < bid) sb += h[q]; } } }
        psum[tid] = sb; psum[512 + tid] = st; }
    __syncthreads();
    if (tid < NE) { int sb = 0, st = 0; for (int part = 0; part < 512 / NE; ++part) { sb += psum[part * NE + tid]; st += psum[512 + part * NE + tid]; } base[tid] = sb; tot[tid] = st; }
    __syncthreads();
    if (tid == 0) { int off = 0, nru = 0;
        for (int e = 0; e < NE; ++e) { pst[e] = off; off += ((tot[e] + MOE_TILE - 1) / MOE_TILE) * MOE_TILE; }
        int nfr = 0, nhr = 0;
        for (int e = 0; e < NE; ++e) { const int n128 = (tot[e] + MOE_TILE - 1) / MOE_TILE; for (int k = 0; k + 1 < n128; k += 2) tab[2 + nfr++] = (pst[e] / MOE_TILE + k) | (e << 16); }
        for (int e = 0; e < NE; ++e) { const int n128 = (tot[e] + MOE_TILE - 1) / MOE_TILE; if (n128 & 1) tab[2 + nfr + nhr++] = (pst[e] / MOE_TILE + n128 - 1) | (e << 16); }
        tab[0] = nfr; tab[1] = nhr; }
    __syncthreads();
    for (int r = rb0 + wave; r < rb1; r += 8) {
        f4 vn[ROWV]; const int rn = r + 8 < rb1 ? r + 8 : r; row_load(X + (size_t)rn * DM, lane, vn);
        const int cj = cond_of_row(r);
        row_modulate(v, RSTD[r], I.norm2_g + (size_t)l * DM, MODV(MOD, l, cj, 4), MODV(MOD, l, cj, 3), lane);
        const int e0 = TE[2 * r], e1 = TE[2 * r + 1]; const int s0 = pst[e0] + base[e0] + TP[2 * r], s1 = pst[e1] + base[e1] + TP[2 * r + 1];
        row_store_bf16(Xg + (size_t)s0 * DM, v, lane); row_store_bf16(Xg + (size_t)s1 * DM, v, lane);
        if (lane == 0) { TS[2 * r] = s0; TS[2 * r + 1] = s1; }
#pragma unroll
        for (int j = 0; j < ROWV; ++j) v[j] = vn[j];
    }
}
__device__ __forceinline__ float fsilu(float v) { return v / (1.0f + __expf(-v)); }
__device__ __forceinline__ float fsigm(float v) { return 1.0f / (1.0f + __expf(-v)); }
struct EpiAct {
    static constexpr bool PERM = true, AFTER_DRAIN = false;
    bf16_t* O; int ldc; int ncol;
    __device__ __forceinline__ void operator()(const pg8::f32x4 (&acc)[2][2][4][2], const pg8::Unit& u, int wr, int wc, int fr, int fq) const {
        const int row0 = u.pm * 128 + wr * 64 + fr, col0 = (u.pn % ncol) * 128 + wc * 32 + 8 * fq;
#pragma unroll
        for (int ai = 0; ai < 2; ++ai)
#pragma unroll
            for (int m = 0; m < 4; ++m) { if (ai == 1 && u.half) continue; bf16_t* rowp = O + (size_t)(row0 + ai * 128 + m * 16) * ldc + col0;
                const pg8::f32x4 g0 = acc[ai][0][m][0], g1 = acc[ai][0][m][1], u0 = acc[ai][1][m][0], u1 = acc[ai][1][m][1];
                u4v w; w.x = pk2(fsilu(g0[0]) * u0[0], fsilu(g0[1]) * u0[1]); w.y = pk2(fsilu(g0[2]) * u0[2], fsilu(g0[3]) * u0[3]);
                w.z = pk2(fsilu(g1[0]) * u1[0], fsilu(g1[1]) * u1[1]); w.w = pk2(fsilu(g1[2]) * u1[2], fsilu(g1[3]) * u1[3]);
                *(u4v*)rowp = w; }
    }
};
struct EpiBf16N {
    static constexpr bool PERM = true, AFTER_DRAIN = false;
    bf16_t* O; int ldc; int ncol;
    __device__ __forceinline__ void operator()(const pg8::f32x4 (&acc)[2][2][4][2], const pg8::Unit& u, int wr, int wc, int fr, int fq) const {
        const int row0 = u.pm * 128 + wr * 64 + fr, col0 = (u.pn % ncol) * 256 + wc * 32 + 8 * fq;
#pragma unroll
        for (int ai = 0; ai < 2; ++ai)
#pragma unroll
            for (int m = 0; m < 4; ++m) { if (ai == 1 && u.half) continue; bf16_t* rowp = O + (size_t)(row0 + ai * 128 + m * 16) * ldc + col0;
#pragma unroll
                for (int bj = 0; bj < 2; ++bj) { const pg8::f32x4 a = acc[ai][bj][m][0], b = acc[ai][bj][m][1];
                    u4v w; w.x = pk2(a[0], a[1]); w.y = pk2(a[2], a[3]); w.z = pk2(b[0], b[1]); w.w = pk2(b[2], b[3]); *(u4v*)(rowp + bj * 128) = w; } }
    }
};
struct EpiGlu {
    static constexpr bool PERM = true, AFTER_DRAIN = false;
    bf16_t* O; int ldc; int ocol; const bf16_t* Zb; int ldz; const float* bias;
    __device__ __forceinline__ void operator()(const pg8::f32x4 (&acc)[2][2][4][2], const pg8::Unit& u, int wr, int wc, int fr, int fq) const {
        const int row0 = u.pm * 128 + wr * 64 + fr, col0 = u.pn * 256 + wc * 32 + 8 * fq;
#pragma unroll
        for (int ai = 0; ai < 2; ++ai)
#pragma unroll
            for (int m = 0; m < 4; ++m) { if (ai == 1 && u.half) continue; const int row = row0 + ai * 128 + m * 16;
#pragma unroll
                for (int bj = 0; bj < 2; ++bj) { const int c = col0 + bj * 128; const u4v z = *(const u4v*)(Zb + (size_t)row * ldz + c);
                    const f4 b0 = *(const f4*)(bias + c), b1 = *(const f4*)(bias + c + 4); const pg8::f32x4 a = acc[ai][bj][m][0], b = acc[ai][bj][m][1];
                    u4v w; w.x = pk2(bflo(z.x) * fsigm(a[0] + b0.x), bfhi(z.x) * fsigm(a[1] + b0.y)); w.y = pk2(bflo(z.y) * fsigm(a[2] + b0.z), bfhi(z.y) * fsigm(a[3] + b0.w));
                    w.z = pk2(bflo(z.z) * fsigm(b[0] + b1.x), bfhi(z.z) * fsigm(b[1] + b1.y)); w.w = pk2(bflo(z.w) * fsigm(b[2] + b1.z), bfhi(z.w) * fsigm(b[3] + b1.w));
                    *(u4v*)(O + (size_t)row * ldc + ocol + c) = w; } }
    }
};
struct EpiResid {
    static constexpr bool PERM = false, AFTER_DRAIN = false;
    float* Xo; const float* res_ctx; const float* res_lat; const float* MOD; int l; int row_base;
    __device__ __forceinline__ void operator()(const pg8::f32x4 (&acc)[2][2][4][2], const pg8::Unit& u, int wr, int wc, int fr, int fq) const {
        const int row0 = row_base + u.pm * 128 + wr * 64 + fr, col0 = u.pn * 256 + wc * 32 + 4 * fq;
#pragma unroll
        for (int ai = 0; ai < 2; ++ai)
#pragma unroll
            for (int m = 0; m < 4; ++m) { if (ai == 1 && u.half) continue; const int row = row0 + ai * 128 + m * 16;
                const float* rp = (row < NCTX ? res_ctx + (size_t)row * DM : res_lat + (size_t)(row - NCTX) * DM) + col0;
                const float* mp = MODV(MOD, l, cond_of_row(row), 2) + col0; float* op = Xo + (size_t)row * DM + col0;
#pragma unroll
                for (int bj = 0; bj < 2; ++bj)
#pragma unroll
                    for (int n = 0; n < 2; ++n) { const int o = bj * 128 + n * 16; const f4 r4 = *(const f4*)(rp + o), m4 = *(const f4*)(mp + o); const pg8::f32x4 a = acc[ai][bj][m][n];
                        f4 x; x.x = r4.x + m4.x * a[0]; x.y = r4.y + m4.y * a[1]; x.z = r4.z + m4.z * a[2]; x.w = r4.w + m4.w * a[3]; *(f4*)(op + o) = x; } }
    }
};
}
namespace nv {
typedef short s8v __attribute__((ext_vector_type(8)));
constexpr int RPAD = 136;
constexpr float LOG2E = 1.4426950408889634f;
__device__ __forceinline__ float shfl_xor_f(float v, int lane, int m) { return __builtin_bit_cast(float, __builtin_amdgcn_ds_bpermute((lane ^ m) << 2, __builtin_bit_cast(int, v))); }

__device__ __forceinline__ void ph_rope_table(float* ROPE, int gtid, int gstride) {
    constexpr int NF = HD / 4;
    for (int idx_ = gtid; idx_ < (SQ * (HD / 2)) * PR_PREP; idx_ += gstride) { const int idx = idx_ % (SQ * (HD / 2));
        const int i = idx % (HD / 2), pos = idx / (HD / 2), rowp = pos / GW, colp = pos % GW, f = i < NF ? i : i - NF;
        const float inv = powf(10000.0f, -(float)f / (float)NF), ang = (i < NF ? (float)rowp : (float)colp) * inv;
        ROPE[2 * idx] = cosf(ang); ROPE[2 * idx + 1] = sinf(ang);
    }
}
struct EpiQKV {
    static constexpr bool PERM = true, AFTER_DRAIN = false;
    bf16_t* O; const float* ROPE;
    __device__ __forceinline__ void operator()(const pg8::f32x4 (&acc)[2][2][4][2], const pg8::Unit& u, int wr, int wc, int fr, int fq) const {
        const int row0 = u.pm * 128 + wr * 64 + fr, col0 = u.pn * 256 + wc * 32 + 8 * fq;
        const int region = (u.pn * 256) / RW;
        const float ksc = region == 1 ? 1.0f / sqrtf((float)HD) : 1.0f;
#pragma unroll
        for (int ai = 0; ai < 2; ++ai)
#pragma unroll
            for (int m = 0; m < 4; ++m) { if (ai == 1 && u.half) continue; const int row = row0 + ai * 128 + m * 16; bf16_t* rowp = O + (size_t)row * INW + col0;
                const bool rope = region < 2 && row >= NCTX; const int pos = rope ? (row - NCTX) % SQ : 0;
#pragma unroll
                for (int bj = 0; bj < 2; ++bj) { pg8::f32x4 a = acc[ai][bj][m][0], b = acc[ai][bj][m][1];
                    if (rope) { const int i0 = ((col0 + bj * 128) % HD) / 2; const f4* rp = (const f4*)(ROPE + ((size_t)pos * (HD / 2) + i0) * 2); const f4 c0 = rp[0], c1 = rp[1];
                        pg8::f32x4 x, y; x[0] = a[0] * c0.x - a[1] * c0.y; x[1] = a[0] * c0.y + a[1] * c0.x; x[2] = a[2] * c0.z - a[3] * c0.w; x[3] = a[2] * c0.w + a[3] * c0.z;
                        y[0] = b[0] * c1.x - b[1] * c1.y; y[1] = b[0] * c1.y + b[1] * c1.x; y[2] = b[2] * c1.z - b[3] * c1.w; y[3] = b[2] * c1.w + b[3] * c1.z; a = x; b = y; }
                    a = a * ksc; b = b * ksc;
                    u4v w; w.x = pk2(a[0], a[1]); w.y = pk2(a[2], a[3]); w.z = pk2(b[0], b[1]); w.w = pk2(b[2], b[3]); *(u4v*)(rowp + bj * 128) = w; } }
    }
};
__device__ __forceinline__ pg8::f32x4 mfma16(const s8v a, const s8v b, const pg8::f32x4 c) { return __builtin_amdgcn_mfma_f32_16x16x32_bf16(a, b, c, 0, 0, 0); }

__device__ __forceinline__ void ph_ret_kv(const In& I, int l, const bf16_t* QKVb, bf16_t* KVT, LAS unsigned char* lds, int bid, int nblk, int tid, int lane, int wave) {
    LAS bf16_t* KTf = (LAS bf16_t*)lds; LAS bf16_t* KTb = KTf + HD * RPAD; LAS bf16_t* VT = KTb + HD * RPAD;
    const int fr = lane & 15, fq = lane >> 4;
    for (int u_ = bid; u_ < NB * NH * NCH * PR_RET; u_ += nblk) { const int u = u_ % (NB * NH * NCH);
        const int n = u % NCH, h = (u / NCH) % NH, b = u / (NCH * NH);
        const float lgf = logg(I, l, 0, h), lgb = logg(I, l, 1, h);
        { const int p = tid & 127, row = row_of(b, n, p); const float wf = expf(lgf * (float)(RC - 1 - p)), wb = expf(lgb * (float)p);
            const bf16_t* kp = QKVb + (size_t)row * INW + RW + h * HD; const bf16_t* vp = QKVb + (size_t)row * INW + 2 * RW + h * HD;
#pragma unroll
            for (int i = 0; i < 4; ++i) { const int dg = (tid >> 7) + 4 * i; const u4v kk = *(const u4v*)(kp + 8 * dg), vv = *(const u4v*)(vp + 8 * dg);
#pragma unroll
                for (int j = 0; j < 8; ++j) { const unsigned kw = kk[j >> 1], vw = vv[j >> 1]; const float kf = (j & 1) ? bfhi(kw) : bflo(kw);
                    KTf[(8 * dg + j) * RPAD + p] = (bf16_t)f2bf_u(kf * wf); KTb[(8 * dg + j) * RPAD + p] = (bf16_t)f2bf_u(kf * wb);
                    VT[(8 * dg + j) * RPAD + p] = (bf16_t)((j & 1) ? (vw >> 16) : (vw & 0xffffu)); } } }
        __syncthreads();
        pg8::f32x4 acc[2][8];
#pragma unroll
        for (int d = 0; d < 2; ++d)
#pragma unroll
            for (int k = 0; k < 8; ++k) acc[d][k] = (pg8::f32x4){0.f, 0.f, 0.f, 0.f};
#pragma unroll
        for (int s = 0; s < 4; ++s) { const s8v bfrag = *(const LAS s8v*)(VT + (16 * wave + fr) * RPAD + 32 * s + 8 * fq);
#pragma unroll
            for (int db = 0; db < 8; ++db) { const s8v af = *(const LAS s8v*)(KTf + (16 * db + fr) * RPAD + 32 * s + 8 * fq), ab = *(const LAS s8v*)(KTb + (16 * db + fr) * RPAD + 32 * s + 8 * fq);
                acc[0][db] = mfma16(af, bfrag, acc[0][db]); acc[1][db] = mfma16(ab, bfrag, acc[1][db]); } }
        const int e = 16 * wave + fr;
#pragma unroll
        for (int d = 0; d < 2; ++d)
#pragma unroll
            for (int db = 0; db < 8; ++db) { u2v w; w.x = pk2(acc[d][db][0], acc[d][db][1]); w.y = pk2(acc[d][db][2], acc[d][db][3]);
                *(u2v*)(KVT + (((((size_t)d * NB + b) * NH + h) * NCH + n) * HD + e) * HD + 16 * db + 4 * fq) = w; }
        __syncthreads();
    }
}
__device__ __forceinline__ void ph_ret_scan(const In& I, int l, const bf16_t* KVT, bf16_t* STT, int gtid, int gstride) {
    for (int idx_ = gtid; idx_ < 2 * NB * NH * HD * (HD / 4) * PR_RET; idx_ += gstride) { const int idx = idx_ % (2 * NB * NH * HD * (HD / 4));
        const int ed = idx % (HD * HD / 4); int t = idx / (HD * HD / 4); const int h = t % NH; t /= NH; const int b = t % NB, dir = t / NB;
        const float dec = expf(logg(I, l, dir, h) * (float)RC); f4 s = (f4){0.f, 0.f, 0.f, 0.f};
#pragma unroll 1
        for (int step = 0; step < NCH; ++step) { const int n = chain_chunk(dir, step);
            const size_t o = ((((size_t)dir * NB + b) * NH + h) * NCH + n) * HD * HD + 4 * (size_t)ed;
            u2v w; w.x = pk2(s.x, s.y); w.y = pk2(s.z, s.w); *(u2v*)(STT + o) = w;
            const u2v kw = *(const u2v*)(KVT + o); const f4 kv = (f4){bflo(kw.x), bfhi(kw.x), bflo(kw.y), bfhi(kw.y)}; s = s * dec + kv; }
    }
}
__device__ __forceinline__ void ph_ret_out(const In& I, int l, const bf16_t* QKVb, const bf16_t* STT, bf16_t* MIXb, LAS unsigned char* lds, int n_lo, int bid, int nblk, int tid, int lane, int wave) {
    LAS bf16_t* Kt = (LAS bf16_t*)lds; LAS bf16_t* VT = Kt + RC * RPAD; LAS bf16_t* ST = VT + HD * RPAD;
    const int fr = lane & 15, fq = lane >> 4, ncn = NCH - n_lo;
    for (int u_ = bid; u_ < NB * NH * ncn * PR_RET; u_ += nblk) { const int u = u_ % (NB * NH * ncn);
        const int n = n_lo + u % ncn, h = (u / ncn) % NH, b = u / (ncn * NH);
        const float lgf = logg(I, l, 0, h), lgb = logg(I, l, 1, h);
#pragma unroll
        for (int i = 0; i < 4; ++i) { const int q = i * 512 + tid, dgq = q & 15, p = q >> 4; const int row = row_of(b, n, p);
            *(LAS u4v*)(Kt + p * RPAD + 8 * dgq) = *(const u4v*)(QKVb + (size_t)row * INW + RW + h * HD + 8 * dgq);
            *(LAS u4v*)(ST + p * RPAD + 8 * dgq) = *(const u4v*)(STT + ((((size_t)0 * NB + b) * NH + h) * NCH + n) * HD * HD + (size_t)p * HD + 8 * dgq); }
        { const int p = tid & 127, row = row_of(b, n, p); const bf16_t* vp = QKVb + (size_t)row * INW + 2 * RW + h * HD;
#pragma unroll
            for (int i = 0; i < 4; ++i) { const int dg = (tid >> 7) + 4 * i; const u4v vv = *(const u4v*)(vp + 8 * dg);
#pragma unroll
                for (int j = 0; j < 8; ++j) { const unsigned vw = vv[j >> 1]; VT[(8 * dg + j) * RPAD + p] = (bf16_t)((j & 1) ? (vw >> 16) : (vw & 0xffffu)); } } }
        __syncthreads();
        const int ipos = 16 * wave + fr, rowq = row_of(b, n, ipos);
        s8v qf[4];
#pragma unroll
        for (int s = 0; s < 4; ++s) qf[s] = *(const s8v*)(QKVb + (size_t)rowq * INW + h * HD + 32 * s + 8 * fq);
        pg8::f32x4 st[8];
#pragma unroll
        for (int jt = 0; jt < 8; ++jt) { st[jt] = (pg8::f32x4){0.f, 0.f, 0.f, 0.f};
#pragma unroll
            for (int s = 0; s < 4; ++s) st[jt] = mfma16(*(const LAS s8v*)(Kt + (16 * jt + fr) * RPAD + 32 * s + 8 * fq), qf[s], st[jt]); }
        const float lf2 = lgf * LOG2E, lb2 = lgb * LOG2E;
#pragma unroll
        for (int jt = 0; jt < 8; ++jt)
#pragma unroll
            for (int r = 0; r < 4; ++r) { const int diff = ipos - (16 * jt + 4 * fq + r); st[jt][r] *= diff >= 0 ? exp2f(lf2 * (float)diff) : exp2f(lb2 * (float)(-diff)); }
        s8v pf[4];
#pragma unroll
        for (int s = 0; s < 4; ++s) { u4v w; w.x = pk2(st[2 * s][0], st[2 * s][1]); w.y = pk2(st[2 * s][2], st[2 * s][3]); w.z = pk2(st[2 * s + 1][0], st[2 * s + 1][1]); w.w = pk2(st[2 * s + 1][2], st[2 * s + 1][3]);
            pf[s] = __builtin_bit_cast(s8v, w); }
        pg8::f32x4 o0[8], oF[8], oB[8];
#pragma unroll
        for (int eb = 0; eb < 8; ++eb) { o0[eb] = (pg8::f32x4){0.f, 0.f, 0.f, 0.f}; oF[eb] = o0[eb]; oB[eb] = o0[eb]; }
        const bf16_t* stb = STT + ((((size_t)1 * NB + b) * NH + h) * NCH + n) * HD * HD;
        u4v sb[4];
#pragma unroll
        for (int i = 0; i < 4; ++i) { const int q = i * 512 + tid, dgq = q & 15, e = q >> 4; sb[i] = *(const u4v*)(stb + (size_t)e * HD + 8 * dgq); }
#pragma unroll
        for (int eb = 0; eb < 8; ++eb)
#pragma unroll
            for (int s = 0; s < 4; ++s) { const LAS bf16_t* vr = VT + (16 * eb + fr) * RPAD + 32 * s + 4 * fq; const u2v lo = *(const LAS u2v*)vr, hi = *(const LAS u2v*)(vr + 16);
                u4v a; a.x = lo.x; a.y = lo.y; a.z = hi.x; a.w = hi.y; o0[eb] = mfma16(__builtin_bit_cast(s8v, a), pf[s], o0[eb]);
                oF[eb] = mfma16(*(const LAS s8v*)(ST + (16 * eb + fr) * RPAD + 32 * s + 8 * fq), qf[s], oF[eb]); }
        __syncthreads();
#pragma unroll
        for (int i = 0; i < 4; ++i) { const int q = i * 512 + tid, dgq = q & 15, e = q >> 4; *(LAS u4v*)(ST + e * RPAD + 8 * dgq) = sb[i]; }
        __syncthreads();
#pragma unroll
        for (int eb = 0; eb < 8; ++eb)
#pragma unroll
            for (int s = 0; s < 4; ++s) oB[eb] = mfma16(*(const LAS s8v*)(ST + (16 * eb + fr) * RPAD + 32 * s + 8 * fq), qf[s], oB[eb]);
        const float qwf = expf(lgf * (float)(ipos + 1)), qwb = expf(lgb * (float)(RC - ipos));
        float sum = 0.f;
#pragma unroll
        for (int eb = 0; eb < 8; ++eb) { o0[eb] = o0[eb] + oF[eb] * qwf + oB[eb] * qwb; sum += (o0[eb][0] + o0[eb][1]) + (o0[eb][2] + o0[eb][3]); }
        sum += shfl_xor_f(sum, lane, 16); sum += shfl_xor_f(sum, lane, 32);
        const float mu = sum * (1.0f / HD); float var = 0.f;
#pragma unroll
        for (int eb = 0; eb < 8; ++eb) { o0[eb] = o0[eb] - mu; var += (o0[eb][0] * o0[eb][0] + o0[eb][1] * o0[eb][1]) + (o0[eb][2] * o0[eb][2] + o0[eb][3] * o0[eb][3]); }
        var += shfl_xor_f(var, lane, 16); var += shfl_xor_f(var, lane, 32);
        const float rs = 1.0f / sqrtf(var * (1.0f / HD) + GN_EPS);
        const bf16_t* gp = QKVb + (size_t)rowq * INW + 3 * RW + h * HD + 4 * fq; bf16_t* op = MIXb + (size_t)rowq * DM + h * HD + 4 * fq;
#pragma unroll
        for (int eb = 0; eb < 8; ++eb) { const u2v g = *(const u2v*)(gp + 16 * eb);
            u2v w; w.x = pk2(o0[eb][0] * rs * fsilu(bflo(g.x)), o0[eb][1] * rs * fsilu(bfhi(g.x))); w.y = pk2(o0[eb][2] * rs * fsilu(bflo(g.y)), o0[eb][3] * rs * fsilu(bfhi(g.y)));
            *(u2v*)(op + 16 * eb) = w; }
        __syncthreads();
    }
}
}
namespace nv {
constexpr int MCT = 16;
constexpr int NMC = (CTXL + SQ) / MCT;
constexpr int NTL = NMC / 16;
constexpr int CTL = CTXL / 256;
static_assert(CTXL % 256 == 0 && SQ % 256 == 0 && SG == 16 && SP == 64 && NG % 8 == 0, "S5 phase geometry");
constexpr int UP = 264;
constexpr int S5_LDS_LOC = ((NMC * UP * 2 + 15) / 16) * 16, LOCP = 132, S5_LDS_HIN = S5_LDS_LOC + 2 * 16 * LOCP * 4, S5_LDS_END = S5_LDS_HIN + 2 * 16 * RPAD * 2;
static_assert(S5_LDS_END <= 131072, "S5 LDS map");
__device__ __forceinline__ void ph_s5_prep1(const In& I, float* LAMP, float* BBc, int gtid, int gstride) {
    for (int idx_ = gtid; idx_ < (NL * 2 * NG * SP) * PR_PREP; idx_ += gstride) { const int idx = idx_ % (NL * 2 * NG * SP);
        const int p = idx % SP, g = (idx / SP) % NG, ld = idx / (SP * NG);
        const size_t ia = ((size_t)ld * NG + g) * SP + p;
        const double are = I.s5_a_re[ia], aim = I.s5_a_im[ia], dt = exp((double)I.s5_log_step[(size_t)ld * NG + g]);
        for (int tau = 0; tau <= 16; ++tau) { const double mag = exp(tau * are * dt), ang = tau * aim * dt;
            float* o = LAMP + ((((size_t)ld * NG + g) * 17 + tau) * SP + p) * 2; o[0] = (float)(mag * cos(ang)); o[1] = (float)(mag * sin(ang)); }
        const double mag = exp(are * dt), ang = aim * dt, abr = mag * cos(ang), abi = mag * sin(ang), den = are * are + aim * aim, nr = abr - 1.0;
        const double fr = (nr * are + abi * aim) / den, fi = (abi * are - nr * aim) / den;
        for (int c = 0; c < SG; ++c) { const double br = I.s5_b_re[ia * SG + c], bi = I.s5_b_im[ia * SG + c];
            BBc[(ia * SG + c) * 2] = (float)(fr * br - fi * bi); BBc[(ia * SG + c) * 2 + 1] = (float)(fr * bi + fi * br); }
    }
}
__device__ __forceinline__ void ph_s5_prep2a(const In& I, const float* LAMP, const float* BBc, float* KTAU, int gtid, int gstride) {
    for (int idx_ = gtid; idx_ < NL * 2 * NG * 16 * SG * PR_PREP; idx_ += gstride) { const int idx = idx_ % (NL * 2 * NG * 16 * SG);
        const int co = idx % SG, tau = (idx / SG) % 16, g = (idx / (SG * 16)) % NG, ld = idx / (SG * 16 * NG);
        const float* lam = LAMP + (((size_t)ld * NG + g) * 17 + tau) * SP * 2; const float* bb = BBc + ((size_t)ld * NG + g) * SP * SG * 2;
        const float* cr = I.s5_c_re + (((size_t)ld * NG + g) * SG + co) * SP; const float* cim = I.s5_c_im + (((size_t)ld * NG + g) * SG + co) * SP;
        float acc[SG];
#pragma unroll
        for (int ci = 0; ci < SG; ++ci) acc[ci] = 0.f;
#pragma unroll 2
        for (int p = 0; p < SP; ++p) { const float wr = cr[p] * lam[2 * p] - cim[p] * lam[2 * p + 1], wi = cr[p] * lam[2 * p + 1] + cim[p] * lam[2 * p];
            const f4* b4 = (const f4*)(bb + (size_t)p * SG * 2);
#pragma unroll
            for (int q = 0; q < SG / 2; ++q) { const f4 x = b4[q]; acc[2 * q] += wr * x.x - wi * x.y; acc[2 * q + 1] += wr * x.z - wi * x.w; } }
        f4* o = (f4*)(KTAU + (size_t)idx * SG);
#pragma unroll
        for (int q = 0; q < SG / 4; ++q) o[q] = (f4){acc[4 * q], acc[4 * q + 1], acc[4 * q + 2], acc[4 * q + 3]};
    }
}
__device__ __forceinline__ void ph_s5_prep2b(const In& I, const float* LAMP, const float* BBc, bf16_t* MINT, bf16_t* MOUT, int gtid, int gstride) {
    for (int idx_ = gtid; idx_ < NL * 2 * NG * 128 * 32 * PR_PREP; idx_ += gstride) { const int idx = idx_ % (NL * 2 * NG * 128 * 32);
        const int k8 = idx % 32, n = (idx / 32) % 128, g = (idx / (32 * 128)) % NG, ld = idx / (32 * 128 * NG), dir = ld & 1;
        const int reim = n >> 6, p = n & 63, t = k8 >> 1, ci0 = (k8 & 1) * 8, e = dir == 0 ? 15 - t : t;
        const float* lam = LAMP + ((((size_t)ld * NG + g) * 17 + e) * SP + p) * 2; const f4* b4 = (const f4*)(BBc + ((((size_t)ld * NG + g) * SP + p) * SG + ci0) * 2);
        const float lr = lam[0], li = lam[1]; float v[8];
#pragma unroll
        for (int q = 0; q < 4; ++q) { const f4 x = b4[q]; v[2 * q] = reim ? lr * x.y + li * x.x : lr * x.x - li * x.y; v[2 * q + 1] = reim ? lr * x.w + li * x.z : lr * x.z - li * x.w; }
        u4v w; w.x = pk2(v[0], v[1]); w.y = pk2(v[2], v[3]); w.z = pk2(v[4], v[5]); w.w = pk2(v[6], v[7]);
        *(u4v*)(MINT + (size_t)idx * 8) = w;
    }
    for (int idx_ = gtid; idx_ < NL * 2 * NG * 256 * 16 * PR_PREP; idx_ += gstride) { const int idx = idx_ % (NL * 2 * NG * 256 * 16);
        const int k8 = idx % 16, n2 = (idx / 16) % 256, g = (idx / (16 * 256)) % NG, ld = idx / (16 * 256 * NG), dir = ld & 1;
        const int reim = k8 >> 3, p0 = (k8 & 7) * 8, t = n2 >> 4, co = n2 & 15, f = dir == 0 ? t + 1 : 16 - t;
        const f4* l4 = (const f4*)(LAMP + ((((size_t)ld * NG + g) * 17 + f) * SP + p0) * 2);
        const f4* cr4 = (const f4*)(I.s5_c_re + (((size_t)ld * NG + g) * SG + co) * SP + p0); const f4* ci4 = (const f4*)(I.s5_c_im + (((size_t)ld * NG + g) * SG + co) * SP + p0);
        float crv[8], civ[8], v[8];
#pragma unroll
        for (int q = 0; q < 2; ++q) { const f4 a = cr4[q], b = ci4[q]; crv[4 * q] = a.x; crv[4 * q + 1] = a.y; crv[4 * q + 2] = a.z; crv[4 * q + 3] = a.w; civ[4 * q] = b.x; civ[4 * q + 1] = b.y; civ[4 * q + 2] = b.z; civ[4 * q + 3] = b.w; }
#pragma unroll
        for (int q = 0; q < 4; ++q) { const f4 x = l4[q];
            v[2 * q] = reim ? -(crv[2 * q] * x.y + civ[2 * q] * x.x) : crv[2 * q] * x.x - civ[2 * q] * x.y;
            v[2 * q + 1] = reim ? -(crv[2 * q + 1] * x.w + civ[2 * q + 1] * x.z) : crv[2 * q + 1] * x.z - civ[2 * q + 1] * x.w; }
        u4v w; w.x = pk2(v[0], v[1]); w.y = pk2(v[2], v[3]); w.z = pk2(v[4], v[5]); w.w = pk2(v[6], v[7]);
        *(u4v*)(MOUT + (size_t)idx * 8) = w;
    }
}
__device__ __forceinline__ void ph_s5_prep3(const In& I, const float* KTAU, bf16_t* KTOT, int gtid, int gstride) {
    for (int idx_ = gtid; idx_ < NL * NG * 256 * 32 * PR_PREP; idx_ += gstride) { const int idx = idx_ % (NL * NG * 256 * 32);
        const int k8 = idx % 32, n = (idx / 32) % 256, g = (idx / (32 * 256)) % NG, l = idx / (32 * 256 * NG);
        const int t = n >> 4, co = n & 15, tp = k8 >> 1, ci0 = (k8 & 1) * 8;
        float v[8];
#pragma unroll
        for (int q = 0; q < 8; ++q) v[q] = 0.f;
        if (tp <= t) { const f4* s = (const f4*)(KTAU + (((((size_t)l * 2 + 0) * NG + g) * 16 + (t - tp)) * SG + co) * SG + ci0); const f4 a = s[0], b = s[1];
            v[0] += a.x; v[1] += a.y; v[2] += a.z; v[3] += a.w; v[4] += b.x; v[5] += b.y; v[6] += b.z; v[7] += b.w; }
        if (tp >= t) { const f4* s = (const f4*)(KTAU + (((((size_t)l * 2 + 1) * NG + g) * 16 + (tp - t)) * SG + co) * SG + ci0); const f4 a = s[0], b = s[1];
            v[0] += a.x; v[1] += a.y; v[2] += a.z; v[3] += a.w; v[4] += b.x; v[5] += b.y; v[6] += b.z; v[7] += b.w; }
        if (tp == t && co >= ci0 && co < ci0 + 8) { const float dd = I.s5_d[((size_t)l * NG + g) * SG + co];
#pragma unroll
            for (int q = 0; q < 8; ++q) if (q == co - ci0) v[q] += dd; }
        u4v w; w.x = pk2(v[0], v[1]); w.y = pk2(v[2], v[3]); w.z = pk2(v[4], v[5]); w.w = pk2(v[6], v[7]);
        *(u4v*)(KTOT + (size_t)idx * 8) = w;
    }
}
__device__ __forceinline__ int s5_token(int b, int m, int t) { return m < CTXL / MCT ? b * CTXL + MCT * m + t : NCTX + b * SQ + MCT * (m - CTXL / MCT) + t; }

__device__ __forceinline__ int s5_chain_m(int dir, int c) { return dir == 0 ? c : (c < CTXL / MCT ? CTXL / MCT - 1 - c : NMC - 1 - (c - CTXL / MCT)); }
__device__ __forceinline__ void ph_s5(int l, const bf16_t* QKVb, const float* LAMP, const bf16_t* MINT, const bf16_t* MOUT, const bf16_t* KTOT, bf16_t* Zb, LAS unsigned char* lds,
                      int mt_lo, int bid, int nblk, int tid, int lane, int wave) {
    LAS bf16_t* U = (LAS bf16_t*)lds;
    const int fr = lane & 15, fq = lane >> 4;
    for (int u_ = bid; u_ < NG * NB * PR_S5; u_ += nblk) { const int u = u_ % (NG * NB);
        const int g = (u % 8) + 8 * (u / (8 * NB)), b = (u / 8) % NB;
        for (int q = tid; q < NMC * MCT * 2; q += 512) { const int half = q & 1, tok = q >> 1, m = tok / MCT, t = tok % MCT;
            *(LAS u4v*)(U + m * UP + t * 16 + 8 * half) = *(const u4v*)(QKVb + (size_t)s5_token(b, m, t) * INW + 4 * RW + g * SG + 8 * half); }
        __syncthreads();
        unsigned Lp[NTL][2][2];
        { pg8::f32x4 L[NTL][2];
#pragma unroll
            for (int mt = 0; mt < NTL; ++mt) { L[mt][0] = (pg8::f32x4){0.f, 0.f, 0.f, 0.f}; L[mt][1] = L[mt][0]; }
            const int ldir = wave >> 2; const bf16_t* mi = MINT + ((((size_t)l * 2 + ldir) * NG + g) * 128 + 32 * (wave & 3) + fr) * 256 + 8 * fq;
            s8v bm0 = *(const s8v*)mi, bm1 = *(const s8v*)(mi + 16 * 256);
#pragma unroll 1
            for (int s = 0; s < 8; ++s) { const int sn = s < 7 ? s + 1 : 7; const s8v nm0 = *(const s8v*)(mi + 32 * sn), nm1 = *(const s8v*)(mi + 16 * 256 + 32 * sn);
#pragma unroll
                for (int mt = 0; mt < NTL; ++mt) { const s8v a = *(const LAS s8v*)(U + (16 * mt + fr) * UP + 32 * s + 8 * fq); L[mt][0] = mfma16(a, bm0, L[mt][0]); L[mt][1] = mfma16(a, bm1, L[mt][1]); }
                bm0 = nm0; bm1 = nm1; }
#pragma unroll
            for (int mt = 0; mt < NTL; ++mt)
#pragma unroll
                for (int c = 0; c < 2; ++c) { Lp[mt][c][0] = pk2(L[mt][c][0], L[mt][c][1]); Lp[mt][c][1] = pk2(L[mt][c][2], L[mt][c][3]); } }
        pg8::f32x4 Y[NTL][2];
#pragma unroll
        for (int mt = 0; mt < NTL; ++mt) { Y[mt][0] = (pg8::f32x4){0.f, 0.f, 0.f, 0.f}; Y[mt][1] = Y[mt][0]; }
        { const bf16_t* kt = KTOT + (((size_t)l * NG + g) * 256 + 32 * wave + fr) * 256 + 8 * fq;
            s8v bk0 = *(const s8v*)kt, bk1 = *(const s8v*)(kt + 16 * 256);
#pragma unroll 1
            for (int s = 0; s < 8; ++s) { const int sn = s < 7 ? s + 1 : 7; const s8v nk0 = *(const s8v*)(kt + 32 * sn), nk1 = *(const s8v*)(kt + 16 * 256 + 32 * sn);
#pragma unroll
                for (int mt = 0; mt < NTL; ++mt) { const s8v a = *(const LAS s8v*)(U + (16 * mt + fr) * UP + 32 * s + 8 * fq); Y[mt][0] = mfma16(a, bk0, Y[mt][0]); Y[mt][1] = mfma16(a, bk1, Y[mt][1]); }
                bk0 = nk0; bk1 = nk1; } }
        __syncthreads();
        int fr2 = fr, fq2 = fq; asm volatile("" : "+v"(fr2), "+v"(fq2));
#pragma unroll
        for (int mt = 0; mt < NTL; ++mt)
#pragma unroll
            for (int c = 0; c < 2; ++c)
#pragma unroll
                for (int r = 0; r < 4; ++r) { const unsigned w = Lp[mt][c][r >> 1]; U[(16 * mt + 4 * fq2 + r) * UP + 32 * wave + 16 * c + fr2] = (bf16_t)((r & 1) ? (w >> 16) : (w & 0xffffu)); }
        __syncthreads();
        int tid2 = tid; asm volatile("" : "+v"(tid2));
        if (tid2 < 128) { const int dir = tid2 >> 6, p = tid2 & 63; const float* lam = LAMP + (((((size_t)l * 2 + dir) * NG + g) * 17 + 16) * SP + p) * 2; const float l16r = lam[0], l16i = lam[1];
            float hre = 0.f, him = 0.f; LAS bf16_t* col = U + dir * 128 + p;
#pragma unroll 1
            for (int c0 = 0; c0 < NMC; c0 += 16) { float lr[16], li[16];
#pragma unroll
                for (int i = 0; i < 16; ++i) { const int m = s5_chain_m(dir, c0 + i); lr[i] = bf2f(col[m * UP]); li[i] = bf2f(col[m * UP + 64]); }
#pragma unroll
                for (int i = 0; i < 16; ++i) { const int m = s5_chain_m(dir, c0 + i); col[m * UP] = (bf16_t)f2bf_u(hre); col[m * UP + 64] = (bf16_t)f2bf_u(him);
                    const float nr = l16r * hre - l16i * him + lr[i], ni = l16r * him + l16i * hre + li[i]; hre = nr; him = ni; } } }
        __syncthreads();
        int fr3 = fr, fq3 = fq; asm volatile("" : "+v"(fr3), "+v"(fq3));
#pragma unroll
        for (int dir = 0; dir < 2; ++dir) { const bf16_t* mo = MOUT + ((((size_t)l * 2 + dir) * NG + g) * 256 + 32 * wave + fr3) * 128 + 8 * fq3;
            s8v b0 = *(const s8v*)mo, b1 = *(const s8v*)(mo + 16 * 128);
#pragma unroll 1
            for (int s = 0; s < 4; ++s) { const int sn = s < 3 ? s + 1 : 3; const s8v n0 = *(const s8v*)(mo + 32 * sn), n1 = *(const s8v*)(mo + 16 * 128 + 32 * sn);
#pragma unroll
                for (int mt = 0; mt < NTL; ++mt) { const s8v a = *(const LAS s8v*)(U + (16 * mt + fr3) * UP + dir * 128 + 32 * s + 8 * fq3); Y[mt][0] = mfma16(a, b0, Y[mt][0]); Y[mt][1] = mfma16(a, b1, Y[mt][1]); }
                b0 = n0; b1 = n1; } }
        int fr4 = fr, fq4 = fq; asm volatile("" : "+v"(fr4), "+v"(fq4));
#pragma unroll
        for (int mt = 0; mt < NTL; ++mt) { if (mt < mt_lo) continue;
#pragma unroll
            for (int c = 0; c < 2; ++c)
#pragma unroll
                for (int r = 0; r < 4; ++r) { const int m = 16 * mt + 4 * fq4 + r, t = 2 * wave + c;
                    Zb[(size_t)s5_token(b, m, t) * SW + g * SG + fr4] = (bf16_t)f2bf_u(gelu_tanh_f(Y[mt][c][r])); } }
        __syncthreads();
    }
}
}
namespace nv {
constexpr int MK_THREADS = 512;
constexpr int MK_LDS_BYTES = 147456;
constexpr int MK_LDS_MISC = 131072;
constexpr int MK_LDS_TAB = MK_LDS_MISC + 64;
constexpr int MK_LDS_PST = MK_LDS_TAB + 1024;

struct EpiF32N {
    static constexpr bool PERM = false, AFTER_DRAIN = false;
    float* C; int ldc; int ncol;
    __device__ __forceinline__ void operator()(const pg8::f32x4 (&acc)[2][2][4][2], const pg8::Unit& u, int wr, int wc, int fr, int fq) const {
        const int row0 = u.pm * 128 + wr * 64 + fr, col0 = (u.pn % ncol) * 256 + wc * 32 + 4 * fq;
#pragma unroll
        for (int ai = 0; ai < 2; ++ai)
#pragma unroll
            for (int m = 0; m < 4; ++m) { if (ai == 1 && u.half) continue; float* rowp = C + (size_t)(row0 + ai * 128 + m * 16) * ldc + col0;
#pragma unroll
                for (int bj = 0; bj < 2; ++bj)
#pragma unroll
                    for (int n = 0; n < 2; ++n) *(pg8::f32x4*)(rowp + bj * 128 + n * 16) = acc[ai][bj][m][n]; }
    }
};
struct MoeOrder {
    const LAS int* tab; int ncol, G, v, nfu, nhu, exr, nfr, nf, j, nb, p1;
    __device__ __forceinline__ void init(const LAS int* tab_, int ncol_, int G_, int c_) {
        tab = tab_; ncol = ncol_; G = G_; v = (G_ % 8 == 0) ? (c_ % 8) * (G_ / 8) + c_ / 8 : c_;
        nfr = tab_[0]; const int nhr = tab_[1]; int uf = nfr * ncol_, uh = nhr * ncol_; exr = 0;
        { const int a = uf / G_, ex = uf % G_;
          if (ex > 0) { const int keep = 2 * (a + 1) + (uh > 2 * (G_ - ex) ? (uh - 2 * (G_ - ex) + G_ - 1) / G_ : 0), dem = 2 * a + (uh + 2 * ex + G_ - 1) / G_;
              if (dem < keep) { exr = ex / ncol_; uf -= ex; uh += 2 * ex; } } }
        nfu = uf; nhu = uh;
        const int r = nfu % G_; nf = nfu / G_ + (v < r ? 1 : 0);
        nb = G_ - r; j = v - r; p1 = 0;
        if (j >= 0) { const int lim = nhu < 2 * nb ? nhu : 2 * nb; p1 = (j < lim ? 1 : 0) + (j + nb < lim ? 1 : 0); }
    }
    __device__ __forceinline__ void half_unit(int hu, pg8::Unit& u) const {
        const int hr = hu / ncol, jc = hu % ncol; int en, part = 0;
        if (hr < 2 * exr) { en = tab[2 + (nfr - exr) + hr / 2]; part = hr & 1; } else en = tab[2 + nfr + (hr - 2 * exr)];
        u.pm = (en & 0xffff) + part; u.pn = ((en >> 16) & 0xff) * ncol + jc; u.half = 1;
    }
    __device__ __forceinline__ bool next(int i, pg8::Unit& u) const {
        if (i < nf) { const int fu = v + i * G; const int en = tab[2 + fu / ncol]; u.pm = en & 0xffff; u.pn = ((en >> 16) & 0xff) * ncol + fu % ncol; u.half = 0; return true; }
        int k = i - nf;
        if (k < p1) { half_unit(j + k * nb, u); return true; }
        k -= p1;
        const int hu = 2 * nb + v + k * G;
        if (nhu > 2 * nb && hu < nhu) { half_unit(hu, u); return true; }
        return false;
    }
    __device__ __forceinline__ void a_ready(const pg8::Unit&) const {}
    __device__ __forceinline__ void done(const pg8::Unit&) const {}
};
constexpr int I_IN = (DM / 64) * (INW / 32), I_GLU = (SW / 64) * (SW / 32), I_OUT = (DM / 64) * (DM / 32), I_G = (DM / 64) * (EFF / 32), I_D = (EFF / 64) * (DM / 32);
constexpr int NITEMS_L = I_IN + I_GLU + I_OUT + NE * (2 * I_G + I_D);
__device__ __forceinline__ void wcvt_item(const In& I, int l, unsigned char* ws, LAS float* scr, int it, int lane) {
    int r = it;
    if (r < I_IN) { p0_transpose_item(I.w_in + (size_t)l * DM * INW, DM, INW, (bf16*)(ws + OFF_WIN), 0, scr, r, lane); return; } r -= I_IN;
    if (r < I_GLU) { p0_transpose_item(I.s5_glu_w + (size_t)l * SW * SW, SW, SW, (bf16*)(ws + OFF_WGLU), 0, scr, r, lane); return; } r -= I_GLU;
    if (r < I_OUT) { p0_transpose_item(I.w_out + (size_t)l * DM * DM, DM, DM, (bf16*)(ws + OFF_WOUT), 0, scr, r, lane); return; } r -= I_OUT;
    const int e = r / (2 * I_G + I_D); r -= e * (2 * I_G + I_D);
    bf16* wgu = (bf16*)(ws + OFF_WGU) + (size_t)e * 2 * EFF * DM; bf16* wd = (bf16*)(ws + OFF_WD) + (size_t)e * DM * EFF;
    if (r < 2 * I_G) { const int up = r >= I_G ? 1 : 0; r -= up * I_G; const int n0 = 32 * (r % (EFF / 32));
        p0_transpose_item((up ? I.exp_w_up : I.exp_w_gate) + ((size_t)l * NE + e) * DM * EFF, DM, EFF, wgu, (n0 / 128) * 128 + up * 128, scr, r, lane); return; }
    r -= 2 * I_G;
    p0_transpose_item(I.exp_w_down + ((size_t)l * NE + e) * EFF * DM, EFF, DM, wd, 0, scr, r, lane);
}
__device__ __forceinline__ void wcvt_item_l0(const In& I, unsigned char* ws, LAS float* scr, int it, int lane) { wcvt_item(I, 0, ws, scr, it, lane); }
__device__ __forceinline__ void d_wcvt(const In& I, int l, unsigned char* ws, LAS unsigned char* lds, int gw, int ngw, int wave, int lane) {
    LAS float* scr = (LAS float*)(lds + wave * 16384);
    for (int it_ = gw; it_ < NITEMS_L * PR_WCVT; it_ += ngw) wcvt_item(I, l, ws, scr, it_ % NITEMS_L, lane);
}

typedef const __attribute__((address_space(4))) Params* KP;
#define KPARAMS() ({ KP kp_ = (KP)__builtin_amdgcn_kernarg_segment_ptr(); asm volatile("" : "+s"(kp_)); kp_; })
#define IN_FIELDS(F) F(x) F(c) F(ctx) F(c_ctx) F(ada_w) F(ada_b) F(norm1_g) F(w_in) F(ret_decay) F(s5_a_re) F(s5_a_im) F(s5_log_step) F(s5_b_re) F(s5_b_im) \
    F(s5_c_re) F(s5_c_im) F(s5_d) F(s5_glu_w) F(s5_glu_b) F(w_out) F(norm2_g) F(router_grp_w) F(router_grp_b) F(router_exp_w) F(router_exp_b) \
    F(exp_w_gate) F(exp_w_up) F(exp_w_down) F(final_g)
__device__ __forceinline__ In load_in(KP kp) { In I;
#define F(n) I.n = kp->I.n;
    IN_FIELDS(F)
#undef F
    return I; }

__global__ void __launch_bounds__(MK_THREADS, 2) k_mega(Params p_unused) {
#ifdef HOST_EMU2
    unsigned char* lds_raw = emu::block_lds();
#else
    extern __shared__ __attribute__((aligned(16))) unsigned char lds_raw[];
#endif
    LAS unsigned char* lds = (LAS unsigned char*)lds_raw;
    const int tid0 = threadIdx.x;
    if (tid0 < 16) ((LAS unsigned*)(lds + MK_LDS_MISC))[tid0] = 0u;
    __syncthreads();
    XcdBarrier bar;
    { KP kp = KPARAMS(); bar = xcd_barrier_post((unsigned*)(kp->ws + OFF_BAR), (volatile LAS unsigned*)(lds + MK_LDS_MISC)); }
    const int bid = blockIdx.x, nblk = gridDim.x, gstride = nblk * MK_THREADS, wave0 = __builtin_amdgcn_readfirstlane(tid0 >> 6);
    const int ngw = nblk * 8;
#define BAR() do { XcdBarrier b_ = bar; asm volatile("" : "+s"(b_.x)); xcd_barrier(b_); } while (0)
#ifdef HOST_EMU2
#define LANE_ID(v) int v = threadIdx.x & 63
#else
#define LANE_ID(v) int v; asm volatile("v_mbcnt_lo_u32_b32 %0, -1, 0\n\tv_mbcnt_hi_u32_b32 %0, -1, %0" : "=v"(v))
#endif
#define PH_BEGIN { KP kp = KPARAMS(); unsigned char* ws = kp->ws; const In I = load_in(kp); (void)I; (void)ws; LANE_ID(lane); \
        const int wave = wave0, tid = wave0 * 64 + lane, gtid = bid * MK_THREADS + tid, gw = bid * 8 + wave; (void)tid; (void)gtid; (void)lane; (void)wave; (void)gw;
#define PH_END }
#define WSF(off) ((float*)(ws + (off)))
#define WSB(off) ((bf16_t*)(ws + (off)))
#define WSI(off) ((int*)(ws + (off)))
#define LTAB ((LAS int*)(lds + MK_LDS_TAB))
#define LPST ((LAS int*)(lds + MK_LDS_PST))
    PH_BEGIN { LAS float* scond = (LAS float*)lds;
        for (int i = tid; i < NCOND * DM; i += MK_THREADS) { const int j = i / DM, k = i % DM; scond[i] = silu_f(j < NB ? I.c[j * DM + k] : I.c_ctx[k]); }
        __syncthreads();
        ph_adaln_part(I, WSF(OFF_PART), scond, gw, ngw, lane);
        __syncthreads(); } PH_END
    PH_BEGIN if (wave < 6) { LAS float* scr = (LAS float*)(lds + wave * 16384); for (int it_ = bid * 6 + wave; it_ < NITEMS_L * PR_WCVT; it_ += nblk * 6) wcvt_item_l0(I, ws, scr, it_ % NITEMS_L, lane); }
      else { const int g2 = bid * 128 + (wave - 6) * 64 + lane, s2 = nblk * 128; ph_prep(I, WSF(OFF_RWT), g2, s2); ph_rope_table(WSF(OFF_ROPE), g2, s2); ph_s5_prep1(I, WSF(OFF_LAMP), WSF(OFF_BBC), g2, s2); } PH_END
    BAR();
    PH_BEGIN ph_adaln_reduce(I, WSF(OFF_PART), WSF(OFF_MOD), gtid, gstride); PH_END
    PH_BEGIN ph_s5_prep2a(I, WSF(OFF_LAMP), WSF(OFF_BBC), WSF(OFF_KTAU), gtid, gstride); PH_END
    BAR();
    for (int l = 0; l < NL; ++l) {
        const int row_lo = (l == NL - 1) ? NCTX : 0;
        if (l > 0) BAR();
        for (int q_ = 0; q_ < PR_BAR; ++q_) BAR();
        if (l > 0) { PH_BEGIN d_wcvt(I, l, ws, lds, gw, ngw, wave, lane); PH_END }
        if (l == 0) { PH_BEGIN ph_norm1<0>(I, l, WSF(OFF_MOD), WSF(OFF_X), WSB(OFF_YB), WSI(OFF_TS), WSF(OFF_TG), WSB(OFF_HB), nullptr, gw, ngw, lane); PH_END }
        else        { PH_BEGIN ph_norm1<1>(I, l, WSF(OFF_MOD), WSF(OFF_X), WSB(OFF_YB), WSI(OFF_TS), WSF(OFF_TG), WSB(OFF_HB), nullptr, gw, ngw, lane); PH_END }
        BAR();
        PH_BEGIN pg8::Gemm g{WSB(OFF_HB), WSB(OFF_WIN), NTOK, INW, DM}; pg8::StaticOrder S; S.init(NTOK, INW, nblk, bid); EpiQKV E{WSB(OFF_QKVB), WSF(OFF_ROPE)};
          pg8::gemm_phase<EpiQKV, pg8::StaticOrder, true, true>(lds, g, S, E, tid); PH_END
        BAR();
        PH_BEGIN ph_ret_kv(I, l, WSB(OFF_QKVB), WSB(OFF_KVT), lds, bid, nblk, tid, lane, wave); PH_END
        if (l == 0) { PH_BEGIN const int nu = NB * NH * NCH, f = nu % nblk == 0 ? 0 : nu % nblk;
            if (bid >= f) { ph_s5_prep2b(I, WSF(OFF_LAMP), WSF(OFF_BBC), WSB(OFF_MINT), WSB(OFF_MOUT), (bid - f) * MK_THREADS + tid, (nblk - f) * MK_THREADS);
                ph_s5_prep3(I, WSF(OFF_KTAU), WSB(OFF_KTOT), (bid - f) * MK_THREADS + tid, (nblk - f) * MK_THREADS); } PH_END }
        BAR();
        PH_BEGIN ph_ret_scan(I, l, WSB(OFF_KVT), WSB(OFF_STT), gtid, gstride); PH_END
        PH_BEGIN ph_s5(l, WSB(OFF_QKVB), WSF(OFF_LAMP), WSB(OFF_MINT), WSB(OFF_MOUT), WSB(OFF_KTOT), WSB(OFF_ZB), lds, (l == NL - 1) ? CTL : 0, bid, nblk, tid, lane, wave); PH_END
        BAR();
        PH_BEGIN ph_ret_out(I, l, WSB(OFF_QKVB), WSB(OFF_STT), WSB(OFF_MIXB), lds, (l == NL - 1) ? CC : 0, bid, nblk, tid, lane, wave); PH_END
        PH_BEGIN const int nru = NB * NH * (NCH - ((l == NL - 1) ? CC : 0)), shift = nru % nblk;
          pg8::Gemm g{WSB(OFF_ZB), WSB(OFF_WGLU), NTOK, SW, SW}; pg8::StaticOrder S; S.init(NTOK, SW, nblk, (bid - shift + nblk) % nblk);
          EpiGlu E{WSB(OFF_MIXB), DM, RW, WSB(OFF_ZB), SW, I.s5_glu_b + (size_t)l * SW};
          pg8::gemm_phase<EpiGlu, pg8::StaticOrder, true, true>(lds, g, S, E, tid); PH_END
        BAR();
        PH_BEGIN const int rbase = (l == NL - 1) ? NCTX : 0;
          pg8::Gemm g{WSB(OFF_MIXB) + (size_t)rbase * DM, WSB(OFF_WOUT), NTOK - rbase, DM, DM}; pg8::StaticOrder S; S.init(NTOK - rbase, DM, nblk, bid); if (l > 0) S.rep = 1;
          EpiResid E{WSF(OFF_X), l == 0 ? I.ctx : WSF(OFF_X), l == 0 ? I.x : WSF(OFF_X) + (size_t)NCTX * DM, WSF(OFF_MOD), l, rbase};
          pg8::gemm_phase<EpiResid, pg8::StaticOrder, true, true>(lds, g, S, E, tid); PH_END
        BAR();
        PH_BEGIN ph_route(I, l, WSF(OFF_MOD), WSF(OFF_X), WSF(OFF_RWT), WSI(OFF_TE), WSF(OFF_TG), WSF(OFF_RSTD), WSI(OFF_TP), WSI(OFF_HIST), lds, row_lo, bid, nblk, tid, lane, wave); PH_END
        BAR();
        PH_BEGIN ph_gather(I, l, WSF(OFF_MOD), WSF(OFF_X), WSF(OFF_RSTD), WSI(OFF_TE), WSI(OFF_TP), WSI(OFF_HIST), WSI(OFF_TS), WSB(OFF_XG), lds, LTAB, LPST, row_lo, bid, nblk, tid, lane, wave); PH_END
        BAR();
        PH_BEGIN pg8::Gemm g{WSB(OFF_XG), WSB(OFF_WGU), 0, 0, DM}; MoeOrder S; S.init(LTAB, (2 * EFF) / 256, nblk, bid); EpiAct E{WSB(OFF_ACTB), EFF, (2 * EFF) / 256};
          pg8::gemm_phase<EpiAct, MoeOrder, true, true>(lds, g, S, E, tid); PH_END
        BAR();
        PH_BEGIN pg8::Gemm g{WSB(OFF_ACTB), WSB(OFF_WD), 0, 0, EFF}; MoeOrder S; S.init(LTAB, DM / 256, nblk, bid); EpiBf16N E{WSB(OFF_YB), DM, DM / 256};
          pg8::gemm_phase<EpiBf16N, MoeOrder, true, true>(lds, g, S, E, tid); PH_END
    }
    BAR();
    PH_BEGIN ph_norm1<2>(I, NL, WSF(OFF_MOD), WSF(OFF_X), WSB(OFF_YB), WSI(OFF_TS), WSF(OFF_TG), nullptr, kp->out, gw, ngw, lane); PH_END
#undef BAR
}
}
#endif

static nv::Params make_params(void* const* d_in, void* d_out, void* d_ws) {
    nv::Params p{};
    const float** f = (const float**)&p.I;
    for (int i = 0; i < 29; ++i) f[i] = (const float*)d_in[i];
    p.out = (float*)d_out; p.ws = (unsigned char*)d_ws;
    return p;
}

extern "C" void kernel_launch(void* const* d_in, const int* in_sizes, int n_in, void* d_out, int out_size, void* d_ws, size_t ws_size, hipStream_t stream) {
    using namespace nv;
    (void)in_sizes; (void)out_size;
    Params p = make_params(d_in, d_out, d_ws);
#if defined(HOST_EMU2)
    (void)n_in; (void)ws_size; (void)stream;
    memset((char*)d_ws + OFF_CTL, 0, SZ_CTL + SZ_BAR);
    static Params pk; pk = p; emu_kernarg = &pk;
    emu::run_grid([]() { k_mega(pk); }, EMU_GRID, MK_THREADS, MK_LDS_BYTES);
#elif !defined(HOST_EMU)
    static int grid = 0;
    if (grid == 0) {
        if (n_in != 29 || ws_size < WS_NEED) { fprintf(stderr, "kernel_launch: n_in %d ws %zu need %zu\n", n_in, ws_size, (size_t)WS_NEED); grid = -1; return; }
        int dev = 0, cus = 0, per_cu = 0;
        if (hipGetDevice(&dev) != hipSuccess || hipDeviceGetAttribute(&cus, hipDeviceAttributeMultiprocessorCount, dev) != hipSuccess) { grid = -1; return; }
        if (hipFuncSetAttribute((const void*)k_mega, hipFuncAttributeMaxDynamicSharedMemorySize, MK_LDS_BYTES) != hipSuccess) { fprintf(stderr, "kernel_launch: hipFuncSetAttribute failed\n"); grid = -1; return; }
        if (hipOccupancyMaxActiveBlocksPerMultiprocessor(&per_cu, (const void*)k_mega, MK_THREADS, MK_LDS_BYTES) != hipSuccess || per_cu < 1) { fprintf(stderr, "kernel_launch: occupancy query says %d\n", per_cu); grid = -1; (void)hipGetLastError(); return; }
        (void)hipGetLastError();
        grid = cus;
    }
    if (grid < 0) return;
    (void)hipMemsetAsync((char*)d_ws + OFF_CTL, 0, SZ_CTL + SZ_BAR, stream);
    hipLaunchKernelGGL(k_mega, dim3(grid), dim3(MK_THREADS), MK_LDS_BYTES, stream, p);
#endif
}
```

```cpp
#ifdef HOST_EMU
#include <cstdio>
#include <cstdlib>
#include <cstring>
#include <cmath>
#include <vector>
#include <cstdint>
#define __global__
#define __device__
#define __host__
#define __forceinline__ inline
#define __launch_bounds__(...)
struct emu_dim3 { unsigned x, y, z; };
static emu_dim3 threadIdx = {0, 0, 0}, blockIdx = {0, 0, 0}, blockDim = {1, 1, 1}, gridDim = {1, 1, 1};
static inline int atomicAdd(int* p, int v) { int o = *p; *p += v; return o; }
typedef void* hipStream_t;
static inline void __syncthreads() {}
#else
#include <hip/hip_runtime.h>
#include <cstdio>
#include <cstdint>
#endif

#ifndef D_MODEL
#define D_MODEL 2048
#define BATCH 4
#define SEQ 2048
#define DEPTH 2
#define GRID_W 64
#define CTX_LEN 256
#define RET_HEADS 8
#define RET_CHUNK 128
#define S5_GROUP 16
#define S5_STATE 64
#define N_EXPERT_GROUPS 4
#define EXPERTS_PER_GROUP 8
#define EXPERT_FF 512
#endif

namespace nv {
constexpr int DM = D_MODEL, NB = BATCH, SQ = SEQ, CTXL = CTX_LEN, NL = DEPTH, GW = GRID_W;
constexpr int RW = DM / 2, SW = DM - RW, NH = RET_HEADS, HD = RW / NH, RC = RET_CHUNK;
constexpr int SG = S5_GROUP, NG = SW / SG, SP = S5_STATE;
constexpr int INW = 4 * RW + SW;
constexpr int NEG = N_EXPERT_GROUPS, EPG = EXPERTS_PER_GROUP, NE = NEG * EPG, EFF = EXPERT_FF;
constexpr int NMOD = 6;
constexpr int NCTX = NB * CTXL, NLAT = NB * SQ, NTOK = NCTX + NLAT;
constexpr int CC = CTXL / RC, LC = SQ / RC, NCH = CC + LC;
constexpr int NCOND = NB + 1;
constexpr float NORM_EPS = 1e-6f, GN_EPS = 1e-5f;
constexpr int MOE_TILE = 128;
constexpr int MOE_CAP = ((2 * NTOK + NE * (MOE_TILE - 1)) / MOE_TILE) * MOE_TILE + MOE_TILE;

struct In {
    const float *x, *c, *ctx, *c_ctx, *ada_w, *ada_b, *norm1_g, *w_in, *ret_decay, *s5_a_re, *s5_a_im, *s5_log_step, *s5_b_re, *s5_b_im,
        *s5_c_re, *s5_c_im, *s5_d, *s5_glu_w, *s5_glu_b, *w_out, *norm2_g, *router_grp_w, *router_grp_b, *router_exp_w, *router_exp_b,
        *exp_w_gate, *exp_w_up, *exp_w_down, *final_g;
};

typedef unsigned short bf16_t;
__device__ __forceinline__ bf16_t f2bf(float f) { unsigned u; __builtin_memcpy(&u, &f, 4); u = (u + 0x7fffu + ((u >> 16) & 1u)) >> 16; return (bf16_t)u; }
__device__ __forceinline__ float nbf2f(bf16_t b) { unsigned u = ((unsigned)b) << 16; float f; __builtin_memcpy(&f, &u, 4); return f; }
__device__ __forceinline__ float silu_f(float v) { return v / (1.0f + expf(-v)); }
__device__ __forceinline__ float sigmoid_f(float v) { return 1.0f / (1.0f + expf(-v)); }
__device__ __forceinline__ float gelu_tanh_f(float v) { return 0.5f * v * (1.0f + tanhf(0.7978845608028654f * (v + 0.044715f * v * v * v))); }
__device__ __forceinline__ int cond_of_row(int r) { return r < NCTX ? NB : (r - NCTX) / SQ; }
__device__ __forceinline__ int row_of(int b, int n, int p) { return n < CC ? b * CTXL + n * RC + p : NCTX + b * SQ + (n - CC) * RC + p; }
__device__ __forceinline__ void bnp_of_row(int r, int& b, int& n, int& p) {
    if (r < NCTX) { b = r / CTXL; const int t = r % CTXL; n = t / RC; p = t % RC; }
    else { const int q = r - NCTX; b = q / SQ; const int t = q % SQ; n = CC + t / RC; p = t % RC; }
}
#define MODV(MOD, l, j, m) ((MOD) + ((size_t)((l) * NCOND + (j)) * NMOD + (m)) * DM)

__device__ __forceinline__ void d_adaln(const In& I, float* MOD, long gtid, long gstride) {
    for (long idx = gtid; idx < (long)NL * NMOD * DM; idx += gstride) {
        const int l = (int)(idx / (NMOD * DM)), n = (int)(idx % (NMOD * DM));
        float acc[NCOND];
#pragma unroll
        for (int j = 0; j < NCOND; ++j) acc[j] = 0.f;
        const float* w = I.ada_w + (size_t)l * DM * NMOD * DM + n;
        for (int k = 0; k < DM; ++k) {
            const float wv = w[(size_t)k * NMOD * DM];
#pragma unroll
            for (int j = 0; j < NB; ++j) acc[j] += silu_f(I.c[j * DM + k]) * wv;
            acc[NB] += silu_f(I.c_ctx[k]) * wv;
        }
        const float bv = I.ada_b[(size_t)l * NMOD * DM + n];
#pragma unroll
        for (int j = 0; j < NCOND; ++j) MOD[(size_t)(l * NCOND + j) * NMOD * DM + n] = acc[j] + bv;
    }
}
__device__ __forceinline__ void d_copy_x(const In& I, float* X, long gtid, long gstride) {
    for (long idx = gtid; idx < (long)NTOK * DM; idx += gstride) {
        const int r = (int)(idx / DM), j = (int)(idx % DM);
        X[idx] = r < NCTX ? I.ctx[(size_t)r * DM + j] : I.x[(size_t)(r - NCTX) * DM + j];
    }
}
__device__ __forceinline__ void d_norm_mod(const float* X, const float* g, const float* MOD, int l, int mshift, int mscale, float* H, bf16_t* Hb, long gtid, long gstride) {
    for (long r = gtid; r < NTOK; r += gstride) {
        const float* xr = X + (size_t)r * DM; float ss = 0.f;
        for (int j = 0; j < DM; ++j) ss += xr[j] * xr[j];
        const float rs = 1.0f / sqrtf(ss / DM + NORM_EPS);
        const int cj = cond_of_row((int)r);
        const float* sh = MODV(MOD, l, cj, mshift); const float* sc = MODV(MOD, l, cj, mscale);
        for (int j = 0; j < DM; ++j) { const float v = xr[j] * rs * g[j] * (1.0f + sc[j]) + sh[j]; H[(size_t)r * DM + j] = v; if (Hb) Hb[(size_t)r * DM + j] = f2bf(v); }
    }
}
__device__ __forceinline__ void d_rope(float* QKV, long gtid, long gstride) {
    const float kscale = 1.0f / sqrtf((float)HD);
    constexpr int NF = HD / 4;
    for (long idx = gtid; idx < (long)NTOK * 2 * NH * (HD / 2); idx += gstride) {
        const int i = (int)(idx % (HD / 2)); long t = idx / (HD / 2);
        const int h = (int)(t % NH); t /= NH; const int which = (int)(t % 2); const int r = (int)(t / 2);
        float* p = QKV + (size_t)r * INW + which * RW + h * HD + 2 * i;
        float t0 = p[0], t1 = p[1];
        if (r >= NCTX) {
            const int pos = (r - NCTX) % SQ, rowp = pos / GW, colp = pos % GW;
            const int f = i < NF ? i : i - NF;
            const float inv = powf(10000.0f, -(float)f / (float)NF);
            const float ang = (i < NF ? (float)rowp : (float)colp) * inv;
            const float cs = cosf(ang), sn = sinf(ang);
            const float a = t0 * cs - t1 * sn, b = t0 * sn + t1 * cs; t0 = a; t1 = b;
        }
        if (which == 1) { t0 *= kscale; t1 *= kscale; }
        p[0] = t0; p[1] = t1;
    }
}
__device__ __forceinline__ float logg(const In& I, int l, int dir, int h) { return -expf(I.ret_decay[(l * 2 + dir) * NH + h]); }
__device__ __forceinline__ void d_ret_kv(const In& I, int l, const float* QKV, float* KV, long gtid, long gstride) {
    for (long idx = gtid; idx < (long)2 * NB * NH * NCH * HD * HD; idx += gstride) {
        const int e = (int)(idx % HD); long t = idx / HD; const int d = (int)(t % HD); t /= HD; const int n = (int)(t % NCH); t /= NCH;
        const int h = (int)(t % NH); t /= NH; const int b = (int)(t % NB); const int dir = (int)(t / NB);
        const float lg = logg(I, l, dir, h); float acc = 0.f;
        for (int p = 0; p < RC; ++p) {
            const int row = row_of(b, n, p);
            const float w = expf(lg * (float)(dir == 0 ? RC - 1 - p : p));
            acc += w * QKV[(size_t)row * INW + RW + h * HD + d] * QKV[(size_t)row * INW + 2 * RW + h * HD + e];
        }
        KV[idx] = acc;
    }
}
__device__ __forceinline__ int chain_chunk(int dir, int step) { return dir == 0 ? step : (step < CC ? CC - 1 - step : NCH - 1 - (step - CC)); }
__device__ __forceinline__ void d_ret_scan(const In& I, int l, const float* KV, float* ST, long gtid, long gstride) {
    for (long idx = gtid; idx < (long)2 * NB * NH * HD * HD; idx += gstride) {
        const int de = (int)(idx % (HD * HD)); long t = idx / (HD * HD); const int h = (int)(t % NH); t /= NH; const int b = (int)(t % NB); const int dir = (int)(t / NB);
        const float dec = expf(logg(I, l, dir, h) * (float)RC); float s = 0.f;
        for (int step = 0; step < NCH; ++step) {
            const int n = chain_chunk(dir, step);
            const size_t o = ((((size_t)dir * NB + b) * NH + h) * NCH + n) * HD * HD + de;
            ST[o] = s; s = dec * s + KV[o];
        }
    }
}
__device__ __forceinline__ void d_ret_scores(const In& I, int l, const float* QKV, float* SC, long gtid, long gstride) {
    for (long idx = gtid; idx < (long)NTOK * NH * RC; idx += gstride) {
        const int j = (int)(idx % RC); long t = idx / RC; const int h = (int)(t % NH); const int r = (int)(t / NH);
        int b, n, p; bnp_of_row(r, b, n, p);
        const int rj = row_of(b, n, j);
        const float* q = QKV + (size_t)r * INW + h * HD; const float* k = QKV + (size_t)rj * INW + RW + h * HD;
        float dot = 0.f;
        for (int d = 0; d < HD; ++d) dot += q[d] * k[d];
        const float D = j <= p ? expf(logg(I, l, 0, h) * (float)(p - j)) : expf(logg(I, l, 1, h) * (float)(j - p));
        SC[idx] = dot * D;
    }
}
__device__ __forceinline__ void d_ret_out(const In& I, int l, const float* QKV, const float* SC, const float* ST, float* RO, long gtid, long gstride) {
    for (long idx = gtid; idx < (long)NTOK * NH * HD; idx += gstride) {
        const int e = (int)(idx % HD); long t = idx / HD; const int h = (int)(t % NH); const int r = (int)(t / NH);
        int b, n, p; bnp_of_row(r, b, n, p);
        float acc = 0.f;
        const float* sc = SC + ((size_t)r * NH + h) * RC;
        for (int j = 0; j < RC; ++j) acc += sc[j] * QKV[(size_t)row_of(b, n, j) * INW + 2 * RW + h * HD + e];
        const float qwf = expf(logg(I, l, 0, h) * (float)(p + 1)), qwb = expf(logg(I, l, 1, h) * (float)(RC - p));
        const float* sf = ST + ((((size_t)0 * NB + b) * NH + h) * NCH + n) * HD * HD + e;
        const float* sb = ST + ((((size_t)1 * NB + b) * NH + h) * NCH + n) * HD * HD + e;
        const float* q = QKV + (size_t)r * INW + h * HD;
        for (int d = 0; d < HD; ++d) acc += q[d] * (qwf * sf[(size_t)d * HD] + qwb * sb[(size_t)d * HD]);
        RO[(size_t)r * RW + h * HD + e] = acc;
    }
}
__device__ __forceinline__ void d_ret_norm(const float* RO, const float* QKV, float* MIX, bf16_t* MIXb, long gtid, long gstride) {
    for (long idx = gtid; idx < (long)NTOK * NH; idx += gstride) {
        const int h = (int)(idx % NH), r = (int)(idx / NH);
        const float* o = RO + (size_t)r * RW + h * HD; float mu = 0.f;
        for (int e = 0; e < HD; ++e) mu += o[e];
        mu /= HD; float var = 0.f;
        for (int e = 0; e < HD; ++e) var += (o[e] - mu) * (o[e] - mu);
        var /= HD; const float rs = 1.0f / sqrtf(var + GN_EPS);
        for (int e = 0; e < HD; ++e) { const float v = (o[e] - mu) * rs * silu_f(QKV[(size_t)r * INW + 3 * RW + h * HD + e]); MIX[(size_t)r * DM + h * HD + e] = v; if (MIXb) MIXb[(size_t)r * DM + h * HD + e] = f2bf(v); }
    }
}
__device__ __forceinline__ void d_s5_disc(const In& I, int l, float* ABAR, float* BBAR, long gtid, long gstride) {
    for (long idx = gtid; idx < (long)2 * NG * SP; idx += gstride) {
        const int p = (int)(idx % SP); long t = idx / SP; const int g = (int)(t % NG); const int dir = (int)(t / NG);
        const size_t ia = (((size_t)l * 2 + dir) * NG + g) * SP + p;
        const float are = I.s5_a_re[ia], aim = I.s5_a_im[ia], dt = expf(I.s5_log_step[((size_t)l * 2 + dir) * NG + g]);
        const float mag = expf(are * dt), ang = aim * dt;
        const float abr = mag * cosf(ang), abi = mag * sinf(ang);
        const float den = are * are + aim * aim, nr = abr - 1.0f;
        const float fr = (nr * are + abi * aim) / den, fi = (abi * are - nr * aim) / den;
        ABAR[idx * 2] = abr; ABAR[idx * 2 + 1] = abi;
#pragma unroll
        for (int c = 0; c < SG; ++c) {
            const float br = I.s5_b_re[ia * SG + c], bi = I.s5_b_im[ia * SG + c];
            BBAR[(idx * SG + c) * 2] = fr * br - fi * bi; BBAR[(idx * SG + c) * 2 + 1] = fr * bi + fi * br;
        }
    }
}
__device__ __forceinline__ int chain_row(int dir, int b, int step) {
    if (dir == 0) return step < CTXL ? b * CTXL + step : NCTX + b * SQ + (step - CTXL);
    return step < CTXL ? b * CTXL + (CTXL - 1 - step) : NCTX + b * SQ + (SQ - 1 - (step - CTXL));
}
__device__ __forceinline__ void d_s5_scan(int dir, const bf16_t* QKV, const float* ABAR, const float* BBAR, float* HS, long gtid, long gstride) {
    for (long idx = gtid; idx < (long)NB * NG * SP; idx += gstride) {
        const int p = (int)(idx % SP); long t = idx / SP; const int g = (int)(t % NG); const int b = (int)(t / NG);
        const size_t ip = ((size_t)dir * NG + g) * SP + p;
        const float ar = ABAR[ip * 2], ai = ABAR[ip * 2 + 1];
        float br[SG], bi[SG];
#pragma unroll
        for (int c = 0; c < SG; ++c) { br[c] = BBAR[(ip * SG + c) * 2]; bi[c] = BBAR[(ip * SG + c) * 2 + 1]; }
        float hr = 0.f, hi = 0.f;
        for (int step = 0; step < CTXL + SQ; ++step) {
            const int row = chain_row(dir, b, step);
            const bf16_t* u = QKV + (size_t)row * INW + 4 * RW + g * SG;
            float ur = 0.f, ui = 0.f;
#pragma unroll
            for (int c = 0; c < SG; ++c) { const float uv = nbf2f(u[c]); ur += br[c] * uv; ui += bi[c] * uv; }
            const float nr = ar * hr - ai * hi + ur, ni = ar * hi + ai * hr + ui; hr = nr; hi = ni;
            float* o = HS + (((size_t)row * NG + g) * SP + p) * 2; o[0] = hr; o[1] = hi;
        }
    }
}
__device__ __forceinline__ void d_s5_y(const In& I, int l, int dir, const bf16_t* QKV, const float* HS, float* Z, bf16_t* Zb, long gtid, long gstride) {
    for (long idx = gtid; idx < (long)NTOK * SW; idx += gstride) {
        const int ch = (int)(idx % SW), row = (int)(idx / SW), g = ch / SG, c = ch % SG;
        float y = dir == 0 ? I.s5_d[((size_t)l * NG + g) * SG + c] * nbf2f(QKV[(size_t)row * INW + 4 * RW + ch]) : Z[idx];
        const float* cr = I.s5_c_re + ((((size_t)l * 2 + dir) * NG + g) * SG + c) * SP;
        const float* ci = I.s5_c_im + ((((size_t)l * 2 + dir) * NG + g) * SG + c) * SP;
        const float* h = HS + ((size_t)row * NG + g) * SP * 2;
        for (int p = 0; p < SP; ++p) y += cr[p] * h[2 * p] - ci[p] * h[2 * p + 1];
        if (dir == 1) { y = gelu_tanh_f(y); if (Zb) Zb[idx] = f2bf(y); }
        Z[idx] = y;
    }
}
__device__ __forceinline__ void d_glu_ep(const In& I, int l, const float* Z, const float* T, float* MIX, bf16_t* MIXb, long gtid, long gstride) {
    for (long idx = gtid; idx < (long)NTOK * SW; idx += gstride) {
        const int j = (int)(idx % SW), r = (int)(idx / SW);
        const float v = Z[idx] * sigmoid_f(T[idx] + I.s5_glu_b[(size_t)l * SW + j]); MIX[(size_t)r * DM + RW + j] = v; if (MIXb) MIXb[(size_t)r * DM + RW + j] = f2bf(v);
    }
}
__device__ __forceinline__ void d_resid(float* X, const float* T2, const float* MOD, int l, int m, long gtid, long gstride) {
    for (long idx = gtid; idx < (long)NTOK * DM; idx += gstride) {
        const int j = (int)(idx % DM), r = (int)(idx / DM);
        X[idx] += MODV(MOD, l, cond_of_row(r), m)[j] * T2[idx];
    }
}
__device__ __forceinline__ void d_route(const In& I, int l, const float* H2, int* TE, int* TP, float* TG, int* CNT, int row_lo, long gtid, long gstride) {
    for (long r = row_lo + gtid; r < NTOK; r += gstride) {
        float gl[NEG], el[NE];
#pragma unroll
        for (int j = 0; j < NEG; ++j) gl[j] = 0.f;
#pragma unroll
        for (int j = 0; j < NE; ++j) el[j] = 0.f;
        const float* h = H2 + (size_t)r * DM;
        const float* gw = I.router_grp_w + (size_t)l * DM * NEG; const float* ew = I.router_exp_w + (size_t)l * DM * NE;
        for (int k = 0; k < DM; ++k) {
            const float hv = h[k];
#pragma unroll
            for (int j = 0; j < NEG; ++j) gl[j] += hv * gw[(size_t)k * NEG + j];
#pragma unroll
            for (int j = 0; j < NE; ++j) el[j] += hv * ew[(size_t)k * NE + j];
        }
#pragma unroll
        for (int j = 0; j < NEG; ++j) gl[j] += I.router_grp_b[l * NEG + j];
#pragma unroll
        for (int j = 0; j < NE; ++j) el[j] += I.router_exp_b[l * NE + j];
        int grp = 0; float gmax = gl[0];
#pragma unroll
        for (int j = 1; j < NEG; ++j) if (gl[j] > gmax) { gmax = gl[j]; grp = j; }
        float den = 0.f;
#pragma unroll
        for (int j = 0; j < NEG; ++j) den += expf(gl[j] - gmax);
        const float gprob = 1.0f / den;
        float sel[EPG];
#pragma unroll
        for (int j = 0; j < EPG; ++j) { float v = el[j];
#pragma unroll
            for (int g2 = 1; g2 < NEG; ++g2) v = (grp == g2) ? el[g2 * EPG + j] : v;
            sel[j] = v; }
        int i0 = 0; float l0 = sel[0];
#pragma unroll
        for (int j = 1; j < EPG; ++j) if (sel[j] > l0) { l0 = sel[j]; i0 = j; }
        int i1 = -1; float l1 = -3.0e38f;
#pragma unroll
        for (int j = 0; j < EPG; ++j) if (j != i0 && sel[j] > l1) { l1 = sel[j]; i1 = j; }
        const float e1 = expf(l1 - l0), g0 = gprob / (1.0f + e1), g1 = gprob * e1 / (1.0f + e1);
        const int ex0 = grp * EPG + i0, ex1 = grp * EPG + i1;
        TE[r * 2] = ex0; TE[r * 2 + 1] = ex1; TG[r * 2] = g0; TG[r * 2 + 1] = g1;
        TP[r * 2] = atomicAdd(&CNT[ex0], 1); TP[r * 2 + 1] = atomicAdd(&CNT[ex1], 1);
    }
}
__device__ __forceinline__ void d_moe_offsets(const int* CNT, int* META, int tile, long gtid) {
    if (gtid == 0) {
        int off = 0, nt = 0;
        for (int e = 0; e < NE; ++e) {
            META[1 + e] = off; const int t = (CNT[e] + tile - 1) / tile;
            for (int k = 0; k < t; ++k) META[64 + nt + k] = e;
            nt += t; off += t * tile;
        }
        META[0] = nt;
    }
}
__device__ __forceinline__ void d_moe_scatter(const int* TE, const int* TP, const int* META, int* SLOT_TOK, int* TS, int row_lo, long gtid, long gstride) {
    for (long idx = (long)row_lo * 2 + gtid; idx < (long)NTOK * 2; idx += gstride) {
        const int slot = META[1 + TE[idx]] + TP[idx];
        SLOT_TOK[slot] = (int)(idx / 2); TS[idx] = slot;
    }
}
__device__ __forceinline__ void d_moe_gather(const float* H2, const int* SLOT_TOK, bf16_t* Xg, const int* META, int tile, long gtid, long gstride) {
    const long nrows = (long)META[0] * tile;
    for (long idx = gtid; idx < nrows * (DM / 4); idx += gstride) {
        const int j = (int)(idx % (DM / 4)) * 4; const long s = idx / (DM / 4); const int tok = SLOT_TOK[s];
        for (int q = 0; q < 4; ++q) Xg[s * DM + j + q] = tok >= 0 ? f2bf(H2[(size_t)tok * DM + j + q]) : (bf16_t)0;
    }
}
__device__ __forceinline__ void d_moe_act(const float* GU, float* ACT, bf16_t* ACTb, const int* META, int tile, long gtid, long gstride) {
    const long nrows = (long)META[0] * tile;
    for (long idx = gtid; idx < nrows * EFF; idx += gstride) {
        const int j = (int)(idx % EFF); const long s = idx / EFF;
        const float v = silu_f(GU[s * 2 * EFF + j]) * GU[s * 2 * EFF + EFF + j]; if (ACT) ACT[idx] = v; if (ACTb) ACTb[idx] = f2bf(v);
    }
}
__device__ __forceinline__ void d_moe_combine(float* X, const float* Y, const int* TS, const float* TG, const float* MOD, int l, int row_lo, long gtid, long gstride) {
    for (long idx = (long)row_lo * DM + gtid; idx < (long)NTOK * DM; idx += gstride) {
        const int j = (int)(idx % DM), r = (int)(idx / DM);
        const float v = TG[r * 2] * Y[(size_t)TS[r * 2] * DM + j] + TG[r * 2 + 1] * Y[(size_t)TS[r * 2 + 1] * DM + j];
        X[idx] += MODV(MOD, l, cond_of_row(r), 5)[j] * v;
    }
}
__device__ __forceinline__ void d_final(const In& I, const float* X, float* out, long gtid, long gstride) {
    for (long r = NCTX + gtid; r < NTOK; r += gstride) {
        const float* xr = X + (size_t)r * DM; float ss = 0.f;
        for (int j = 0; j < DM; ++j) ss += xr[j] * xr[j];
        const float rs = 1.0f / sqrtf(ss / DM + NORM_EPS);
        for (int j = 0; j < DM; ++j) out[(size_t)(r - NCTX) * DM + j] = xr[j] * rs * I.final_g[j];
    }
}

struct GemmArgs { const float* A; int lda; const int* gather; const float* B; int ldb; size_t strideB; float* C; int ldc; int M, N, K; const int* META; };
#ifdef HOST_EMU
__device__ __forceinline__ void d_gemm(const GemmArgs& g, void* smem, int bid, int nblk) {
    (void)smem; (void)bid; (void)nblk;
    const int M = g.META ? g.META[0] * MOE_TILE : g.M;
    for (int m = 0; m < M; ++m) {
        const float* B = g.B + (g.META ? (size_t)g.META[64 + m / MOE_TILE] * g.strideB : 0);
        const int src = g.gather ? g.gather[m] : m;
        for (int n = 0; n < g.N; ++n) { double acc = 0;
            if (src >= 0) for (int k = 0; k < g.K; ++k) acc += (double)g.A[(size_t)src * g.lda + k] * B[(size_t)k * g.ldb + n];
            g.C[(size_t)m * g.ldc + n] = (float)acc; }
    }
}
#else
__device__ __forceinline__ void d_gemm(const GemmArgs& g, void* smem, int bid, int nblk) {
    float* As = (float*)smem;
    float* Bs = As + 16 * 132;
    const int tid = threadIdx.x, tx = tid % 16, ty = tid / 16;
    const int M = g.META ? g.META[0] * MOE_TILE : g.M;
    const int ntm = (M + 127) / 128, ntn = (g.N + 63) / 64;
    for (int tile = bid; tile < ntm * ntn; tile += nblk) {
        const int tm = tile / ntn, tn = tile % ntn, m0 = tm * 128, n0 = tn * 64;
        const float* B = g.B + (g.META ? (size_t)g.META[64 + tm] * g.strideB : 0);
        float acc[4][4];
        for (int i = 0; i < 4; ++i) for (int j = 0; j < 4; ++j) acc[i][j] = 0.f;
        for (int k0 = 0; k0 < g.K; k0 += 16) {
            for (int q = tid; q < 128 * 16; q += 512) { const int mm = q / 16, kk = q % 16; const int m = m0 + mm; float v = 0.f;
                if (m < M && k0 + kk < g.K) { const int src = g.gather ? g.gather[m] : m; if (src >= 0) v = g.A[(size_t)src * g.lda + k0 + kk]; }
                As[kk * 132 + mm] = v; }
            for (int q = tid; q < 16 * 64; q += 512) { const int kk = q / 64, nn = q % 64; float v = 0.f;
                if (k0 + kk < g.K && n0 + nn < g.N) v = B[(size_t)(k0 + kk) * g.ldb + n0 + nn];
                Bs[kk * 64 + nn] = v; }
            __syncthreads();
#pragma unroll
            for (int kk = 0; kk < 16; ++kk) { float a[4], b[4];
#pragma unroll
                for (int i = 0; i < 4; ++i) a[i] = As[kk * 132 + ty * 4 + i];
#pragma unroll
                for (int j = 0; j < 4; ++j) b[j] = Bs[kk * 64 + tx * 4 + j];
#pragma unroll
                for (int i = 0; i < 4; ++i)
#pragma unroll
                    for (int j = 0; j < 4; ++j) acc[i][j] += a[i] * b[j]; }
            __syncthreads();
        }
        for (int i = 0; i < 4; ++i) { const int m = m0 + ty * 4 + i; if (m >= M) continue;
            for (int j = 0; j < 4; ++j) { const int n = n0 + tx * 4 + j; if (n < g.N) g.C[(size_t)m * g.ldc + n] = acc[i][j]; } }
    }
}
#endif
}

#ifndef PR_GEMM
#define PR_GEMM 1
#endif
#ifndef PR_WCVT
#define PR_WCVT 1
#endif
#ifndef PR_RET
#define PR_RET 1
#endif
#ifndef PR_S5
#define PR_S5 1
#endif
#ifndef PR_ROUTE
#define PR_ROUTE 1
#endif
#ifndef PR_NORM
#define PR_NORM 1
#endif
#ifndef PR_BAR
#define PR_BAR 0
#endif
#ifndef PR_PREP
#define PR_PREP 1
#endif
#ifndef PR_FIN
#define PR_FIN 1
#endif
namespace nv {
constexpr size_t al256(size_t x) { return (x + 255) & ~(size_t)255; }
constexpr size_t cmax(size_t a, size_t b) { return a > b ? a : b; }
constexpr int NRLc = NEG + NE;
constexpr size_t OFF_CTL = 0, SZ_CTL = 4096;
constexpr size_t OFF_BAR = OFF_CTL + SZ_CTL, SZ_BAR = 16384;
constexpr size_t OFF_MOD = OFF_BAR + SZ_BAR, SZ_MOD = al256((size_t)NL * NCOND * NMOD * DM * 4);
constexpr size_t OFF_PART = OFF_MOD + SZ_MOD, SZ_PART = al256((size_t)(DM / 128) * NL * NCOND * NMOD * DM * 4);
constexpr size_t OFF_RWT = OFF_PART + SZ_PART, SZ_RWT = al256((size_t)NL * NRLc * DM * 4);
constexpr size_t OFF_LAMP = OFF_RWT + SZ_RWT, SZ_LAMP = al256((size_t)NL * 2 * NG * 17 * SP * 2 * 4);
constexpr size_t OFF_BBC = OFF_LAMP + SZ_LAMP, SZ_BBC = al256((size_t)NL * 2 * NG * SP * SG * 2 * 4);
constexpr size_t OFF_KTAU = OFF_BBC + SZ_BBC, SZ_KTAU = al256((size_t)NL * 2 * NG * 16 * SG * SG * 4);
constexpr size_t OFF_MINT = OFF_KTAU + SZ_KTAU, SZ_MINT = al256((size_t)NL * 2 * NG * 128 * 256 * 2);
constexpr size_t OFF_MOUT = OFF_MINT + SZ_MINT, SZ_MOUT = SZ_MINT;
constexpr size_t OFF_KTOT = OFF_MOUT + SZ_MOUT, SZ_KTOT = al256((size_t)NL * NG * 256 * 256 * 2);
constexpr size_t OFF_TE = OFF_KTOT + SZ_KTOT, SZ_T2I = al256((size_t)NTOK * 2 * 4);
constexpr size_t OFF_TP = OFF_TE + SZ_T2I, OFF_TG = OFF_TP + SZ_T2I, OFF_TS = OFF_TG + SZ_T2I, OFF_RSTD = OFF_TS + SZ_T2I;
constexpr size_t OFF_HIST = OFF_RSTD + SZ_T2I, SZ_HIST = al256((size_t)1024 * NE * 4);
constexpr size_t OFF_X = OFF_HIST + SZ_HIST, SZ_X = al256((size_t)NTOK * DM * 4);
constexpr size_t OFF_QKVB = OFF_X + SZ_X, SZ_QKVB = al256((size_t)NTOK * INW * 2);
constexpr size_t OFF_ROPE = OFF_QKVB + SZ_QKVB, SZ_ROPE = al256((size_t)SQ * (HD / 2) * 2 * 4);
constexpr size_t OFF_MIXB = OFF_ROPE + SZ_ROPE, SZ_MIXB = al256((size_t)NTOK * DM * 2);
constexpr size_t OFF_ZB = OFF_MIXB + SZ_MIXB, SZ_ZB = al256((size_t)NTOK * SW * 2);
constexpr size_t OFF_HB = OFF_ZB + SZ_ZB, SZ_HB = SZ_MIXB;
constexpr size_t OFF_WIN = OFF_HB + SZ_HB, SZ_WIN = al256((size_t)INW * DM * 2);
constexpr size_t OFF_WGLU = OFF_WIN + SZ_WIN, SZ_WGLU = al256((size_t)SW * SW * 2);
constexpr size_t OFF_WOUT = OFF_WGLU + SZ_WGLU, SZ_WOUT = al256((size_t)DM * DM * 2);
constexpr size_t OFF_WGU = OFF_WOUT + SZ_WOUT, SZ_WGU = al256((size_t)NE * 2 * EFF * DM * 2);
constexpr size_t OFF_WD = OFF_WGU + SZ_WGU, SZ_WD = al256((size_t)NE * DM * EFF * 2);
constexpr size_t OFF_BIG = OFF_WD + SZ_WD;
constexpr size_t SZ_KV = al256((size_t)2 * NB * NH * NCH * HD * HD * 4);
constexpr size_t OFF_KVT = OFF_BIG, OFF_STT = OFF_KVT + SZ_KV, SZ_STT = al256((size_t)2 * NB * NH * NCH * HD * HD * 2);
constexpr size_t OFF_XG = OFF_BIG, SZ_XG = al256((size_t)MOE_CAP * DM * 2);
constexpr size_t OFF_ACTB = OFF_XG + SZ_XG, SZ_ACTB = al256((size_t)MOE_CAP * EFF * 2);
constexpr size_t OFF_YB = OFF_ACTB + SZ_ACTB, SZ_YB = al256((size_t)MOE_CAP * DM * 2);
constexpr size_t WS_NEED = cmax(OFF_STT + SZ_STT, OFF_YB + SZ_YB);

struct Params { In I; float* out; unsigned char* ws; };
}

#ifndef HOST_EMU
#ifdef HOST_EMU2
#define LAS
#endif
#define XB_TMO      128
#define XB_XCNT(j)  (256  + 64 * (j))
#define XB_XSUB(j)  (1280 + 64 * (j))
#define XB_XGEN(j)  (2304 + 64 * (j))
#define XB_TOP      3328
#define XB_TOPGEN   3392
#define XCD_BAR_WORDS 3456
#define XB_SPIN_CAP (1u << 18)
#ifndef LAS
#define LAS __attribute__((address_space(3)))
#endif

__device__ __forceinline__ unsigned xb_ld(unsigned* p)              { return __hip_atomic_load(p, __ATOMIC_RELAXED, __HIP_MEMORY_SCOPE_AGENT); }
__device__ __forceinline__ unsigned xb_add(unsigned* p, unsigned v) { return __hip_atomic_fetch_add(p, v, __ATOMIC_RELAXED, __HIP_MEMORY_SCOPE_AGENT); }
__device__ __forceinline__ unsigned xb_xcc_id() { return (unsigned)__builtin_amdgcn_s_getreg((3 << 11) | 20) & 0xFu; }
#define XB_SPIN(cond, bar) do { unsigned _sp = 0; while (cond) { __builtin_amdgcn_s_sleep(1); \
    if ((++_sp & 255u) == 0u) { if (xb_ld(&(bar)[XB_TMO])) break; if (_sp > XB_SPIN_CAP) { atomicAdd(&(bar)[XB_TMO], 1u); break; } } } } while (0)

struct XcdBarrier {
    unsigned* bar; unsigned x;
    volatile LAS unsigned* st;
};

__device__ __forceinline__ XcdBarrier xcd_barrier_post(unsigned* bar, volatile LAS unsigned* st) {
    XcdBarrier b; b.bar = bar; b.x = xb_xcc_id(); b.st = st;
    if (threadIdx.x == 0) (void)xb_add(&bar[XB_XCNT(b.x)], 1u);
    return b;
}
__device__ __forceinline__ void xcd_barrier_complete(unsigned* bar, unsigned x, unsigned& nloc, unsigned& nx) {
    const unsigned G = gridDim.x * gridDim.y * gridDim.z;
    unsigned sum, cnt, mine, sp = 0u;
    for (;;) {
        sum = 0u; cnt = 0u; mine = 0u;
#pragma unroll
        for (unsigned j = 0; j < 16; ++j) { const unsigned c = xb_ld(&bar[XB_XCNT(j)]); sum += c; cnt += (c > 0u) ? 1u : 0u; mine = (j == x) ? c : mine; }
        if (sum == G) break;
        __builtin_amdgcn_s_sleep(1);
        if ((++sp & 255u) == 0u) { if (xb_ld(&bar[XB_TMO])) break; if (sp > XB_SPIN_CAP) { atomicAdd(&bar[XB_TMO], 1u); break; } }
    }
    nloc = mine > 0u ? mine : 1u; nx = cnt > 0u ? cnt : 1u;
}

__device__ __forceinline__ void xcd_barrier(const XcdBarrier& b) {
    asm volatile("s_waitcnt vmcnt(0)" ::: "memory");
    __syncthreads();
    if (threadIdx.x == 0) {
        unsigned* bar = b.bar;
        __builtin_amdgcn_s_waitcnt(0);
        unsigned nloc = b.st[0], nx = b.st[1];
        if (nloc == 0u) { xcd_barrier_complete(bar, b.x, nloc, nx); b.st[0] = nloc; b.st[1] = nx; }
        const unsigned old = xb_add(&bar[XB_XSUB(b.x)], 1u);
        const unsigned gen = old / nloc;
        if (old + 1u == (gen + 1u) * nloc) {
            __builtin_amdgcn_fence(__ATOMIC_RELEASE, "agent");
            asm volatile("s_waitcnt vmcnt(0)" ::: "memory");
            const unsigned og = xb_add(&bar[XB_TOP], 1u);
            const unsigned tg = og / nx;
            if (og + 1u == (tg + 1u) * nx) xb_add(&bar[XB_TOPGEN], 1u);
            else XB_SPIN(xb_ld(&bar[XB_TOPGEN]) == tg, bar);
            __builtin_amdgcn_fence(__ATOMIC_ACQUIRE, "agent");
            xb_add(&bar[XB_XGEN(b.x)], 1u);
            asm volatile("s_waitcnt vmcnt(0)" ::: "memory");
        } else {
            XB_SPIN(xb_ld(&bar[XB_XGEN(b.x)]) == gen, bar);
            __builtin_amdgcn_fence(__ATOMIC_ACQUIRE, "agent");
            asm volatile("s_waitcnt vmcnt(0)" ::: "memory");
        }
    }
    __syncthreads();
}


#ifndef HOST_EMU2
#define GAS __attribute__((address_space(1)))
#else
#define GAS
#endif
typedef unsigned short bf16;
typedef unsigned v4u __attribute__((ext_vector_type(4)));
#ifdef HOST_EMU2
#define LDS_WAIT() do { emu::wave_sync(); emu::set_ids(); } while (0)
#else
#define LDS_WAIT() asm volatile("s_waitcnt lgkmcnt(0)" ::: "memory")
#endif
__device__ __forceinline__ unsigned f2bf_u(float f) { unsigned u = __builtin_bit_cast(unsigned, f); return (u + 0x7fffu + ((u >> 16) & 1u)) >> 16; }
__device__ __forceinline__ unsigned pk2(float lo, float hi) { return f2bf_u(lo) | (f2bf_u(hi) << 16); }
namespace pg8 {
#define PG8_LAS __attribute__((address_space(3)))
typedef unsigned short bf16_t;
typedef short bf16x8 __attribute__((ext_vector_type(8)));
typedef float f32x4 __attribute__((ext_vector_type(4)));
typedef unsigned u32x4 __attribute__((ext_vector_type(4)));
constexpr int BM = 256, BK = 64, HALF = 128, HTB = HALF * BK * 2  , STAGE_BYTES = 8 * HTB, NXCD = 8, WGM = 8;

__host__ __device__ __forceinline__ int lds_byte(int r, int c) { const int st = (r >> 4) * 2 + (c >> 5), rr = r & 15, cc = c & 31, ob = rr * 64 + cc * 2; return st * 1024 + (ob ^ (((ob >> 9) & 1) << 5)); }
__host__ __device__ __forceinline__ void stage_rc(int b, int& R, int& C) { const int st = b / 1024, sb = b % 1024, swz = sb ^ (((sb >> 9) & 1) << 5); R = (st >> 1) * 16 + swz / 64; C = (st & 1) * 32 + (swz % 64) / 2; }
__host__ __device__ __forceinline__ int perm32(int rho) { const int n = rho >> 4, i = rho & 15; return 8 * (i >> 2) + 4 * n + (i & 3); }

struct Unit { int pm, pn, half; };
struct Gemm { const bf16_t* A; const bf16_t* Bt; int M, N, K; };

struct StaticOrder {
    int nM, nN, nwg, G, c, rep;
    __host__ __device__ void init(int M, int N, int G_, int c_) { nM = M / BM; nN = N / BM; nwg = nM * nN; G = G_; c = c_; rep = PR_GEMM; }
    __host__ __device__ bool next(int i, Unit& u) const {
        long L = (long)i * G + c; int part = -1;
        if (rep == 1) { const int nfull = (nwg / G) * G, r = nwg - nfull;
            if (r > 0 && 2 * r <= G && L >= nfull) { if (L >= nfull + 2 * r) return false; part = (int)((L - nfull) & 1); L = nfull + (L - nfull) / 2; } }
        if (L >= (long)nwg * rep) return false;
        int wgid = (int)(L % nwg); { const int q = nwg / NXCD, r = nwg % NXCD, xcd = wgid % NXCD, off = wgid / NXCD; wgid = (xcd < r ? xcd * (q + 1) : r * (q + 1) + (xcd - r) * q) + off; }
        const int nig = WGM * nN, gid = wgid / nig, fm = gid * WGM, gsz = (nM - fm) < WGM ? (nM - fm) : WGM;
        u.pm = 2 * (fm + ((wgid % nig) % gsz)) + (part > 0 ? 1 : 0); u.pn = (wgid % nig) / gsz; u.half = part >= 0 ? 1 : 0; return true;
    }
    __device__ __forceinline__ void a_ready(const Unit&) const {}
    __device__ __forceinline__ void done(const Unit&) const {}
};

#ifdef HOST_EMU2
__device__ __forceinline__ unsigned cvt_pk_bf16(float lo, float hi) { return pk2(lo, hi); }
#else
__device__ __forceinline__ unsigned cvt_pk_bf16(float lo, float hi) { unsigned r; asm volatile("v_cvt_pk_bf16_f32 %0, %1, %2" : "=v"(r) : "v"(lo), "v"(hi)); return r; }
#endif
template <class Epi, class Sched, bool ALIGN_EPI = false, bool SP2 = false>
__device__ __forceinline__ void gemm_phase(PG8_LAS unsigned char* lds, const Gemm g, const Sched& S, const Epi& E, const int tid) {
    const int wid = __builtin_amdgcn_readfirstlane(tid >> 6), lane = tid & 63, wr = wid >> 2, wc = wid & 3, fr = lane & 15, fq = lane >> 4;
    const int K = g.K, nt = K / BK;
    unsigned voffA[2], voffB[2];
#pragma unroll
    for (int i = 0; i < 2; ++i) { int R, C; stage_rc(tid * 16 + i * 8192, R, C); const int Rb = Epi::PERM ? ((R & ~31) + perm32(R & 31)) : R;
        voffA[i] = (unsigned)(R * K + C) * 2u; voffB[i] = (unsigned)(Rb * K + C) * 2u; }
    const size_t kstep = (size_t)(BK * 2);
    const size_t hstep = (size_t)HALF * K * 2;
    const size_t tstep = 2 * hstep;
    const unsigned ldsw = (unsigned)wid * 1024u;
    const int aoff = lds_byte(wr * 64 + fr, fq * 8), boff = lds_byte(wc * 32 + fr, fq * 8);
#define PG8_SA(b, h) (((b) * 2 + (h)) * HTB)
#define PG8_SB(b, h) ((4 + (b) * 2 + (h)) * HTB)
#define PG8_STAGE(bufoff, gbase, voff) do { _Pragma("unroll") for (int _i = 0; _i < 2; ++_i) \
        __builtin_amdgcn_global_load_lds((const unsigned*)((const char*)(gbase) + (voff)[_i]), (PG8_LAS unsigned*)(lds + (bufoff) + ldsw + _i * 8192), 16, 0, 0); } while (0)
#define PG8_LDA(dst, b, h) do { _Pragma("unroll") for (int m = 0; m < 4; ++m) _Pragma("unroll") for (int k = 0; k < 2; ++k) dst[m][k] = *(const PG8_LAS bf16x8*)(lds + PG8_SA(b, h) + aoff + m * 2048 + k * 1024); } while (0)
#define PG8_LDB(dst, b, h) do { _Pragma("unroll") for (int n = 0; n < 2; ++n) _Pragma("unroll") for (int k = 0; k < 2; ++k) dst[n][k] = *(const PG8_LAS bf16x8*)(lds + PG8_SB(b, h) + boff + n * 2048 + k * 1024); } while (0)
#define PG8_MMA(ai, bj, At, Bt) do { __builtin_amdgcn_s_setprio(1); _Pragma("unroll") for (int m = 0; m < 4; ++m) _Pragma("unroll") for (int n = 0; n < 2; ++n) _Pragma("unroll") for (int k = 0; k < 2; ++k) \
        acc[ai][bj][m][n] = __builtin_amdgcn_mfma_f32_16x16x32_bf16(Bt[n][k], At[m][k], acc[ai][bj][m][n], 0, 0, 0); __builtin_amdgcn_s_setprio(0); } while (0)
#define PG8_WAIT_V(n) asm volatile("s_waitcnt vmcnt(" #n ")" ::: "memory")
#define PG8_WAIT_L(n) asm volatile("s_waitcnt lgkmcnt(" #n ")" ::: "memory")
#define PG8_BAR __builtin_amdgcn_s_barrier()
#define PG8_SCHED __builtin_amdgcn_sched_barrier(0)
    Unit cur, nxt; int ui = 0;
    if (!S.next(0, cur)) return;
    f32x4 acc[2][2][4][2];
#pragma unroll
    for (int a = 0; a < 2; ++a)
#pragma unroll
        for (int b = 0; b < 2; ++b)
#pragma unroll
            for (int m = 0; m < 4; ++m)
#pragma unroll
                for (int n = 0; n < 2; ++n) acc[a][b][m][n] = (f32x4){0.f, 0.f, 0.f, 0.f};
    bf16x8 At[4][2], B0[2][2], B1[2][2];
    const char* cA = (const char*)g.A + (size_t)cur.pm * hstep; const char* cB = (const char*)g.Bt + (size_t)cur.pn * tstep;
    S.a_ready(cur);
    if constexpr (SP2) {
        PG8_STAGE(PG8_SB(0, 0), cB, voffB); PG8_STAGE(PG8_SB(0, 1), cB + hstep, voffB); PG8_STAGE(PG8_SA(0, 0), cA, voffA); PG8_STAGE(PG8_SA(0, 1), cA + hstep, voffA);
        if (wr == 1) PG8_BAR;
        PG8_WAIT_V(2); PG8_BAR;
        PG8_STAGE(PG8_SB(1, 0), cB + kstep, voffB); PG8_STAGE(PG8_SA(1, 0), cA + kstep, voffA); PG8_STAGE(PG8_SB(1, 1), cB + hstep + kstep, voffB);
        PG8_WAIT_V(6); PG8_BAR;
    } else {
        PG8_STAGE(PG8_SB(0, 0), cB, voffB); PG8_STAGE(PG8_SA(0, 0), cA, voffA); PG8_STAGE(PG8_SB(0, 1), cB + hstep, voffB); PG8_STAGE(PG8_SA(0, 1), cA + hstep, voffA);
        if (wr == 1) PG8_BAR;
        PG8_WAIT_V(4); PG8_BAR;
        PG8_STAGE(PG8_SB(1, 0), cB + kstep, voffB); PG8_STAGE(PG8_SA(1, 0), cA + kstep, voffA); PG8_STAGE(PG8_SB(1, 1), cB + hstep + kstep, voffB);
        PG8_WAIT_V(6); PG8_BAR;
    }
    for (;;) {
        const bool has_next = S.next(ui + 1, nxt);
        const char* nA = has_next ? (const char*)g.A + (size_t)nxt.pm * hstep : cA; const char* nB = has_next ? (const char*)g.Bt + (size_t)nxt.pn * tstep : cB;
        for (int t = 0; t < nt; t += 2) {
            const bool last = (t == nt - 2);
            const char* a1 = cA + (size_t)(t + 1) * kstep;
            const char* a2 = last ? nA : cA + (size_t)(t + 2) * kstep; const char* b2 = last ? nB : cB + (size_t)(t + 2) * kstep;
            const char* a3 = a2 + kstep; const char* b3 = b2 + kstep;
            if (last && has_next) S.a_ready(nxt);
            if constexpr (SP2) {
            PG8_LDB(B0, 0, 0); PG8_LDB(B1, 0, 1); PG8_SCHED; PG8_LDA(At, 0, 0); PG8_STAGE(PG8_SA(1, 1), a1 + hstep, voffA);
            PG8_WAIT_V(8); PG8_WAIT_L(0); PG8_BAR; PG8_MMA(0, 0, At, B0); PG8_MMA(0, 1, At, B1); PG8_BAR; PG8_SCHED;
            PG8_LDA(At, 0, 1); PG8_STAGE(PG8_SB(0, 0), b2, voffB); PG8_STAGE(PG8_SB(0, 1), b2 + hstep, voffB); PG8_STAGE(PG8_SA(0, 0), a2, voffA);
            PG8_WAIT_V(8); PG8_WAIT_L(0); PG8_BAR; if (!cur.half) { PG8_MMA(1, 0, At, B0); PG8_MMA(1, 1, At, B1); } PG8_BAR; PG8_SCHED;
            PG8_LDB(B0, 1, 0); PG8_LDB(B1, 1, 1); PG8_SCHED; PG8_LDA(At, 1, 0); PG8_STAGE(PG8_SA(0, 1), a2 + hstep, voffA);
            PG8_WAIT_V(8); PG8_WAIT_L(0); PG8_BAR; PG8_MMA(0, 0, At, B0); PG8_MMA(0, 1, At, B1); PG8_BAR; PG8_SCHED;
            PG8_LDA(At, 1, 1); PG8_STAGE(PG8_SB(1, 0), b3, voffB); PG8_STAGE(PG8_SB(1, 1), b3 + hstep, voffB); PG8_STAGE(PG8_SA(1, 0), a3, voffA);
            PG8_WAIT_V(8); PG8_WAIT_L(0); PG8_BAR; if (!cur.half) { PG8_MMA(1, 0, At, B0); PG8_MMA(1, 1, At, B1); } PG8_BAR; PG8_SCHED;
            } else {
            PG8_LDB(B0, 0, 0); PG8_SCHED; PG8_LDA(At, 0, 0); PG8_STAGE(PG8_SA(1, 1), a1 + hstep, voffA);
            PG8_WAIT_L(8); PG8_BAR; PG8_WAIT_L(0); PG8_MMA(0, 0, At, B0); PG8_BAR; PG8_SCHED;
            PG8_LDB(B1, 0, 1); PG8_STAGE(PG8_SB(0, 0), b2, voffB);
            PG8_BAR; PG8_WAIT_L(0); PG8_MMA(0, 1, At, B1); PG8_BAR;
            PG8_LDA(At, 0, 1); PG8_STAGE(PG8_SA(0, 0), a2, voffA);
            PG8_BAR; PG8_WAIT_L(0); PG8_MMA(1, 0, At, B0); PG8_BAR; PG8_SCHED;
            PG8_STAGE(PG8_SB(0, 1), b2 + hstep, voffB);
            PG8_WAIT_V(6); PG8_BAR; PG8_MMA(1, 1, At, B1); PG8_BAR;
            PG8_LDB(B0, 1, 0); PG8_SCHED; PG8_LDA(At, 1, 0); PG8_STAGE(PG8_SA(0, 1), a2 + hstep, voffA);
            PG8_WAIT_L(8); PG8_BAR; PG8_WAIT_L(0); PG8_MMA(0, 0, At, B0); PG8_BAR; PG8_SCHED;
            PG8_LDB(B1, 1, 1); PG8_STAGE(PG8_SB(1, 0), b3, voffB);
            PG8_BAR; PG8_WAIT_L(0); PG8_MMA(0, 1, At, B1); PG8_BAR;
            PG8_LDA(At, 1, 1); PG8_STAGE(PG8_SA(1, 0), a3, voffA);
            PG8_BAR; PG8_WAIT_L(0); PG8_MMA(1, 0, At, B0); PG8_BAR; PG8_SCHED;
            PG8_STAGE(PG8_SB(1, 1), b3 + hstep, voffB);
            PG8_WAIT_V(6); PG8_BAR; PG8_MMA(1, 1, At, B1); PG8_BAR;
            }
        }
        if constexpr (ALIGN_EPI) { if (wr == 0) PG8_BAR; }
        if constexpr (!Epi::AFTER_DRAIN) { E(acc, cur, wr, wc, fr, fq); S.done(cur); }
        if (!has_next) break;
#pragma unroll
        for (int a = 0; a < 2; ++a)
#pragma unroll
            for (int b = 0; b < 2; ++b)
#pragma unroll
                for (int m = 0; m < 4; ++m)
#pragma unroll
                    for (int n = 0; n < 2; ++n) acc[a][b][m][n] = (f32x4){0.f, 0.f, 0.f, 0.f};
        cur = nxt; cA = nA; cB = nB; ++ui;
        if constexpr (ALIGN_EPI) { if (wr == 1) PG8_BAR; }
    }
    PG8_WAIT_V(0);
    if constexpr (!ALIGN_EPI) { if (wr == 0) PG8_BAR; }
    PG8_BAR;
    if constexpr (Epi::AFTER_DRAIN) { E.fused(acc, cur, wr, wc, fr, fq, lds, wid, lane); S.done(cur); }
#undef PG8_SA
#undef PG8_SB
#undef PG8_STAGE
#undef PG8_LDA
#undef PG8_LDB
#undef PG8_MMA
#undef PG8_WAIT_V
#undef PG8_WAIT_L
#undef PG8_BAR
#undef PG8_SCHED
}
}
__device__ __forceinline__ void p0_transpose_item(const float* W, int K, int N, bf16* WT, int row_off, LAS float* scr, int item, int lane) {
    const int nblk = N / 32, kb = item / nblk, nb = item % nblk, k0 = 64 * kb, n0 = 32 * nb;
#pragma unroll 8
    for (int i = 0; i < 32; ++i) { const int kk = 2 * i + (lane >> 5); scr[kk * 33 + (lane & 31)] = W[(size_t)(k0 + kk) * N + n0 + (lane & 31)]; }
    LDS_WAIT(); asm volatile("" ::: "memory");
    const int c = lane & 7;
#pragma unroll
    for (int j = 0; j < 4; ++j) { const int n = (lane >> 3) + 8 * j; const LAS float* s = scr + (8 * c) * 33 + n;
        v4u o; o.x = pk2(s[0 * 33], s[1 * 33]); o.y = pk2(s[2 * 33], s[3 * 33]); o.z = pk2(s[4 * 33], s[5 * 33]); o.w = pk2(s[6 * 33], s[7 * 33]);
        *(GAS v4u*)(WT + (size_t)(row_off + n0 + n) * K + k0 + 8 * c) = o; }
    LDS_WAIT(); asm volatile("" ::: "memory");
}
namespace nv {
typedef float f4 __attribute__((ext_vector_type(4)));
typedef unsigned u2v __attribute__((ext_vector_type(2)));
typedef unsigned u4v __attribute__((ext_vector_type(4)));
constexpr int ROWV = DM / 256;
constexpr int NRL = NEG + NE;
constexpr int AD_KS = 128;
constexpr int AD_NKS = DM / AD_KS;
#ifdef HOST_EMU2
#define WAVE_SYNC() do { emu::wave_sync(); emu::set_ids(); } while (0)
#else
#define WAVE_SYNC() __builtin_amdgcn_wave_barrier()
#endif
template <int CTRL> __device__ __forceinline__ float dpp_f(float v) { return __builtin_bit_cast(float, __builtin_amdgcn_update_dpp(0, __builtin_bit_cast(int, v), CTRL, 0xf, 0xf, true)); }
__device__ __forceinline__ float wave_sum(float v) {
    v += dpp_f<0xB1>(v); v += dpp_f<0x4E>(v); v += dpp_f<0x141>(v); v += dpp_f<0x140>(v);
    const int iv = __builtin_bit_cast(int, v);
    return (__builtin_bit_cast(float, __builtin_amdgcn_readlane(iv, 0)) + __builtin_bit_cast(float, __builtin_amdgcn_readlane(iv, 16))) +
           (__builtin_bit_cast(float, __builtin_amdgcn_readlane(iv, 32)) + __builtin_bit_cast(float, __builtin_amdgcn_readlane(iv, 48)));
}
__device__ __forceinline__ float bf2f(unsigned short b) { return __builtin_bit_cast(float, ((unsigned)b) << 16); }
__device__ __forceinline__ float bflo(unsigned w) { return __builtin_bit_cast(float, w << 16); }
__device__ __forceinline__ float bfhi(unsigned w) { return __builtin_bit_cast(float, w & 0xffff0000u); }
__device__ __forceinline__ void row_load(const float* p, int lane, f4 (&v)[ROWV]) {
#pragma unroll
    for (int j = 0; j < ROWV; ++j) v[j] = *(const f4*)(p + 4 * lane + 256 * j);
}
__device__ __forceinline__ float row_ss(const f4 (&v)[ROWV]) { float s = 0.f;
#pragma unroll
    for (int j = 0; j < ROWV; ++j) s += (v[j].x * v[j].x + v[j].y * v[j].y) + (v[j].z * v[j].z + v[j].w * v[j].w);
    return s; }
__device__ __forceinline__ void row_modulate(f4 (&v)[ROWV], float rstd, const float* g, const float* sc, const float* sh, int lane) {
#pragma unroll
    for (int j = 0; j < ROWV; ++j) { const int c = 4 * lane + 256 * j; const f4 gg = *(const f4*)(g + c), ss = *(const f4*)(sc + c), hh = *(const f4*)(sh + c);
        v[j] = v[j] * rstd * gg * (ss + 1.0f) + hh; }
}
__device__ __forceinline__ void row_store_bf16(bf16_t* o, const f4 (&v)[ROWV], int lane) {
#pragma unroll
    for (int j = 0; j < ROWV; ++j) { u2v w; w.x = pk2(v[j].x, v[j].y); w.y = pk2(v[j].z, v[j].w); *(u2v*)(o + 4 * lane + 256 * j) = w; }
}

__device__ __forceinline__ void ph_prep(const In& I, float* RWT, int gtid, int gstride) {
    for (int idx_ = gtid; idx_ < (NL * NRL * DM) * PR_PREP; idx_ += gstride) { const int idx = idx_ % (NL * NRL * DM);
        const int k = idx % DM, jj = (idx / DM) % NRL, l = idx / (DM * NRL);
        RWT[idx] = jj < NEG ? I.router_grp_w[((size_t)l * DM + k) * NEG + jj] : I.router_exp_w[((size_t)l * DM + k) * NE + (jj - NEG)];
    }
}
__device__ __forceinline__ void ph_adaln_part(const In& I, float* PART, const LAS float* scond, int gw, int ngw, int lane) {
    constexpr int NCH = NMOD * DM / 256;
    for (int it_ = gw; it_ < NL * NCH * AD_NKS * PR_WCVT; it_ += ngw) { const int it = it_ % (NL * NCH * AD_NKS);
        const int ks = it % AD_NKS, ch = (it / AD_NKS) % NCH, l = it / (AD_NKS * NCH);
        const float* w = I.ada_w + ((size_t)l * DM + (size_t)ks * AD_KS) * (NMOD * DM) + ch * 256 + 4 * lane;
        f4 acc[NCOND];
#pragma unroll
        for (int j = 0; j < NCOND; ++j) acc[j] = (f4){0.f, 0.f, 0.f, 0.f};
#pragma unroll 8
        for (int k = 0; k < AD_KS; ++k) { const f4 wv = *(const f4*)(w + (size_t)k * (NMOD * DM));
#pragma unroll
            for (int j = 0; j < NCOND; ++j) acc[j] += wv * scond[j * DM + ks * AD_KS + k]; }
#pragma unroll
        for (int j = 0; j < NCOND; ++j) *(f4*)(PART + (((size_t)ks * NL + l) * NCOND + j) * (NMOD * DM) + ch * 256 + 4 * lane) = acc[j];
    }
}
__device__ __forceinline__ void ph_adaln_reduce(const In& I, const float* PART, float* MOD, int gtid, int gstride) {
    for (int idx_ = gtid; idx_ < (NL * NCOND * NMOD * DM) * PR_PREP; idx_ += gstride) { const int idx = idx_ % (NL * NCOND * NMOD * DM);
        const int n = idx % (NMOD * DM), l = idx / (NCOND * NMOD * DM);
        float s = I.ada_b[(size_t)l * NMOD * DM + n];
        for (int ks = 0; ks < AD_NKS; ++ks) s += PART[(size_t)ks * NL * NCOND * NMOD * DM + idx];
        MOD[idx] = s;
    }
}

__device__ __forceinline__ void row_combine(f4 (&v)[ROWV], const bf16_t* Yb, const int* TS, const float* TG, const float* mod5, int r, int lane) {
    const int s0 = TS[2 * r], s1 = TS[2 * r + 1]; const float g0 = TG[2 * r], g1 = TG[2 * r + 1];
#pragma unroll
    for (int j = 0; j < ROWV; ++j) { const int c = 4 * lane + 256 * j;
        const u2v a = *(const u2v*)(Yb + (size_t)s0 * DM + c), b = *(const u2v*)(Yb + (size_t)s1 * DM + c); const f4 m = *(const f4*)(mod5 + c);
        f4 y; y.x = g0 * bflo(a.x) + g1 * bflo(b.x); y.y = g0 * bfhi(a.x) + g1 * bfhi(b.x); y.z = g0 * bflo(a.y) + g1 * bflo(b.y); y.w = g0 * bfhi(a.y) + g1 * bfhi(b.y);
        v[j] += m * y; }
}

template <int MODE>
__device__ __forceinline__ void ph_norm1(const In& I, int l, const float* MOD, float* X, const bf16_t* Yb, const int* TS, const float* TG, bf16_t* Hb, float* out, int gw, int ngw, int lane) {
    const int r0 = MODE == 2 ? NCTX : 0;
    for (int r_ = gw; r_ < (NTOK - r0) * (MODE == 0 ? PR_NORM : (MODE == 2 ? PR_FIN : 1)); r_ += ngw) { const int r = r0 + r_ % (NTOK - r0);
        f4 v[ROWV];
        const float* src = MODE == 0 ? (r < NCTX ? I.ctx + (size_t)r * DM : I.x + (size_t)(r - NCTX) * DM) : X + (size_t)r * DM;
        row_load(src, lane, v);
        const int cj = cond_of_row(r);
        if (MODE >= 1) {
            row_combine(v, Yb, TS, TG, MODV(MOD, (MODE == 1 ? l - 1 : NL - 1), cj, 5), r, lane);
            if (MODE == 1) {
#pragma unroll
                for (int j = 0; j < ROWV; ++j) *(f4*)(X + (size_t)r * DM + 4 * lane + 256 * j) = v[j]; }
        }
        const float rstd = 1.0f / sqrtf(wave_sum(row_ss(v)) * (1.0f / DM) + NORM_EPS);
        if (MODE == 2) {
#pragma unroll
            for (int j = 0; j < ROWV; ++j) { const int c = 4 * lane + 256 * j; *(f4*)(out + (size_t)(r - NCTX) * DM + c) = v[j] * rstd * *(const f4*)(I.final_g + c); }
        } else {
            row_modulate(v, rstd, I.norm1_g + (size_t)l * DM, MODV(MOD, l, cj, 1), MODV(MOD, l, cj, 0), lane);
            row_store_bf16(Hb + (size_t)r * DM, v, lane);
        }
    }
}
constexpr int RT_LDS_W = 0;
constexpr int RT_LDS_LG = 2 * 6 * DM * 4;
constexpr int RT_LDS_SE = RT_LDS_LG + 40 * 40 * 4;
__device__ __forceinline__ void route_rows(int nblk, int bid, int row_lo, int& rb0, int& rb1) {
    const int per = (NTOK - row_lo + nblk - 1) / nblk; rb0 = row_lo + bid * per; rb1 = rb0 + per < NTOK ? rb0 + per : NTOK; if (rb0 > NTOK) rb0 = NTOK;
}
__device__ __forceinline__ void ph_route(const In& I, int l, const float* MOD, const float* X, const float* RWT, int* TE, float* TG, float* RSTD, int* TP, int* HIST, LAS unsigned char* lds,
                         int row_lo, int bid, int nblk, int tid, int lane, int wave) {
    LAS float* wbuf = (LAS float*)(lds + RT_LDS_W); LAS float* lgs = (LAS float*)(lds + RT_LDS_LG); LAS int* sexp = (LAS int*)(lds + RT_LDS_SE);
    int rb0, rb1; route_rows(nblk, bid, row_lo, rb0, rb1);
    const float* wl = RWT + (size_t)l * NRL * DM;
    constexpr int RR = 5, RCH = 3;
    for (int rp_ = 0; rp_ < PR_ROUTE; ++rp_)
    for (int g0 = rb0; g0 < rb1; g0 += 8 * RR) {
        f4 v[RR][ROWV]; float rs[RR];
#pragma unroll
        for (int i = 0; i < RR; ++i) { const int r = g0 + RR * wave + i; rs[i] = 0.f;
#pragma unroll
            for (int j = 0; j < ROWV; ++j) v[i][j] = (f4){0.f, 0.f, 0.f, 0.f};
            if (r < rb1) { row_load(X + (size_t)r * DM, lane, v[i]); rs[i] = 1.0f / sqrtf(wave_sum(row_ss(v[i])) * (1.0f / DM) + NORM_EPS); const int cj = cond_of_row(r);
                row_modulate(v[i], rs[i], I.norm2_g + (size_t)l * DM, MODV(MOD, l, cj, 4), MODV(MOD, l, cj, 3), lane); } }
        f4 wn[RCH];
#pragma unroll
        for (int c = 0; c < RCH; ++c) { wn[c] = (f4){0.f, 0.f, 0.f, 0.f}; if (tid < DM / 4 && c < NRL) wn[c] = *(const f4*)(wl + (size_t)c * DM + 4 * tid); }
#pragma unroll 1
        for (int j0 = 0; j0 < NRL; j0 += RCH) { const int buf = (j0 / RCH) & 1;
            if (tid < DM / 4) {
#pragma unroll
                for (int c = 0; c < RCH; ++c) *(LAS f4*)(wbuf + (buf * RCH + c) * DM + 4 * tid) = wn[c];
#pragma unroll
                for (int c = 0; c < RCH; ++c) if (j0 + RCH + c < NRL) wn[c] = *(const f4*)(wl + (size_t)(j0 + RCH + c) * DM + 4 * tid); }
            __syncthreads();
#pragma unroll 1
            for (int c = 0; c < RCH; ++c) { const int jj = j0 + c; if (jj >= NRL) break;
                const LAS float* w = wbuf + (buf * RCH + c) * DM + 4 * lane; float s[RR];
#pragma unroll
                for (int i = 0; i < RR; ++i) s[i] = 0.f;
#pragma unroll
                for (int j = 0; j < ROWV; ++j) { const f4 wv = *(const LAS f4*)(w + 256 * j);
#pragma unroll
                    for (int i = 0; i < RR; ++i) s[i] += (v[i][j].x * wv.x + v[i][j].y * wv.y) + (v[i][j].z * wv.z + v[i][j].w * wv.w); }
                const float bias = jj < NEG ? I.router_grp_b[l * NEG + jj] : I.router_exp_b[l * NE + (jj - NEG)];
#pragma unroll
                for (int i = 0; i < RR; ++i) { const float t = wave_sum(s[i]); if (lane == 0) lgs[(RR * wave + i) * 40 + jj] = t + bias; } }
        }
        WAVE_SYNC();
#pragma unroll
        for (int i = 0; i < RR; ++i) { const int r = g0 + RR * wave + i; const bool valid = r < rb1;
            float lg[NRL];
#pragma unroll
            for (int jj = 0; jj < NRL; ++jj) lg[jj] = lgs[(RR * wave + i) * 40 + jj];
            int grp = 0; float gmax = lg[0];
#pragma unroll
            for (int j = 1; j < NEG; ++j) if (lg[j] > gmax) { gmax = lg[j]; grp = j; }
            float den = 0.f;
#pragma unroll
            for (int j = 0; j < NEG; ++j) den += expf(lg[j] - gmax);
            const float gprob = 1.0f / den;
            float sel[EPG];
#pragma unroll
            for (int j = 0; j < EPG; ++j) { float x = lg[NEG + j];
#pragma unroll
                for (int g2 = 1; g2 < NEG; ++g2) x = (grp == g2) ? lg[NEG + g2 * EPG + j] : x;
                sel[j] = x; }
            int i0 = 0; float l0 = sel[0];
#pragma unroll
            for (int j = 1; j < EPG; ++j) if (sel[j] > l0) { l0 = sel[j]; i0 = j; }
            int i1 = -1; float l1 = -3.0e38f;
#pragma unroll
            for (int j = 0; j < EPG; ++j) if (j != i0 && sel[j] > l1) { l1 = sel[j]; i1 = j; }
            const float e1 = expf(l1 - l0), g0v = gprob / (1.0f + e1), g1v = gprob * e1 / (1.0f + e1);
            if (valid && lane == 0) { const int ex0 = grp * EPG + i0, ex1 = grp * EPG + i1; TE[2 * r] = ex0; TE[2 * r + 1] = ex1; TG[2 * r] = g0v; TG[2 * r + 1] = g1v; RSTD[r] = rs[i];
                sexp[2 * (r - rb0)] = ex0; sexp[2 * (r - rb0) + 1] = ex1; } }
        WAVE_SYNC();
    }
    __syncthreads();
    const int ns = 2 * (rb1 - rb0);
    for (int t = tid; t < ns; t += 512) { const int e = sexp[t]; int rank = 0; for (int q = 0; q < t; ++q) rank += (sexp[q] == e) ? 1 : 0; TP[2 * rb0 + t] = rank; }
    if (tid < NE) { int c = 0; for (int q = 0; q < ns; ++q) c += (sexp[q] == tid) ? 1 : 0; HIST[bid * NE + tid] = c; }
    __syncthreads();
}
constexpr int GA_LDS_PS = 0;
constexpr int GA_LDS_BASE = 2 * 512 * 4;
__device__ __forceinline__ void ph_gather(const In& I, int l, const float* MOD, const float* X, const float* RSTD, const int* TE, const int* TP, const int* HIST, int* TS, bf16_t* Xg,
                          LAS unsigned char* lds, LAS int* tab, LAS int* pst, int row_lo, int bid, int nblk, int tid, int lane, int wave) {
    LAS int* psum = (LAS int*)(lds + GA_LDS_PS); LAS int* base = (LAS int*)(lds + GA_LDS_BASE); LAS int* tot = base + NE;
    int rb0, rb1; route_rows(nblk, bid, row_lo, rb0, rb1);
    f4 v[ROWV];
    { const int r = rb0 + wave < rb1 ? rb0 + wave : (rb1 > rb0 ? rb1 - 1 : rb0); row_load(X + (size_t)(r < NTOK ? r : NTOK - 1) * DM, lane, v); }
    { constexpr int PARTS = 512 / NE; const int e = tid % NE, part = tid / NE; const int per = (nblk + PARTS - 1) / PARTS; int sb = 0, st = 0;
        for (int k = 0; k < per; k += 4) { int h[4];
#pragma unroll
            for (int q = 0; q < 4; ++q) { const int bb = part * per + k + q; h[q] = HIST[(bb < nblk ? bb : nblk - 1) * NE + e]; }
#pragma unroll
            for (int q = 0; q < 4; ++q) { const int bb = part * per + k + q; if (k + q < per && bb < nblk) { st += h[q]; if (bb < bid) sb += h[q]; } } }
        psum[tid] = sb; psum[512 + tid] = st; }
    __syncthreads();
    if (tid < NE) { int sb = 0, st = 0; for (int part = 0; part < 512 / NE; ++part) { sb += psum[part * NE + tid]; st += psum[512 + part * NE + tid]; } base[tid] = sb; tot[tid] = st; }
    __syncthreads();
    if (tid == 0) { int off = 0, nru = 0;
        for (int e = 0; e < NE; ++e) { pst[e] = off; off += ((tot[e] + MOE_TILE - 1) / MOE_TILE) * MOE_TILE; }
        int nfr = 0, nhr = 0;
        for (int e = 0; e < NE; ++e) { const int n128 = (tot[e] + MOE_TILE - 1) / MOE_TILE; for (int k = 0; k + 1 < n128; k += 2) tab[2 + nfr++] = (pst[e] / MOE_TILE + k) | (e << 16); }
        for (int e = 0; e < NE; ++e) { const int n128 = (tot[e] + MOE_TILE - 1) / MOE_TILE; if (n128 & 1) tab[2 + nfr + nhr++] = (pst[e] / MOE_TILE + n128 - 1) | (e << 16); }
        tab[0] = nfr; tab[1] = nhr; }
    __syncthreads();
    for (int r = rb0 + wave; r < rb1; r += 8) {
        f4 vn[ROWV]; const int rn = r + 8 < rb1 ? r + 8 : r; row_load(X + (size_t)rn * DM, lane, vn);
        const int cj = cond_of_row(r);
        row_modulate(v, RSTD[r], I.norm2_g + (size_t)l * DM, MODV(MOD, l, cj, 4), MODV(MOD, l, cj, 3), lane);
        const int e0 = TE[2 * r], e1 = TE[2 * r + 1]; const int s0 = pst[e0] + base[e0] + TP[2 * r], s1 = pst[e1] + base[e1] + TP[2 * r + 1];
        row_store_bf16(Xg + (size_t)s0 * DM, v, lane); row_store_bf16(Xg + (size_t)s1 * DM, v, lane);
        if (lane == 0) { TS[2 * r] = s0; TS[2 * r + 1] = s1; }
#pragma unroll
        for (int j = 0; j < ROWV; ++j) v[j] = vn[j];
    }
}
__device__ __forceinline__ float fsilu(float v) { return v / (1.0f + __expf(-v)); }
__device__ __forceinline__ float fsigm(float v) { return 1.0f / (1.0f + __expf(-v)); }
struct EpiAct {
    static constexpr bool PERM = true, AFTER_DRAIN = false;
    bf16_t* O; int ldc; int ncol;
    __device__ __forceinline__ void operator()(const pg8::f32x4 (&acc)[2][2][4][2], const pg8::Unit& u, int wr, int wc, int fr, int fq) const {
        const int row0 = u.pm * 128 + wr * 64 + fr, col0 = (u.pn % ncol) * 128 + wc * 32 + 8 * fq;
#pragma unroll
        for (int ai = 0; ai < 2; ++ai)
#pragma unroll
            for (int m = 0; m < 4; ++m) { if (ai == 1 && u.half) continue; bf16_t* rowp = O + (size_t)(row0 + ai * 128 + m * 16) * ldc + col0;
                const pg8::f32x4 g0 = acc[ai][0][m][0], g1 = acc[ai][0][m][1], u0 = acc[ai][1][m][0], u1 = acc[ai][1][m][1];
                u4v w; w.x = pk2(fsilu(g0[0]) * u0[0], fsilu(g0[1]) * u0[1]); w.y = pk2(fsilu(g0[2]) * u0[2], fsilu(g0[3]) * u0[3]);
                w.z = pk2(fsilu(g1[0]) * u1[0], fsilu(g1[1]) * u1[1]); w.w = pk2(fsilu(g1[2]) * u1[2], fsilu(g1[3]) * u1[3]);
                *(u4v*)rowp = w; }
    }
};
struct EpiBf16N {
    static constexpr bool PERM = true, AFTER_DRAIN = false;
    bf16_t* O; int ldc; int ncol;
    __device__ __forceinline__ void operator()(const pg8::f32x4 (&acc)[2][2][4][2], const pg8::Unit& u, int wr, int wc, int fr, int fq) const {
        const int row0 = u.pm * 128 + wr * 64 + fr, col0 = (u.pn % ncol) * 256 + wc * 32 + 8 * fq;
#pragma unroll
        for (int ai = 0; ai < 2; ++ai)
#pragma unroll
            for (int m = 0; m < 4; ++m) { if (ai == 1 && u.half) continue; bf16_t* rowp = O + (size_t)(row0 + ai * 128 + m * 16) * ldc + col0;
#pragma unroll
                for (int bj = 0; bj < 2; ++bj) { const pg8::f32x4 a = acc[ai][bj][m][0], b = acc[ai][bj][m][1];
                    u4v w; w.x = pk2(a[0], a[1]); w.y = pk2(a[2], a[3]); w.z = pk2(b[0], b[1]); w.w = pk2(b[2], b[3]); *(u4v*)(rowp + bj * 128) = w; } }
    }
};
struct EpiGlu {
    static constexpr bool PERM = true, AFTER_DRAIN = false;
    bf16_t* O; int ldc; int ocol; const bf16_t* Zb; int ldz; const float* bias;
    __device__ __forceinline__ void operator()(const pg8::f32x4 (&acc)[2][2][4][2], const pg8::Unit& u, int wr, int wc, int fr, int fq) const {
        const int row0 = u.pm * 128 + wr * 64 + fr, col0 = u.pn * 256 + wc * 32 + 8 * fq;
#pragma unroll
        for (int ai = 0; ai < 2; ++ai)
#pragma unroll
            for (int m = 0; m < 4; ++m) { if (ai == 1 && u.half) continue; const int row = row0 + ai * 128 + m * 16;
#pragma unroll
                for (int bj = 0; bj < 2; ++bj) { const int c = col0 + bj * 128; const u4v z = *(const u4v*)(Zb + (size_t)row * ldz + c);
                    const f4 b0 = *(const f4*)(bias + c), b1 = *(const f4*)(bias + c + 4); const pg8::f32x4 a = acc[ai][bj][m][0], b = acc[ai][bj][m][1];
                    u4v w; w.x = pk2(bflo(z.x) * fsigm(a[0] + b0.x), bfhi(z.x) * fsigm(a[1] + b0.y)); w.y = pk2(bflo(z.y) * fsigm(a[2] + b0.z), bfhi(z.y) * fsigm(a[3] + b0.w));
                    w.z = pk2(bflo(z.z) * fsigm(b[0] + b1.x), bfhi(z.z) * fsigm(b[1] + b1.y)); w.w = pk2(bflo(z.w) * fsigm(b[2] + b1.z), bfhi(z.w) * fsigm(b[3] + b1.w));
                    *(u4v*)(O + (size_t)row * ldc + ocol + c) = w; } }
    }
};
struct EpiResid {
    static constexpr bool PERM = false, AFTER_DRAIN = false;
    float* Xo; const float* res_ctx; const float* res_lat; const float* MOD; int l; int row_base;
    __device__ __forceinline__ void operator()(const pg8::f32x4 (&acc)[2][2][4][2], const pg8::Unit& u, int wr, int wc, int fr, int fq) const {
        const int row0 = row_base + u.pm * 128 + wr * 64 + fr, col0 = u.pn * 256 + wc * 32 + 4 * fq;
#pragma unroll
        for (int ai = 0; ai < 2; ++ai)
#pragma unroll
            for (int m = 0; m < 4; ++m) { if (ai == 1 && u.half) continue; const int row = row0 + ai * 128 + m * 16;
                const float* rp = (row < NCTX ? res_ctx + (size_t)row * DM : res_lat + (size_t)(row - NCTX) * DM) + col0;
                const float* mp = MODV(MOD, l, cond_of_row(row), 2) + col0; float* op = Xo + (size_t)row * DM + col0;
#pragma unroll
                for (int bj = 0; bj < 2; ++bj)
#pragma unroll
                    for (int n = 0; n < 2; ++n) { const int o = bj * 128 + n * 16; const f4 r4 = *(const f4*)(rp + o), m4 = *(const f4*)(mp + o); const pg8::f32x4 a = acc[ai][bj][m][n];
                        f4 x; x.x = r4.x + m4.x * a[0]; x.y = r4.y + m4.y * a[1]; x.z = r4.z + m4.z * a[2]; x.w = r4.w + m4.w * a[3]; *(f4*)(op + o) = x; } }
    }
};
}
namespace nv {
typedef short s8v __attribute__((ext_vector_type(8)));
constexpr int RPAD = 136;
constexpr float LOG2E = 1.4426950408889634f;
__device__ __forceinline__ float shfl_xor_f(float v, int lane, int m) { return __builtin_bit_cast(float, __builtin_amdgcn_ds_bpermute((lane ^ m) << 2, __builtin_bit_cast(int, v))); }

__device__ __forceinline__ void ph_rope_table(float* ROPE, int gtid, int gstride) {
    constexpr int NF = HD / 4;
    for (int idx_ = gtid; idx_ < (SQ * (HD / 2)) * PR_PREP; idx_ += gstride) { const int idx = idx_ % (SQ * (HD / 2));
        const int i = idx % (HD / 2), pos = idx / (HD / 2), rowp = pos / GW, colp = pos % GW, f = i < NF ? i : i - NF;
        const float inv = powf(10000.0f, -(float)f / (float)NF), ang = (i < NF ? (float)rowp : (float)colp) * inv;
        ROPE[2 * idx] = cosf(ang); ROPE[2 * idx + 1] = sinf(ang);
    }
}
struct EpiQKV {
    static constexpr bool PERM = true, AFTER_DRAIN = false;
    bf16_t* O; const float* ROPE;
    __device__ __forceinline__ void operator()(const pg8::f32x4 (&acc)[2][2][4][2], const pg8::Unit& u, int wr, int wc, int fr, int fq) const {
        const int row0 = u.pm * 128 + wr * 64 + fr, col0 = u.pn * 256 + wc * 32 + 8 * fq;
        const int region = (u.pn * 256) / RW;
        const float ksc = region == 1 ? 1.0f / sqrtf((float)HD) : 1.0f;
#pragma unroll
        for (int ai = 0; ai < 2; ++ai)
#pragma unroll
            for (int m = 0; m < 4; ++m) { if (ai == 1 && u.half) continue; const int row = row0 + ai * 128 + m * 16; bf16_t* rowp = O + (size_t)row * INW + col0;
                const bool rope = region < 2 && row >= NCTX; const int pos = rope ? (row - NCTX) % SQ : 0;
#pragma unroll
                for (int bj = 0; bj < 2; ++bj) { pg8::f32x4 a = acc[ai][bj][m][0], b = acc[ai][bj][m][1];
                    if (rope) { const int i0 = ((col0 + bj * 128) % HD) / 2; const f4* rp = (const f4*)(ROPE + ((size_t)pos * (HD / 2) + i0) * 2); const f4 c0 = rp[0], c1 = rp[1];
                        pg8::f32x4 x, y; x[0] = a[0] * c0.x - a[1] * c0.y; x[1] = a[0] * c0.y + a[1] * c0.x; x[2] = a[2] * c0.z - a[3] * c0.w; x[3] = a[2] * c0.w + a[3] * c0.z;
                        y[0] = b[0] * c1.x - b[1] * c1.y; y[1] = b[0] * c1.y + b[1] * c1.x; y[2] = b[2] * c1.z - b[3] * c1.w; y[3] = b[2] * c1.w + b[3] * c1.z; a = x; b = y; }
                    a = a * ksc; b = b * ksc;
                    u4v w; w.x = pk2(a[0], a[1]); w.y = pk2(a[2], a[3]); w.z = pk2(b[0], b[1]); w.w = pk2(b[2], b[3]); *(u4v*)(rowp + bj * 128) = w; } }
    }
};
__device__ __forceinline__ pg8::f32x4 mfma16(const s8v a, const s8v b, const pg8::f32x4 c) { return __builtin_amdgcn_mfma_f32_16x16x32_bf16(a, b, c, 0, 0, 0); }

__device__ __forceinline__ void ph_ret_kv(const In& I, int l, const bf16_t* QKVb, bf16_t* KVT, LAS unsigned char* lds, int bid, int nblk, int tid, int lane, int wave) {
    LAS bf16_t* KTf = (LAS bf16_t*)lds; LAS bf16_t* KTb = KTf + HD * RPAD; LAS bf16_t* VT = KTb + HD * RPAD;
    const int fr = lane & 15, fq = lane >> 4;
    for (int u_ = bid; u_ < NB * NH * NCH * PR_RET; u_ += nblk) { const int u = u_ % (NB * NH * NCH);
        const int n = u % NCH, h = (u / NCH) % NH, b = u / (NCH * NH);
        const float lgf = logg(I, l, 0, h), lgb = logg(I, l, 1, h);
        { const int p = tid & 127, row = row_of(b, n, p); const float wf = expf(lgf * (float)(RC - 1 - p)), wb = expf(lgb * (float)p);
            const bf16_t* kp = QKVb + (size_t)row * INW + RW + h * HD; const bf16_t* vp = QKVb + (size_t)row * INW + 2 * RW + h * HD;
#pragma unroll
            for (int i = 0; i < 4; ++i) { const int dg = (tid >> 7) + 4 * i; const u4v kk = *(const u4v*)(kp + 8 * dg), vv = *(const u4v*)(vp + 8 * dg);
#pragma unroll
                for (int j = 0; j < 8; ++j) { const unsigned kw = kk[j >> 1], vw = vv[j >> 1]; const float kf = (j & 1) ? bfhi(kw) : bflo(kw);
                    KTf[(8 * dg + j) * RPAD + p] = (bf16_t)f2bf_u(kf * wf); KTb[(8 * dg + j) * RPAD + p] = (bf16_t)f2bf_u(kf * wb);
                    VT[(8 * dg + j) * RPAD + p] = (bf16_t)((j & 1) ? (vw >> 16) : (vw & 0xffffu)); } } }
        __syncthreads();
        pg8::f32x4 acc[2][8];
#pragma unroll
        for (int d = 0; d < 2; ++d)
#pragma unroll
            for (int k = 0; k < 8; ++k) acc[d][k] = (pg8::f32x4){0.f, 0.f, 0.f, 0.f};
#pragma unroll
        for (int s = 0; s < 4; ++s) { const s8v bfrag = *(const LAS s8v*)(VT + (16 * wave + fr) * RPAD + 32 * s + 8 * fq);
#pragma unroll
            for (int db = 0; db < 8; ++db) { const s8v af = *(const LAS s8v*)(KTf + (16 * db + fr) * RPAD + 32 * s + 8 * fq), ab = *(const LAS s8v*)(KTb + (16 * db + fr) * RPAD + 32 * s + 8 * fq);
                acc[0][db] = mfma16(af, bfrag, acc[0][db]); acc[1][db] = mfma16(ab, bfrag, acc[1][db]); } }
        const int e = 16 * wave + fr;
#pragma unroll
        for (int d = 0; d < 2; ++d)
#pragma unroll
            for (int db = 0; db < 8; ++db) { u2v w; w.x = pk2(acc[d][db][0], acc[d][db][1]); w.y = pk2(acc[d][db][2], acc[d][db][3]);
                *(u2v*)(KVT + (((((size_t)d * NB + b) * NH + h) * NCH + n) * HD + e) * HD + 16 * db + 4 * fq) = w; }
        __syncthreads();
    }
}
__device__ __forceinline__ void ph_ret_scan(const In& I, int l, const bf16_t* KVT, bf16_t* STT, int gtid, int gstride) {
    for (int idx_ = gtid; idx_ < 2 * NB * NH * HD * (HD / 4) * PR_RET; idx_ += gstride) { const int idx = idx_ % (2 * NB * NH * HD * (HD / 4));
        const int ed = idx % (HD * HD / 4); int t = idx / (HD * HD / 4); const int h = t % NH; t /= NH; const int b = t % NB, dir = t / NB;
        const float dec = expf(logg(I, l, dir, h) * (float)RC); f4 s = (f4){0.f, 0.f, 0.f, 0.f};
#pragma unroll 1
        for (int step = 0; step < NCH; ++step) { const int n = chain_chunk(dir, step);
            const size_t o = ((((size_t)dir * NB + b) * NH + h) * NCH + n) * HD * HD + 4 * (size_t)ed;
            u2v w; w.x = pk2(s.x, s.y); w.y = pk2(s.z, s.w); *(u2v*)(STT + o) = w;
            const u2v kw = *(const u2v*)(KVT + o); const f4 kv = (f4){bflo(kw.x), bfhi(kw.x), bflo(kw.y), bfhi(kw.y)}; s = s * dec + kv; }
    }
}
__device__ __forceinline__ void ph_ret_out(const In& I, int l, const bf16_t* QKVb, const bf16_t* STT, bf16_t* MIXb, LAS unsigned char* lds, int n_lo, int bid, int nblk, int tid, int lane, int wave) {
    LAS bf16_t* Kt = (LAS bf16_t*)lds; LAS bf16_t* VT = Kt + RC * RPAD; LAS bf16_t* ST = VT + HD * RPAD;
    const int fr = lane & 15, fq = lane >> 4, ncn = NCH - n_lo;
    for (int u_ = bid; u_ < NB * NH * ncn * PR_RET; u_ += nblk) { const int u = u_ % (NB * NH * ncn);
        const int n = n_lo + u % ncn, h = (u / ncn) % NH, b = u / (ncn * NH);
        const float lgf = logg(I, l, 0, h), lgb = logg(I, l, 1, h);
#pragma unroll
        for (int i = 0; i < 4; ++i) { const int q = i * 512 + tid, dgq = q & 15, p = q >> 4; const int row = row_of(b, n, p);
            *(LAS u4v*)(Kt + p * RPAD + 8 * dgq) = *(const u4v*)(QKVb + (size_t)row * INW + RW + h * HD + 8 * dgq);
            *(LAS u4v*)(ST + p * RPAD + 8 * dgq) = *(const u4v*)(STT + ((((size_t)0 * NB + b) * NH + h) * NCH + n) * HD * HD + (size_t)p * HD + 8 * dgq); }
        { const int p = tid & 127, row = row_of(b, n, p); const bf16_t* vp = QKVb + (size_t)row * INW + 2 * RW + h * HD;
#pragma unroll
            for (int i = 0; i < 4; ++i) { const int dg = (tid >> 7) + 4 * i; const u4v vv = *(const u4v*)(vp + 8 * dg);
#pragma unroll
                for (int j = 0; j < 8; ++j) { const unsigned vw = vv[j >> 1]; VT[(8 * dg + j) * RPAD + p] = (bf16_t)((j & 1) ? (vw >> 16) : (vw & 0xffffu)); } } }
        __syncthreads();
        const int ipos = 16 * wave + fr, rowq = row_of(b, n, ipos);
        s8v qf[4];
#pragma unroll
        for (int s = 0; s < 4; ++s) qf[s] = *(const s8v*)(QKVb + (size_t)rowq * INW + h * HD + 32 * s + 8 * fq);
        pg8::f32x4 st[8];
#pragma unroll
        for (int jt = 0; jt < 8; ++jt) { st[jt] = (pg8::f32x4){0.f, 0.f, 0.f, 0.f};
#pragma unroll
            for (int s = 0; s < 4; ++s) st[jt] = mfma16(*(const LAS s8v*)(Kt + (16 * jt + fr) * RPAD + 32 * s + 8 * fq), qf[s], st[jt]); }
        const float lf2 = lgf * LOG2E, lb2 = lgb * LOG2E;
#pragma unroll
        for (int jt = 0; jt < 8; ++jt)
#pragma unroll
            for (int r = 0; r < 4; ++r) { const int diff = ipos - (16 * jt + 4 * fq + r); st[jt][r] *= diff >= 0 ? exp2f(lf2 * (float)diff) : exp2f(lb2 * (float)(-diff)); }
        s8v pf[4];
#pragma unroll
        for (int s = 0; s < 4; ++s) { u4v w; w.x = pk2(st[2 * s][0], st[2 * s][1]); w.y = pk2(st[2 * s][2], st[2 * s][3]); w.z = pk2(st[2 * s + 1][0], st[2 * s + 1][1]); w.w = pk2(st[2 * s + 1][2], st[2 * s + 1][3]);
            pf[s] = __builtin_bit_cast(s8v, w); }
        pg8::f32x4 o0[8], oF[8], oB[8];
#pragma unroll
        for (int eb = 0; eb < 8; ++eb) { o0[eb] = (pg8::f32x4){0.f, 0.f, 0.f, 0.f}; oF[eb] = o0[eb]; oB[eb] = o0[eb]; }
        const bf16_t* stb = STT + ((((size_t)1 * NB + b) * NH + h) * NCH + n) * HD * HD;
        u4v sb[4];
#pragma unroll
        for (int i = 0; i < 4; ++i) { const int q = i * 512 + tid, dgq = q & 15, e = q >> 4; sb[i] = *(const u4v*)(stb + (size_t)e * HD + 8 * dgq); }
#pragma unroll
        for (int eb = 0; eb < 8; ++eb)
#pragma unroll
            for (int s = 0; s < 4; ++s) { const LAS bf16_t* vr = VT + (16 * eb + fr) * RPAD + 32 * s + 4 * fq; const u2v lo = *(const LAS u2v*)vr, hi = *(const LAS u2v*)(vr + 16);
                u4v a; a.x = lo.x; a.y = lo.y; a.z = hi.x; a.w = hi.y; o0[eb] = mfma16(__builtin_bit_cast(s8v, a), pf[s], o0[eb]);
                oF[eb] = mfma16(*(const LAS s8v*)(ST + (16 * eb + fr) * RPAD + 32 * s + 8 * fq), qf[s], oF[eb]); }
        __syncthreads();
#pragma unroll
        for (int i = 0; i < 4; ++i) { const int q = i * 512 + tid, dgq = q & 15, e = q >> 4; *(LAS u4v*)(ST + e * RPAD + 8 * dgq) = sb[i]; }
        __syncthreads();
#pragma unroll
        for (int eb = 0; eb < 8; ++eb)
#pragma unroll
            for (int s = 0; s < 4; ++s) oB[eb] = mfma16(*(const LAS s8v*)(ST + (16 * eb + fr) * RPAD + 32 * s + 8 * fq), qf[s], oB[eb]);
        const float qwf = expf(lgf * (float)(ipos + 1)), qwb = expf(lgb * (float)(RC - ipos));
        float sum = 0.f;
#pragma unroll
        for (int eb = 0; eb < 8; ++eb) { o0[eb] = o0[eb] + oF[eb] * qwf + oB[eb] * qwb; sum += (o0[eb][0] + o0[eb][1]) + (o0[eb][2] + o0[eb][3]); }
        sum += shfl_xor_f(sum, lane, 16); sum += shfl_xor_f(sum, lane, 32);
        const float mu = sum * (1.0f / HD); float var = 0.f;
#pragma unroll
        for (int eb = 0; eb < 8; ++eb) { o0[eb] = o0[eb] - mu; var += (o0[eb][0] * o0[eb][0] + o0[eb][1] * o0[eb][1]) + (o0[eb][2] * o0[eb][2] + o0[eb][3] * o0[eb][3]); }
        var += shfl_xor_f(var, lane, 16); var += shfl_xor_f(var, lane, 32);
        const float rs = 1.0f / sqrtf(var * (1.0f / HD) + GN_EPS);
        const bf16_t* gp = QKVb + (size_t)rowq * INW + 3 * RW + h * HD + 4 * fq; bf16_t* op = MIXb + (size_t)rowq * DM + h * HD + 4 * fq;
#pragma unroll
        for (int eb = 0; eb < 8; ++eb) { const u2v g = *(const u2v*)(gp + 16 * eb);
            u2v w; w.x = pk2(o0[eb][0] * rs * fsilu(bflo(g.x)), o0[eb][1] * rs * fsilu(bfhi(g.x))); w.y = pk2(o0[eb][2] * rs * fsilu(bflo(g.y)), o0[eb][3] * rs * fsilu(bfhi(g.y)));
            *(u2v*)(op + 16 * eb) = w; }
        __syncthreads();
    }
}
}
namespace nv {
constexpr int MCT = 16;
constexpr int NMC = (CTXL + SQ) / MCT;
constexpr int NTL = NMC / 16;
constexpr int CTL = CTXL / 256;
static_assert(CTXL % 256 == 0 && SQ % 256 == 0 && SG == 16 && SP == 64 && NG % 8 == 0, "S5 phase geometry");
constexpr int UP = 264;
constexpr int S5_LDS_LOC = ((NMC * UP * 2 + 15) / 16) * 16, LOCP = 132, S5_LDS_HIN = S5_LDS_LOC + 2 * 16 * LOCP * 4, S5_LDS_END = S5_LDS_HIN + 2 * 16 * RPAD * 2;
static_assert(S5_LDS_END <= 131072, "S5 LDS map");
__device__ __forceinline__ void ph_s5_prep1(const In& I, float* LAMP, float* BBc, int gtid, int gstride) {
    for (int idx_ = gtid; idx_ < (NL * 2 * NG * SP) * PR_PREP; idx_ += gstride) { const int idx = idx_ % (NL * 2 * NG * SP);
        const int p = idx % SP, g = (idx / SP) % NG, ld = idx / (SP * NG);
        const size_t ia = ((size_t)ld * NG + g) * SP + p;
        const double are = I.s5_a_re[ia], aim = I.s5_a_im[ia], dt = exp((double)I.s5_log_step[(size_t)ld * NG + g]);
        for (int tau = 0; tau <= 16; ++tau) { const double mag = exp(tau * are * dt), ang = tau * aim * dt;
            float* o = LAMP + ((((size_t)ld * NG + g) * 17 + tau) * SP + p) * 2; o[0] = (float)(mag * cos(ang)); o[1] = (float)(mag * sin(ang)); }
        const double mag = exp(are * dt), ang = aim * dt, abr = mag * cos(ang), abi = mag * sin(ang), den = are * are + aim * aim, nr = abr - 1.0;
        const double fr = (nr * are + abi * aim) / den, fi = (abi * are - nr * aim) / den;
        for (int c = 0; c < SG; ++c) { const double br = I.s5_b_re[ia * SG + c], bi = I.s5_b_im[ia * SG + c];
            BBc[(ia * SG + c) * 2] = (float)(fr * br - fi * bi); BBc[(ia * SG + c) * 2 + 1] = (float)(fr * bi + fi * br); }
    }
}
__device__ __forceinline__ void ph_s5_prep2a(const In& I, const float* LAMP, const float* BBc, float* KTAU, int gtid, int gstride) {
    for (int idx_ = gtid; idx_ < NL * 2 * NG * 16 * SG * PR_PREP; idx_ += gstride) { const int idx = idx_ % (NL * 2 * NG * 16 * SG);
        const int co = idx % SG, tau = (idx / SG) % 16, g = (idx / (SG * 16)) % NG, ld = idx / (SG * 16 * NG);
        const float* lam = LAMP + (((size_t)ld * NG + g) * 17 + tau) * SP * 2; const float* bb = BBc + ((size_t)ld * NG + g) * SP * SG * 2;
        const float* cr = I.s5_c_re + (((size_t)ld * NG + g) * SG + co) * SP; const float* cim = I.s5_c_im + (((size_t)ld * NG + g) * SG + co) * SP;
        float acc[SG];
#pragma unroll
        for (int ci = 0; ci < SG; ++ci) acc[ci] = 0.f;
#pragma unroll 2
        for (int p = 0; p < SP; ++p) { const float wr = cr[p] * lam[2 * p] - cim[p] * lam[2 * p + 1], wi = cr[p] * lam[2 * p + 1] + cim[p] * lam[2 * p];
            const f4* b4 = (const f4*)(bb + (size_t)p * SG * 2);
#pragma unroll
            for (int q = 0; q < SG / 2; ++q) { const f4 x = b4[q]; acc[2 * q] += wr * x.x - wi * x.y; acc[2 * q + 1] += wr * x.z - wi * x.w; } }
        f4* o = (f4*)(KTAU + (size_t)idx * SG);
#pragma unroll
        for (int q = 0; q < SG / 4; ++q) o[q] = (f4){acc[4 * q], acc[4 * q + 1], acc[4 * q + 2], acc[4 * q + 3]};
    }
}
__device__ __forceinline__ void ph_s5_prep2b(const In& I, const float* LAMP, const float* BBc, bf16_t* MINT, bf16_t* MOUT, int gtid, int gstride) {
    for (int idx_ = gtid; idx_ < NL * 2 * NG * 128 * 32 * PR_PREP; idx_ += gstride) { const int idx = idx_ % (NL * 2 * NG * 128 * 32);
        const int k8 = idx % 32, n = (idx / 32) % 128, g = (idx / (32 * 128)) % NG, ld = idx / (32 * 128 * NG), dir = ld & 1;
        const int reim = n >> 6, p = n & 63, t = k8 >> 1, ci0 = (k8 & 1) * 8, e = dir == 0 ? 15 - t : t;
        const float* lam = LAMP + ((((size_t)ld * NG + g) * 17 + e) * SP + p) * 2; const f4* b4 = (const f4*)(BBc + ((((size_t)ld * NG + g) * SP + p) * SG + ci0) * 2);
        const float lr = lam[0], li = lam[1]; float v[8];
#pragma unroll
        for (int q = 0; q < 4; ++q) { const f4 x = b4[q]; v[2 * q] = reim ? lr * x.y + li * x.x : lr * x.x - li * x.y; v[2 * q + 1] = reim ? lr * x.w + li * x.z : lr * x.z - li * x.w; }
        u4v w; w.x = pk2(v[0], v[1]); w.y = pk2(v[2], v[3]); w.z = pk2(v[4], v[5]); w.w = pk2(v[6], v[7]);
        *(u4v*)(MINT + (size_t)idx * 8) = w;
    }
    for (int idx_ = gtid; idx_ < NL * 2 * NG * 256 * 16 * PR_PREP; idx_ += gstride) { const int idx = idx_ % (NL * 2 * NG * 256 * 16);
        const int k8 = idx % 16, n2 = (idx / 16) % 256, g = (idx / (16 * 256)) % NG, ld = idx / (16 * 256 * NG), dir = ld & 1;
        const int reim = k8 >> 3, p0 = (k8 & 7) * 8, t = n2 >> 4, co = n2 & 15, f = dir == 0 ? t + 1 : 16 - t;
        const f4* l4 = (const f4*)(LAMP + ((((size_t)ld * NG + g) * 17 + f) * SP + p0) * 2);
        const f4* cr4 = (const f4*)(I.s5_c_re + (((size_t)ld * NG + g) * SG + co) * SP + p0); const f4* ci4 = (const f4*)(I.s5_c_im + (((size_t)ld * NG + g) * SG + co) * SP + p0);
        float crv[8], civ[8], v[8];
#pragma unroll
        for (int q = 0; q < 2; ++q) { const f4 a = cr4[q], b = ci4[q]; crv[4 * q] = a.x; crv[4 * q + 1] = a.y; crv[4 * q + 2] = a.z; crv[4 * q + 3] = a.w; civ[4 * q] = b.x; civ[4 * q + 1] = b.y; civ[4 * q + 2] = b.z; civ[4 * q + 3] = b.w; }
#pragma unroll
        for (int q = 0; q < 4; ++q) { const f4 x = l4[q];
            v[2 * q] = reim ? -(crv[2 * q] * x.y + civ[2 * q] * x.x) : crv[2 * q] * x.x - civ[2 * q] * x.y;
            v[2 * q + 1] = reim ? -(crv[2 * q + 1] * x.w + civ[2 * q + 1] * x.z) : crv[2 * q + 1] * x.z - civ[2 * q + 1] * x.w; }
        u4v w; w.x = pk2(v[0], v[1]); w.y = pk2(v[2], v[3]); w.z = pk2(v[4], v[5]); w.w = pk2(v[6], v[7]);
        *(u4v*)(MOUT + (size_t)idx * 8) = w;
    }
}
__device__ __forceinline__ void ph_s5_prep3(const In& I, const float* KTAU, bf16_t* KTOT, int gtid, int gstride) {
    for (int idx_ = gtid; idx_ < NL * NG * 256 * 32 * PR_PREP; idx_ += gstride) { const int idx = idx_ % (NL * NG * 256 * 32);
        const int k8 = idx % 32, n = (idx / 32) % 256, g = (idx / (32 * 256)) % NG, l = idx / (32 * 256 * NG);
        const int t = n >> 4, co = n & 15, tp = k8 >> 1, ci0 = (k8 & 1) * 8;
        float v[8];
#pragma unroll
        for (int q = 0; q < 8; ++q) v[q] = 0.f;
        if (tp <= t) { const f4* s = (const f4*)(KTAU + (((((size_t)l * 2 + 0) * NG + g) * 16 + (t - tp)) * SG + co) * SG + ci0); const f4 a = s[0], b = s[1];
            v[0] += a.x; v[1] += a.y; v[2] += a.z; v[3] += a.w; v[4] += b.x; v[5] += b.y; v[6] += b.z; v[7] += b.w; }
        if (tp >= t) { const f4* s = (const f4*)(KTAU + (((((size_t)l * 2 + 1) * NG + g) * 16 + (tp - t)) * SG + co) * SG + ci0); const f4 a = s[0], b = s[1];
            v[0] += a.x; v[1] += a.y; v[2] += a.z; v[3] += a.w; v[4] += b.x; v[5] += b.y; v[6] += b.z; v[7] += b.w; }
        if (tp == t && co >= ci0 && co < ci0 + 8) { const float dd = I.s5_d[((size_t)l * NG + g) * SG + co];
#pragma unroll
            for (int q = 0; q < 8; ++q) if (q == co - ci0) v[q] += dd; }
        u4v w; w.x = pk2(v[0], v[1]); w.y = pk2(v[2], v[3]); w.z = pk2(v[4], v[5]); w.w = pk2(v[6], v[7]);
        *(u4v*)(KTOT + (size_t)idx * 8) = w;
    }
}
__device__ __forceinline__ int s5_token(int b, int m, int t) { return m < CTXL / MCT ? b * CTXL + MCT * m + t : NCTX + b * SQ + MCT * (m - CTXL / MCT) + t; }

__device__ __forceinline__ int s5_chain_m(int dir, int c) { return dir == 0 ? c : (c < CTXL / MCT ? CTXL / MCT - 1 - c : NMC - 1 - (c - CTXL / MCT)); }
__device__ __forceinline__ void ph_s5(int l, const bf16_t* QKVb, const float* LAMP, const bf16_t* MINT, const bf16_t* MOUT, const bf16_t* KTOT, bf16_t* Zb, LAS unsigned char* lds,
                      int mt_lo, int bid, int nblk, int tid, int lane, int wave) {
    LAS bf16_t* U = (LAS bf16_t*)lds;
    const int fr = lane & 15, fq = lane >> 4;
    for (int u_ = bid; u_ < NG * NB * PR_S5; u_ += nblk) { const int u = u_ % (NG * NB);
        const int g = (u % 8) + 8 * (u / (8 * NB)), b = (u / 8) % NB;
        for (int q = tid; q < NMC * MCT * 2; q += 512) { const int half = q & 1, tok = q >> 1, m = tok / MCT, t = tok % MCT;
            *(LAS u4v*)(U + m * UP + t * 16 + 8 * half) = *(const u4v*)(QKVb + (size_t)s5_token(b, m, t) * INW + 4 * RW + g * SG + 8 * half); }
        __syncthreads();
        unsigned Lp[NTL][2][2];
        { pg8::f32x4 L[NTL][2];
#pragma unroll
            for (int mt = 0; mt < NTL; ++mt) { L[mt][0] = (pg8::f32x4){0.f, 0.f, 0.f, 0.f}; L[mt][1] = L[mt][0]; }
            const int ldir = wave >> 2; const bf16_t* mi = MINT + ((((size_t)l * 2 + ldir) * NG + g) * 128 + 32 * (wave & 3) + fr) * 256 + 8 * fq;
            s8v q[4][2];
#pragma unroll
            for (int s = 0; s < 4; ++s) { q[s][0] = *(const s8v*)(mi + 32 * s); q[s][1] = *(const s8v*)(mi + 16 * 256 + 32 * s); }
#pragma unroll 1
            for (int h = 0; h < 2; ++h) { s8v n[4][2];
#pragma unroll
                for (int s = 0; s < 4; ++s) { n[s][0] = q[s][0]; n[s][1] = q[s][1]; }
                if (h == 0) {
#pragma unroll
                    for (int s = 0; s < 4; ++s) { n[s][0] = *(const s8v*)(mi + 32 * (4 + s)); n[s][1] = *(const s8v*)(mi + 16 * 256 + 32 * (4 + s)); } }
#pragma unroll
                for (int s = 0; s < 4; ++s) {
#pragma unroll
                    for (int mt = 0; mt < NTL; ++mt) { const s8v a = *(const LAS s8v*)(U + (16 * mt + fr) * UP + 128 * h + 32 * s + 8 * fq); L[mt][0] = mfma16(a, q[s][0], L[mt][0]); L[mt][1] = mfma16(a, q[s][1], L[mt][1]); } }
#pragma unroll
                for (int s = 0; s < 4; ++s) { q[s][0] = n[s][0]; q[s][1] = n[s][1]; } }
#pragma unroll
            for (int mt = 0; mt < NTL; ++mt)
#pragma unroll
                for (int c = 0; c < 2; ++c) { Lp[mt][c][0] = pk2(L[mt][c][0], L[mt][c][1]); Lp[mt][c][1] = pk2(L[mt][c][2], L[mt][c][3]); } }
        pg8::f32x4 Y[NTL][2];
#pragma unroll
        for (int mt = 0; mt < NTL; ++mt) { Y[mt][0] = (pg8::f32x4){0.f, 0.f, 0.f, 0.f}; Y[mt][1] = Y[mt][0]; }
        { const bf16_t* kt = KTOT + (((size_t)l * NG + g) * 256 + 32 * wave + fr) * 256 + 8 * fq;
            s8v q[4][2];
#pragma unroll
            for (int s = 0; s < 4; ++s) { q[s][0] = *(const s8v*)(kt + 32 * s); q[s][1] = *(const s8v*)(kt + 16 * 256 + 32 * s); }
#pragma unroll 1
            for (int h = 0; h < 2; ++h) { s8v n[4][2];
#pragma unroll
                for (int s = 0; s < 4; ++s) { n[s][0] = q[s][0]; n[s][1] = q[s][1]; }
                if (h == 0) {
#pragma unroll
                    for (int s = 0; s < 4; ++s) { n[s][0] = *(const s8v*)(kt + 32 * (4 + s)); n[s][1] = *(const s8v*)(kt + 16 * 256 + 32 * (4 + s)); } }
#pragma unroll
                for (int s = 0; s < 4; ++s) {
#pragma unroll
                    for (int mt = 0; mt < NTL; ++mt) { const s8v a = *(const LAS s8v*)(U + (16 * mt + fr) * UP + 128 * h + 32 * s + 8 * fq); Y[mt][0] = mfma16(a, q[s][0], Y[mt][0]); Y[mt][1] = mfma16(a, q[s][1], Y[mt][1]); } }
#pragma unroll
                for (int s = 0; s < 4; ++s) { q[s][0] = n[s][0]; q[s][1] = n[s][1]; } } }
        __syncthreads();
        int fr2 = fr, fq2 = fq; asm volatile("" : "+v"(fr2), "+v"(fq2));
#pragma unroll
        for (int mt = 0; mt < NTL; ++mt)
#pragma unroll
            for (int c = 0; c < 2; ++c)
#pragma unroll
                for (int r = 0; r < 4; ++r) { const unsigned w = Lp[mt][c][r >> 1]; U[(16 * mt + 4 * fq2 + r) * UP + 32 * wave + 16 * c + fr2] = (bf16_t)((r & 1) ? (w >> 16) : (w & 0xffffu)); }
        __syncthreads();
        int tid2 = tid; asm volatile("" : "+v"(tid2));
        if (tid2 < 128) { const int dir = tid2 >> 6, p = tid2 & 63; const float* lam = LAMP + (((((size_t)l * 2 + dir) * NG + g) * 17 + 16) * SP + p) * 2; const float l16r = lam[0], l16i = lam[1];
            float hre = 0.f, him = 0.f; LAS bf16_t* col = U + dir * 128 + p;
#pragma unroll 1
            for (int c0 = 0; c0 < NMC; c0 += 16) { float lr[16], li[16];
#pragma unroll
                for (int i = 0; i < 16; ++i) { const int m = s5_chain_m(dir, c0 + i); lr[i] = bf2f(col[m * UP]); li[i] = bf2f(col[m * UP + 64]); }
#pragma unroll
                for (int i = 0; i < 16; ++i) { const int m = s5_chain_m(dir, c0 + i); col[m * UP] = (bf16_t)f2bf_u(hre); col[m * UP + 64] = (bf16_t)f2bf_u(him);
                    const float nr = l16r * hre - l16i * him + lr[i], ni = l16r * him + l16i * hre + li[i]; hre = nr; him = ni; } } }
        __syncthreads();
        int fr3 = fr, fq3 = fq; asm volatile("" : "+v"(fr3), "+v"(fq3));
#pragma unroll
        for (int dir = 0; dir < 2; ++dir) { const bf16_t* mo = MOUT + ((((size_t)l * 2 + dir) * NG + g) * 256 + 32 * wave + fr3) * 128 + 8 * fq3;
            s8v bo[4][2];
#pragma unroll
            for (int s = 0; s < 4; ++s) { bo[s][0] = *(const s8v*)(mo + 32 * s); bo[s][1] = *(const s8v*)(mo + 16 * 128 + 32 * s); }
#pragma unroll
            for (int s = 0; s < 4; ++s) {
#pragma unroll
                for (int mt = 0; mt < NTL; ++mt) { const s8v a = *(const LAS s8v*)(U + (16 * mt + fr3) * UP + dir * 128 + 32 * s + 8 * fq3); Y[mt][0] = mfma16(a, bo[s][0], Y[mt][0]); Y[mt][1] = mfma16(a, bo[s][1], Y[mt][1]); } } }
        int fr4 = fr, fq4 = fq; asm volatile("" : "+v"(fr4), "+v"(fq4));
#pragma unroll
        for (int mt = 0; mt < NTL; ++mt) { if (mt < mt_lo) continue;
#pragma unroll
            for (int c = 0; c < 2; ++c)
#pragma unroll
                for (int r = 0; r < 4; ++r) { const int m = 16 * mt + 4 * fq4 + r, t = 2 * wave + c;
                    Zb[(size_t)s5_token(b, m, t) * SW + g * SG + fr4] = (bf16_t)f2bf_u(gelu_tanh_f(Y[mt][c][r])); } }
        __syncthreads();
    }
}
}
namespace nv {
constexpr int MK_THREADS = 512;
constexpr int MK_LDS_BYTES = 147456;
constexpr int MK_LDS_MISC = 131072;
constexpr int MK_LDS_TAB = MK_LDS_MISC + 64;
constexpr int MK_LDS_PST = MK_LDS_TAB + 1024;

struct EpiF32N {
    static constexpr bool PERM = false, AFTER_DRAIN = false;
    float* C; int ldc; int ncol;
    __device__ __forceinline__ void operator()(const pg8::f32x4 (&acc)[2][2][4][2], const pg8::Unit& u, int wr, int wc, int fr, int fq) const {
        const int row0 = u.pm * 128 + wr * 64 + fr, col0 = (u.pn % ncol) * 256 + wc * 32 + 4 * fq;
#pragma unroll
        for (int ai = 0; ai < 2; ++ai)
#pragma unroll
            for (int m = 0; m < 4; ++m) { if (ai == 1 && u.half) continue; float* rowp = C + (size_t)(row0 + ai * 128 + m * 16) * ldc + col0;
#pragma unroll
                for (int bj = 0; bj < 2; ++bj)
#pragma unroll
                    for (int n = 0; n < 2; ++n) *(pg8::f32x4*)(rowp + bj * 128 + n * 16) = acc[ai][bj][m][n]; }
    }
};
struct MoeOrder {
    const LAS int* tab; int ncol, G, v, nfu, nhu, exr, nfr, nf, j, nb, p1;
    __device__ __forceinline__ void init(const LAS int* tab_, int ncol_, int G_, int c_) {
        tab = tab_; ncol = ncol_; G = G_; v = (G_ % 8 == 0) ? (c_ % 8) * (G_ / 8) + c_ / 8 : c_;
        nfr = tab_[0]; const int nhr = tab_[1]; int uf = nfr * ncol_, uh = nhr * ncol_; exr = 0;
        { const int a = uf / G_, ex = uf % G_;
          if (ex > 0) { const int keep = 2 * (a + 1) + (uh > 2 * (G_ - ex) ? (uh - 2 * (G_ - ex) + G_ - 1) / G_ : 0), dem = 2 * a + (uh + 2 * ex + G_ - 1) / G_;
              if (dem < keep) { exr = ex / ncol_; uf -= ex; uh += 2 * ex; } } }
        nfu = uf; nhu = uh;
        const int r = nfu % G_; nf = nfu / G_ + (v < r ? 1 : 0);
        nb = G_ - r; j = v - r; p1 = 0;
        if (j >= 0) { const int lim = nhu < 2 * nb ? nhu : 2 * nb; p1 = (j < lim ? 1 : 0) + (j + nb < lim ? 1 : 0); }
    }
    __device__ __forceinline__ void half_unit(int hu, pg8::Unit& u) const {
        const int hr = hu / ncol, jc = hu % ncol; int en, part = 0;
        if (hr < 2 * exr) { en = tab[2 + (nfr - exr) + hr / 2]; part = hr & 1; } else en = tab[2 + nfr + (hr - 2 * exr)];
        u.pm = (en & 0xffff) + part; u.pn = ((en >> 16) & 0xff) * ncol + jc; u.half = 1;
    }
    __device__ __forceinline__ bool next(int i, pg8::Unit& u) const {
        if (i < nf) { const int fu = v + i * G; const int en = tab[2 + fu / ncol]; u.pm = en & 0xffff; u.pn = ((en >> 16) & 0xff) * ncol + fu % ncol; u.half = 0; return true; }
        int k = i - nf;
        if (k < p1) { half_unit(j + k * nb, u); return true; }
        k -= p1;
        const int hu = 2 * nb + v + k * G;
        if (nhu > 2 * nb && hu < nhu) { half_unit(hu, u); return true; }
        return false;
    }
    __device__ __forceinline__ void a_ready(const pg8::Unit&) const {}
    __device__ __forceinline__ void done(const pg8::Unit&) const {}
};
constexpr int I_IN = (DM / 64) * (INW / 32), I_GLU = (SW / 64) * (SW / 32), I_OUT = (DM / 64) * (DM / 32), I_G = (DM / 64) * (EFF / 32), I_D = (EFF / 64) * (DM / 32);
constexpr int NITEMS_L = I_IN + I_GLU + I_OUT + NE * (2 * I_G + I_D);
__device__ __forceinline__ void wcvt_item(const In& I, int l, unsigned char* ws, LAS float* scr, int it, int lane) {
    int r = it;
    if (r < I_IN) { p0_transpose_item(I.w_in + (size_t)l * DM * INW, DM, INW, (bf16*)(ws + OFF_WIN), 0, scr, r, lane); return; } r -= I_IN;
    if (r < I_GLU) { p0_transpose_item(I.s5_glu_w + (size_t)l * SW * SW, SW, SW, (bf16*)(ws + OFF_WGLU), 0, scr, r, lane); return; } r -= I_GLU;
    if (r < I_OUT) { p0_transpose_item(I.w_out + (size_t)l * DM * DM, DM, DM, (bf16*)(ws + OFF_WOUT), 0, scr, r, lane); return; } r -= I_OUT;
    const int e = r / (2 * I_G + I_D); r -= e * (2 * I_G + I_D);
    bf16* wgu = (bf16*)(ws + OFF_WGU) + (size_t)e * 2 * EFF * DM; bf16* wd = (bf16*)(ws + OFF_WD) + (size_t)e * DM * EFF;
    if (r < 2 * I_G) { const int up = r >= I_G ? 1 : 0; r -= up * I_G; const int n0 = 32 * (r % (EFF / 32));
        p0_transpose_item((up ? I.exp_w_up : I.exp_w_gate) + ((size_t)l * NE + e) * DM * EFF, DM, EFF, wgu, (n0 / 128) * 128 + up * 128, scr, r, lane); return; }
    r -= 2 * I_G;
    p0_transpose_item(I.exp_w_down + ((size_t)l * NE + e) * EFF * DM, EFF, DM, wd, 0, scr, r, lane);
}
__device__ __forceinline__ void wcvt_item_l0(const In& I, unsigned char* ws, LAS float* scr, int it, int lane) { wcvt_item(I, 0, ws, scr, it, lane); }
__device__ __forceinline__ void d_wcvt(const In& I, int l, unsigned char* ws, LAS unsigned char* lds, int gw, int ngw, int wave, int lane) {
    LAS float* scr = (LAS float*)(lds + wave * 16384);
    for (int it_ = gw; it_ < NITEMS_L * PR_WCVT; it_ += ngw) wcvt_item(I, l, ws, scr, it_ % NITEMS_L, lane);
}

typedef const __attribute__((address_space(4))) Params* KP;
#define KPARAMS() ({ KP kp_ = (KP)__builtin_amdgcn_kernarg_segment_ptr(); asm volatile("" : "+s"(kp_)); kp_; })
#define IN_FIELDS(F) F(x) F(c) F(ctx) F(c_ctx) F(ada_w) F(ada_b) F(norm1_g) F(w_in) F(ret_decay) F(s5_a_re) F(s5_a_im) F(s5_log_step) F(s5_b_re) F(s5_b_im) \
    F(s5_c_re) F(s5_c_im) F(s5_d) F(s5_glu_w) F(s5_glu_b) F(w_out) F(norm2_g) F(router_grp_w) F(router_grp_b) F(router_exp_w) F(router_exp_b) \
    F(exp_w_gate) F(exp_w_up) F(exp_w_down) F(final_g)
__device__ __forceinline__ In load_in(KP kp) { In I;
#define F(n) I.n = kp->I.n;
    IN_FIELDS(F)
#undef F
    return I; }

__global__ void __launch_bounds__(MK_THREADS, 2) k_mega(Params p_unused) {
#ifdef HOST_EMU2
    unsigned char* lds_raw = emu::block_lds();
#else
    extern __shared__ __attribute__((aligned(16))) unsigned char lds_raw[];
#endif
    LAS unsigned char* lds = (LAS unsigned char*)lds_raw;
    const int tid0 = threadIdx.x;
    if (tid0 < 16) ((LAS unsigned*)(lds + MK_LDS_MISC))[tid0] = 0u;
    __syncthreads();
    XcdBarrier bar;
    { KP kp = KPARAMS(); bar = xcd_barrier_post((unsigned*)(kp->ws + OFF_BAR), (volatile LAS unsigned*)(lds + MK_LDS_MISC)); }
    const int bid = blockIdx.x, nblk = gridDim.x, gstride = nblk * MK_THREADS, wave0 = __builtin_amdgcn_readfirstlane(tid0 >> 6);
    const int ngw = nblk * 8;
#define BAR() do { XcdBarrier b_ = bar; asm volatile("" : "+s"(b_.x)); xcd_barrier(b_); } while (0)
#ifdef HOST_EMU2
#define LANE_ID(v) int v = threadIdx.x & 63
#else
#define LANE_ID(v) int v; asm volatile("v_mbcnt_lo_u32_b32 %0, -1, 0\n\tv_mbcnt_hi_u32_b32 %0, -1, %0" : "=v"(v))
#endif
#define PH_BEGIN { KP kp = KPARAMS(); unsigned char* ws = kp->ws; const In I = load_in(kp); (void)I; (void)ws; LANE_ID(lane); \
        const int wave = wave0, tid = wave0 * 64 + lane, gtid = bid * MK_THREADS + tid, gw = bid * 8 + wave; (void)tid; (void)gtid; (void)lane; (void)wave; (void)gw;
#define PH_END }
#define WSF(off) ((float*)(ws + (off)))
#define WSB(off) ((bf16_t*)(ws + (off)))
#define WSI(off) ((int*)(ws + (off)))
#define LTAB ((LAS int*)(lds + MK_LDS_TAB))
#define LPST ((LAS int*)(lds + MK_LDS_PST))
    PH_BEGIN { LAS float* scond = (LAS float*)lds;
        for (int i = tid; i < NCOND * DM; i += MK_THREADS) { const int j = i / DM, k = i % DM; scond[i] = silu_f(j < NB ? I.c[j * DM + k] : I.c_ctx[k]); }
        __syncthreads();
        ph_adaln_part(I, WSF(OFF_PART), scond, gw, ngw, lane);
        __syncthreads(); } PH_END
    PH_BEGIN if (wave < 6) { LAS float* scr = (LAS float*)(lds + wave * 16384); for (int it_ = bid * 6 + wave; it_ < NITEMS_L * PR_WCVT; it_ += nblk * 6) wcvt_item_l0(I, ws, scr, it_ % NITEMS_L, lane); }
      else { const int g2 = bid * 128 + (wave - 6) * 64 + lane, s2 = nblk * 128; ph_prep(I, WSF(OFF_RWT), g2, s2); ph_rope_table(WSF(OFF_ROPE), g2, s2); ph_s5_prep1(I, WSF(OFF_LAMP), WSF(OFF_BBC), g2, s2); } PH_END
    BAR();
    PH_BEGIN ph_adaln_reduce(I, WSF(OFF_PART), WSF(OFF_MOD), gtid, gstride); PH_END
    PH_BEGIN ph_s5_prep2a(I, WSF(OFF_LAMP), WSF(OFF_BBC), WSF(OFF_KTAU), gtid, gstride); PH_END
    BAR();
    for (int l = 0; l < NL; ++l) {
        const int row_lo = (l == NL - 1) ? NCTX : 0;
        if (l > 0) BAR();
        for (int q_ = 0; q_ < PR_BAR; ++q_) BAR();
        if (l > 0) { PH_BEGIN d_wcvt(I, l, ws, lds, gw, ngw, wave, lane); PH_END }
        if (l == 0) { PH_BEGIN ph_norm1<0>(I, l, WSF(OFF_MOD), WSF(OFF_X), WSB(OFF_YB), WSI(OFF_TS), WSF(OFF_TG), WSB(OFF_HB), nullptr, gw, ngw, lane); PH_END }
        else        { PH_BEGIN ph_norm1<1>(I, l, WSF(OFF_MOD), WSF(OFF_X), WSB(OFF_YB), WSI(OFF_TS), WSF(OFF_TG), WSB(OFF_HB), nullptr, gw, ngw, lane); PH_END }
        BAR();
        PH_BEGIN pg8::Gemm g{WSB(OFF_HB), WSB(OFF_WIN), NTOK, INW, DM}; pg8::StaticOrder S; S.init(NTOK, INW, nblk, bid); EpiQKV E{WSB(OFF_QKVB), WSF(OFF_ROPE)};
          pg8::gemm_phase<EpiQKV, pg8::StaticOrder, true, true>(lds, g, S, E, tid); PH_END
        BAR();
        PH_BEGIN ph_ret_kv(I, l, WSB(OFF_QKVB), WSB(OFF_KVT), lds, bid, nblk, tid, lane, wave); PH_END
        if (l == 0) { PH_BEGIN const int nu = NB * NH * NCH, f = nu % nblk == 0 ? 0 : nu % nblk;
            if (bid >= f) { ph_s5_prep2b(I, WSF(OFF_LAMP), WSF(OFF_BBC), WSB(OFF_MINT), WSB(OFF_MOUT), (bid - f) * MK_THREADS + tid, (nblk - f) * MK_THREADS);
                ph_s5_prep3(I, WSF(OFF_KTAU), WSB(OFF_KTOT), (bid - f) * MK_THREADS + tid, (nblk - f) * MK_THREADS); } PH_END }
        BAR();
        PH_BEGIN ph_ret_scan(I, l, WSB(OFF_KVT), WSB(OFF_STT), gtid, gstride); PH_END
        PH_BEGIN ph_s5(l, WSB(OFF_QKVB), WSF(OFF_LAMP), WSB(OFF_MINT), WSB(OFF_MOUT), WSB(OFF_KTOT), WSB(OFF_ZB), lds, (l == NL - 1) ? CTL : 0, bid, nblk, tid, lane, wave); PH_END
        BAR();
        PH_BEGIN ph_ret_out(I, l, WSB(OFF_QKVB), WSB(OFF_STT), WSB(OFF_MIXB), lds, (l == NL - 1) ? CC : 0, bid, nblk, tid, lane, wave); PH_END
        PH_BEGIN const int nru = NB * NH * (NCH - ((l == NL - 1) ? CC : 0)), shift = nru % nblk;
          pg8::Gemm g{WSB(OFF_ZB), WSB(OFF_WGLU), NTOK, SW, SW}; pg8::StaticOrder S; S.init(NTOK, SW, nblk, (bid - shift + nblk) % nblk);
          EpiGlu E{WSB(OFF_MIXB), DM, RW, WSB(OFF_ZB), SW, I.s5_glu_b + (size_t)l * SW};
          pg8::gemm_phase<EpiGlu, pg8::StaticOrder, true, true>(lds, g, S, E, tid); PH_END
        BAR();
        PH_BEGIN const int rbase = (l == NL - 1) ? NCTX : 0;
          pg8::Gemm g{WSB(OFF_MIXB) + (size_t)rbase * DM, WSB(OFF_WOUT), NTOK - rbase, DM, DM}; pg8::StaticOrder S; S.init(NTOK - rbase, DM, nblk, bid); if (l > 0) S.rep = 1;
          EpiResid E{WSF(OFF_X), l == 0 ? I.ctx : WSF(OFF_X), l == 0 ? I.x : WSF(OFF_X) + (size_t)NCTX * DM, WSF(OFF_MOD), l, rbase};
          pg8::gemm_phase<EpiResid, pg8::StaticOrder, true, true>(lds, g, S, E, tid); PH_END
        BAR();
        PH_BEGIN ph_route(I, l, WSF(OFF_MOD), WSF(OFF_X), WSF(OFF_RWT), WSI(OFF_TE), WSF(OFF_TG), WSF(OFF_RSTD), WSI(OFF_TP), WSI(OFF_HIST), lds, row_lo, bid, nblk, tid, lane, wave); PH_END
        BAR();
        PH_BEGIN ph_gather(I, l, WSF(OFF_MOD), WSF(OFF_X), WSF(OFF_RSTD), WSI(OFF_TE), WSI(OFF_TP), WSI(OFF_HIST), WSI(OFF_TS), WSB(OFF_XG), lds, LTAB, LPST, row_lo, bid, nblk, tid, lane, wave); PH_END
        BAR();
        PH_BEGIN pg8::Gemm g{WSB(OFF_XG), WSB(OFF_WGU), 0, 0, DM}; MoeOrder S; S.init(LTAB, (2 * EFF) / 256, nblk, bid); EpiAct E{WSB(OFF_ACTB), EFF, (2 * EFF) / 256};
          pg8::gemm_phase<EpiAct, MoeOrder, true, true>(lds, g, S, E, tid); PH_END
        BAR();
        PH_BEGIN pg8::Gemm g{WSB(OFF_ACTB), WSB(OFF_WD), 0, 0, EFF}; MoeOrder S; S.init(LTAB, DM / 256, nblk, bid); EpiBf16N E{WSB(OFF_YB), DM, DM / 256};
          pg8::gemm_phase<EpiBf16N, MoeOrder, true, true>(lds, g, S, E, tid); PH_END
    }
    BAR();
    PH_BEGIN ph_norm1<2>(I, NL, WSF(OFF_MOD), WSF(OFF_X), WSB(OFF_YB), WSI(OFF_TS), WSF(OFF_TG), nullptr, kp->out, gw, ngw, lane); PH_END
#undef BAR
}
}
#endif

static nv::Params make_params(void* const* d_in, void* d_out, void* d_ws) {
    nv::Params p{};
    const float** f = (const float**)&p.I;
    for (int i = 0; i < 29; ++i) f[i] = (const float*)d_in[i];
    p.out = (float*)d_out; p.ws = (unsigned char*)d_ws;
    return p;
}

extern "C" void kernel_launch(void* const* d_in, const int* in_sizes, int n_in, void* d_out, int out_size, void* d_ws, size_t ws_size, hipStream_t stream) {
    using namespace nv;
    (void)in_sizes; (void)out_size;
    Params p = make_params(d_in, d_out, d_ws);
#if defined(HOST_EMU2)
    (void)n_in; (void)ws_size; (void)stream;
    memset((char*)d_ws + OFF_CTL, 0, SZ_CTL + SZ_BAR);
    static Params pk; pk = p; emu_kernarg = &pk;
    emu::run_grid([]() { k_mega(pk); }, EMU_GRID, MK_THREADS, MK_LDS_BYTES);
#elif !defined(HOST_EMU)
    static int grid = 0;
    if (grid == 0) {
        if (n_in != 29 || ws_size < WS_NEED) { fprintf(stderr, "kernel_launch: n_in %d ws %zu need %zu\n", n_in, ws_size, (size_t)WS_NEED); grid = -1; return; }
        int dev = 0, cus = 0, per_cu = 0;
        if (hipGetDevice(&dev) != hipSuccess || hipDeviceGetAttribute(&cus, hipDeviceAttributeMultiprocessorCount, dev) != hipSuccess) { grid = -1; return; }
        if (hipFuncSetAttribute((const void*)k_mega, hipFuncAttributeMaxDynamicSharedMemorySize, MK_LDS_BYTES) != hipSuccess) { fprintf(stderr, "kernel_launch: hipFuncSetAttribute failed\n"); grid = -1; return; }
        if (hipOccupancyMaxActiveBlocksPerMultiprocessor(&per_cu, (const void*)k_mega, MK_THREADS, MK_LDS_BYTES) != hipSuccess || per_cu < 1) { fprintf(stderr, "kernel_launch: occupancy query says %d\n", per_cu); grid = -1; (void)hipGetLastError(); return; }
        (void)hipGetLastError();
        grid = cus;
    }
    if (grid < 0) return;
    (void)hipMemsetAsync((char*)d_ws + OFF_CTL, 0, SZ_CTL + SZ_BAR, stream);
    hipLaunchKernelGGL(k_mega, dim3(grid), dim3(MK_THREADS), MK_LDS_BYTES, stream, p);
#endif
}
```

```cpp
#ifdef HOST_EMU
#include <cstdio>
#include <cstdlib>
#include <cstring>
#include <cmath>
#include <vector>
#include <cstdint>
#define __global__
#define __device__
#define __host__
#define __forceinline__ inline
#define __launch_bounds__(...)
struct emu_dim3 { unsigned x, y, z; };
static emu_dim3 threadIdx = {0, 0, 0}, blockIdx = {0, 0, 0}, blockDim = {1, 1, 1}, gridDim = {1, 1, 1};
static inline int atomicAdd(int* p, int v) { int o = *p; *p += v; return o; }
typedef void* hipStream_t;
static inline void __syncthreads() {}
#else
#include <hip/hip_runtime.h>
#include <cstdio>
#include <cstdint>
#endif

#ifndef D_MODEL
#define D_MODEL 2048
#define BATCH 4
#define SEQ 2048
#define DEPTH 2
#define GRID_W 64
#define CTX_LEN 256
#define RET_HEADS 8
#define RET_CHUNK 128
#define S5_GROUP 16
#define S5_STATE 64
#define N_EXPERT_GROUPS 4
#define EXPERTS_PER_GROUP 8
#define EXPERT_FF 512
#endif

namespace nv {
constexpr int DM = D_MODEL, NB = BATCH, SQ = SEQ, CTXL = CTX_LEN, NL = DEPTH, GW = GRID_W;
constexpr int RW = DM / 2, SW = DM - RW, NH = RET_HEADS, HD = RW / NH, RC = RET_CHUNK;
constexpr int SG = S5_GROUP, NG = SW / SG, SP = S5_STATE;
constexpr int INW = 4 * RW + SW;
constexpr int NEG = N_EXPERT_GROUPS, EPG = EXPERTS_PER_GROUP, NE = NEG * EPG, EFF = EXPERT_FF;
constexpr int NMOD = 6;
constexpr int NCTX = NB * CTXL, NLAT = NB * SQ, NTOK = NCTX + NLAT;
constexpr int CC = CTXL / RC, LC = SQ / RC, NCH = CC + LC;
constexpr int NCOND = NB + 1;
constexpr float NORM_EPS = 1e-6f, GN_EPS = 1e-5f;
constexpr int MOE_TILE = 128;
constexpr int MOE_CAP = ((2 * NTOK + NE * (MOE_TILE - 1)) / MOE_TILE) * MOE_TILE + MOE_TILE;

struct In {
    const float *x, *c, *ctx, *c_ctx, *ada_w, *ada_b, *norm1_g, *w_in, *ret_decay, *s5_a_re, *s5_a_im, *s5_log_step, *s5_b_re, *s5_b_im,
        *s5_c_re, *s5_c_im, *s5_d, *s5_glu_w, *s5_glu_b, *w_out, *norm2_g, *router_grp_w, *router_grp_b, *router_exp_w, *router_exp_b,
        *exp_w_gate, *exp_w_up, *exp_w_down, *final_g;
};

typedef unsigned short bf16_t;
__device__ __forceinline__ bf16_t f2bf(float f) { unsigned u; __builtin_memcpy(&u, &f, 4); u = (u + 0x7fffu + ((u >> 16) & 1u)) >> 16; return (bf16_t)u; }
__device__ __forceinline__ float nbf2f(bf16_t b) { unsigned u = ((unsigned)b) << 16; float f; __builtin_memcpy(&f, &u, 4); return f; }
__device__ __forceinline__ float silu_f(float v) { return v / (1.0f + expf(-v)); }
__device__ __forceinline__ float sigmoid_f(float v) { return 1.0f / (1.0f + expf(-v)); }
__device__ __forceinline__ float gelu_tanh_f(float v) { return 0.5f * v * (1.0f + tanhf(0.7978845608028654f * (v + 0.044715f * v * v * v))); }
__device__ __forceinline__ int cond_of_row(int r) { return r < NCTX ? NB : (r - NCTX) / SQ; }
__device__ __forceinline__ int row_of(int b, int n, int p) { return n < CC ? b * CTXL + n * RC + p : NCTX + b * SQ + (n - CC) * RC + p; }
__device__ __forceinline__ void bnp_of_row(int r, int& b, int& n, int& p) {
    if (r < NCTX) { b = r / CTXL; const int t = r % CTXL; n = t / RC; p = t % RC; }
    else { const int q = r - NCTX; b = q / SQ; const int t = q % SQ; n = CC + t / RC; p = t % RC; }
}
#define MODV(MOD, l, j, m) ((MOD) + ((size_t)((l) * NCOND + (j)) * NMOD + (m)) * DM)

__device__ __forceinline__ void d_adaln(const In& I, float* MOD, long gtid, long gstride) {
    for (long idx = gtid; idx < (long)NL * NMOD * DM; idx += gstride) {
        const int l = (int)(idx / (NMOD * DM)), n = (int)(idx % (NMOD * DM));
        float acc[NCOND];
#pragma unroll
        for (int j = 0; j < NCOND; ++j) acc[j] = 0.f;
        const float* w = I.ada_w + (size_t)l * DM * NMOD * DM + n;
        for (int k = 0; k < DM; ++k) {
            const float wv = w[(size_t)k * NMOD * DM];
#pragma unroll
            for (int j = 0; j < NB; ++j) acc[j] += silu_f(I.c[j * DM + k]) * wv;
            acc[NB] += silu_f(I.c_ctx[k]) * wv;
        }
        const float bv = I.ada_b[(size_t)l * NMOD * DM + n];
#pragma unroll
        for (int j = 0; j < NCOND; ++j) MOD[(size_t)(l * NCOND + j) * NMOD * DM + n] = acc[j] + bv;
    }
}
__device__ __forceinline__ void d_copy_x(const In& I, float* X, long gtid, long gstride) {
    for (long idx = gtid; idx < (long)NTOK * DM; idx += gstride) {
        const int r = (int)(idx / DM), j = (int)(idx % DM);
        X[idx] = r < NCTX ? I.ctx[(size_t)r * DM + j] : I.x[(size_t)(r - NCTX) * DM + j];
    }
}
__device__ __forceinline__ void d_norm_mod(const float* X, const float* g, const float* MOD, int l, int mshift, int mscale, float* H, bf16_t* Hb, long gtid, long gstride) {
    for (long r = gtid; r < NTOK; r += gstride) {
        const float* xr = X + (size_t)r * DM; float ss = 0.f;
        for (int j = 0; j < DM; ++j) ss += xr[j] * xr[j];
        const float rs = 1.0f / sqrtf(ss / DM + NORM_EPS);
        const int cj = cond_of_row((int)r);
        const float* sh = MODV(MOD, l, cj, mshift); const float* sc = MODV(MOD, l, cj, mscale);
        for (int j = 0; j < DM; ++j) { const float v = xr[j] * rs * g[j] * (1.0f + sc[j]) + sh[j]; H[(size_t)r * DM + j] = v; if (Hb) Hb[(size_t)r * DM + j] = f2bf(v); }
    }
}
__device__ __forceinline__ void d_rope(float* QKV, long gtid, long gstride) {
    const float kscale = 1.0f / sqrtf((float)HD);
    constexpr int NF = HD / 4;
    for (long idx = gtid; idx < (long)NTOK * 2 * NH * (HD / 2); idx += gstride) {
        const int i = (int)(idx % (HD / 2)); long t = idx / (HD / 2);
        const int h = (int)(t % NH); t /= NH; const int which = (int)(t % 2); const int r = (int)(t / 2);
        float* p = QKV + (size_t)r * INW + which * RW + h * HD + 2 * i;
        float t0 = p[0], t1 = p[1];
        if (r >= NCTX) {
            const int pos = (r - NCTX) % SQ, rowp = pos / GW, colp = pos % GW;
            const int f = i < NF ? i : i - NF;
            const float inv = powf(10000.0f, -(float)f / (float)NF);
            const float ang = (i < NF ? (float)rowp : (float)colp) * inv;
            const float cs = cosf(ang), sn = sinf(ang);
            const float a = t0 * cs - t1 * sn, b = t0 * sn + t1 * cs; t0 = a; t1 = b;
        }
        if (which == 1) { t0 *= kscale; t1 *= kscale; }
        p[0] = t0; p[1] = t1;
    }
}
__device__ __forceinline__ float logg(const In& I, int l, int dir, int h) { return -expf(I.ret_decay[(l * 2 + dir) * NH + h]); }
__device__ __forceinline__ void d_ret_kv(const In& I, int l, const float* QKV, float* KV, long gtid, long gstride) {
    for (long idx = gtid; idx < (long)2 * NB * NH * NCH * HD * HD; idx += gstride) {
        const int e = (int)(idx % HD); long t = idx / HD; const int d = (int)(t % HD); t /= HD; const int n = (int)(t % NCH); t /= NCH;
        const int h = (int)(t % NH); t /= NH; const int b = (int)(t % NB); const int dir = (int)(t / NB);
        const float lg = logg(I, l, dir, h); float acc = 0.f;
        for (int p = 0; p < RC; ++p) {
            const int row = row_of(b, n, p);
            const float w = expf(lg * (float)(dir == 0 ? RC - 1 - p : p));
            acc += w * QKV[(size_t)row * INW + RW + h * HD + d] * QKV[(size_t)row * INW + 2 * RW + h * HD + e];
        }
        KV[idx] = acc;
    }
}
__device__ __forceinline__ int chain_chunk(int dir, int step) { return dir == 0 ? step : (step < CC ? CC - 1 - step : NCH - 1 - (step - CC)); }
__device__ __forceinline__ void d_ret_scan(const In& I, int l, const float* KV, float* ST, long gtid, long gstride) {
    for (long idx = gtid; idx < (long)2 * NB * NH * HD * HD; idx += gstride) {
        const int de = (int)(idx % (HD * HD)); long t = idx / (HD * HD); const int h = (int)(t % NH); t /= NH; const int b = (int)(t % NB); const int dir = (int)(t / NB);
        const float dec = expf(logg(I, l, dir, h) * (float)RC); float s = 0.f;
        for (int step = 0; step < NCH; ++step) {
            const int n = chain_chunk(dir, step);
            const size_t o = ((((size_t)dir * NB + b) * NH + h) * NCH + n) * HD * HD + de;
            ST[o] = s; s = dec * s + KV[o];
        }
    }
}
__device__ __forceinline__ void d_ret_scores(const In& I, int l, const float* QKV, float* SC, long gtid, long gstride) {
    for (long idx = gtid; idx < (long)NTOK * NH * RC; idx += gstride) {
        const int j = (int)(idx % RC); long t = idx / RC; const int h = (int)(t % NH); const int r = (int)(t / NH);
        int b, n, p; bnp_of_row(r, b, n, p);
        const int rj = row_of(b, n, j);
        const float* q = QKV + (size_t)r * INW + h * HD; const float* k = QKV + (size_t)rj * INW + RW + h * HD;
        float dot = 0.f;
        for (int d = 0; d < HD; ++d) dot += q[d] * k[d];
        const float D = j <= p ? expf(logg(I, l, 0, h) * (float)(p - j)) : expf(logg(I, l, 1, h) * (float)(j - p));
        SC[idx] = dot * D;
    }
}
__device__ __forceinline__ void d_ret_out(const In& I, int l, const float* QKV, const float* SC, const float* ST, float* RO, long gtid, long gstride) {
    for (long idx = gtid; idx < (long)NTOK * NH * HD; idx += gstride) {
        const int e = (int)(idx % HD); long t = idx / HD; const int h = (int)(t % NH); const int r = (int)(t / NH);
        int b, n, p; bnp_of_row(r, b, n, p);
        float acc = 0.f;
        const float* sc = SC + ((size_t)r * NH + h) * RC;
        for (int j = 0; j < RC; ++j) acc += sc[j] * QKV[(size_t)row_of(b, n, j) * INW + 2 * RW + h * HD + e];
        const float qwf = expf(logg(I, l, 0, h) * (float)(p + 1)), qwb = expf(logg(I, l, 1, h) * (float)(RC - p));
        const float* sf = ST + ((((size_t)0 * NB + b) * NH + h) * NCH + n) * HD * HD + e;
        const float* sb = ST + ((((size_t)1 * NB + b) * NH + h) * NCH + n) * HD * HD + e;
        const float* q = QKV + (size_t)r * INW + h * HD;
        for (int d = 0; d < HD; ++d) acc += q[d] * (qwf * sf[(size_t)d * HD] + qwb * sb[(size_t)d * HD]);
        RO[(size_t)r * RW + h * HD + e] = acc;
    }
}
__device__ __forceinline__ void d_ret_norm(const float* RO, const float* QKV, float* MIX, bf16_t* MIXb, long gtid, long gstride) {
    for (long idx = gtid; idx < (long)NTOK * NH; idx += gstride) {
        const int h = (int)(idx % NH), r = (int)(idx / NH);
        const float* o = RO + (size_t)r * RW + h * HD; float mu = 0.f;
        for (int e = 0; e < HD; ++e) mu += o[e];
        mu /= HD; float var = 0.f;
        for (int e = 0; e < HD; ++e) var += (o[e] - mu) * (o[e] - mu);
        var /= HD; const float rs = 1.0f / sqrtf(var + GN_EPS);
        for (int e = 0; e < HD; ++e) { const float v = (o[e] - mu) * rs * silu_f(QKV[(size_t)r * INW + 3 * RW + h * HD + e]); MIX[(size_t)r * DM + h * HD + e] = v; if (MIXb) MIXb[(size_t)r * DM + h * HD + e] = f2bf(v); }
    }
}
__device__ __forceinline__ void d_s5_disc(const In& I, int l, float* ABAR, float* BBAR, long gtid, long gstride) {
    for (long idx = gtid; idx < (long)2 * NG * SP; idx += gstride) {
        const int p = (int)(idx % SP); long t = idx / SP; const int g = (int)(t % NG); const int dir = (int)(t / NG);
        const size_t ia = (((size_t)l * 2 + dir) * NG + g) * SP + p;
        const float are = I.s5_a_re[ia], aim = I.s5_a_im[ia], dt = expf(I.s5_log_step[((size_t)l * 2 + dir) * NG + g]);
        const float mag = expf(are * dt), ang = aim * dt;
        const float abr = mag * cosf(ang), abi = mag * sinf(ang);
        const float den = are * are + aim * aim, nr = abr - 1.0f;
        const float fr = (nr * are + abi * aim) / den, fi = (abi * are - nr * aim) / den;
        ABAR[idx * 2] = abr; ABAR[idx * 2 + 1] = abi;
#pragma unroll
        for (int c = 0; c < SG; ++c) {
            const float br = I.s5_b_re[ia * SG + c], bi = I.s5_b_im[ia * SG + c];
            BBAR[(idx * SG + c) * 2] = fr * br - fi * bi; BBAR[(idx * SG + c) * 2 + 1] = fr * bi + fi * br;
        }
    }
}
__device__ __forceinline__ int chain_row(int dir, int b, int step) {
    if (dir == 0) return step < CTXL ? b * CTXL + step : NCTX + b * SQ + (step - CTXL);
    return step < CTXL ? b * CTXL + (CTXL - 1 - step) : NCTX + b * SQ + (SQ - 1 - (step - CTXL));
}
__device__ __forceinline__ void d_s5_scan(int dir, const bf16_t* QKV, const float* ABAR, const float* BBAR, float* HS, long gtid, long gstride) {
    for (long idx = gtid; idx < (long)NB * NG * SP; idx += gstride) {
        const int p = (int)(idx % SP); long t = idx / SP; const int g = (int)(t % NG); const int b = (int)(t / NG);
        const size_t ip = ((size_t)dir * NG + g) * SP + p;
        const float ar = ABAR[ip * 2], ai = ABAR[ip * 2 + 1];
        float br[SG], bi[SG];
#pragma unroll
        for (int c = 0; c < SG; ++c) { br[c] = BBAR[(ip * SG + c) * 2]; bi[c] = BBAR[(ip * SG + c) * 2 + 1]; }
        float hr = 0.f, hi = 0.f;
        for (int step = 0; step < CTXL + SQ; ++step) {
            const int row = chain_row(dir, b, step);
            const bf16_t* u = QKV + (size_t)row * INW + 4 * RW + g * SG;
            float ur = 0.f, ui = 0.f;
#pragma unroll
            for (int c = 0; c < SG; ++c) { const float uv = nbf2f(u[c]); ur += br[c] * uv; ui += bi[c] * uv; }
            const float nr = ar * hr - ai * hi + ur, ni = ar * hi + ai * hr + ui; hr = nr; hi = ni;
            float* o = HS + (((size_t)row * NG + g) * SP + p) * 2; o[0] = hr; o[1] = hi;
        }
    }
}
__device__ __forceinline__ void d_s5_y(const In& I, int l, int dir, const bf16_t* QKV, const float* HS, float* Z, bf16_t* Zb, long gtid, long gstride) {
    for (long idx = gtid; idx < (long)NTOK * SW; idx += gstride) {
        const int ch = (int)(idx % SW), row = (int)(idx / SW), g = ch / SG, c = ch % SG;
        float y = dir == 0 ? I.s5_d[((size_t)l * NG + g) * SG + c] * nbf2f(QKV[(size_t)row * INW + 4 * RW + ch]) : Z[idx];
        const float* cr = I.s5_c_re + ((((size_t)l * 2 + dir) * NG + g) * SG + c) * SP;
        const float* ci = I.s5_c_im + ((((size_t)l * 2 + dir) * NG + g) * SG + c) * SP;
        const float* h = HS + ((size_t)row * NG + g) * SP * 2;
        for (int p = 0; p < SP; ++p) y += cr[p] * h[2 * p] - ci[p] * h[2 * p + 1];
        if (dir == 1) { y = gelu_tanh_f(y); if (Zb) Zb[idx] = f2bf(y); }
        Z[idx] = y;
    }
}
__device__ __forceinline__ void d_glu_ep(const In& I, int l, const float* Z, const float* T, float* MIX, bf16_t* MIXb, long gtid, long gstride) {
    for (long idx = gtid; idx < (long)NTOK * SW; idx += gstride) {
        const int j = (int)(idx % SW), r = (int)(idx / SW);
        const float v = Z[idx] * sigmoid_f(T[idx] + I.s5_glu_b[(size_t)l * SW + j]); MIX[(size_t)r * DM + RW + j] = v; if (MIXb) MIXb[(size_t)r * DM + RW + j] = f2bf(v);
    }
}
__device__ __forceinline__ void d_resid(float* X, const float* T2, const float* MOD, int l, int m, long gtid, long gstride) {
    for (long idx = gtid; idx < (long)NTOK * DM; idx += gstride) {
        const int j = (int)(idx % DM), r = (int)(idx / DM);
        X[idx] += MODV(MOD, l, cond_of_row(r), m)[j] * T2[idx];
    }
}
__device__ __forceinline__ void d_route(const In& I, int l, const float* H2, int* TE, int* TP, float* TG, int* CNT, int row_lo, long gtid, long gstride) {
    for (long r = row_lo + gtid; r < NTOK; r += gstride) {
        float gl[NEG], el[NE];
#pragma unroll
        for (int j = 0; j < NEG; ++j) gl[j] = 0.f;
#pragma unroll
        for (int j = 0; j < NE; ++j) el[j] = 0.f;
        const float* h = H2 + (size_t)r * DM;
        const float* gw = I.router_grp_w + (size_t)l * DM * NEG; const float* ew = I.router_exp_w + (size_t)l * DM * NE;
        for (int k = 0; k < DM; ++k) {
            const float hv = h[k];
#pragma unroll
            for (int j = 0; j < NEG; ++j) gl[j] += hv * gw[(size_t)k * NEG + j];
#pragma unroll
            for (int j = 0; j < NE; ++j) el[j] += hv * ew[(size_t)k * NE + j];
        }
#pragma unroll
        for (int j = 0; j < NEG; ++j) gl[j] += I.router_grp_b[l * NEG + j];
#pragma unroll
        for (int j = 0; j < NE; ++j) el[j] += I.router_exp_b[l * NE + j];
        int grp = 0; float gmax = gl[0];
#pragma unroll
        for (int j = 1; j < NEG; ++j) if (gl[j] > gmax) { gmax = gl[j]; grp = j; }
        float den = 0.f;
#pragma unroll
        for (int j = 0; j < NEG; ++j) den += expf(gl[j] - gmax);
        const float gprob = 1.0f / den;
        float sel[EPG];
#pragma unroll
        for (int j = 0; j < EPG; ++j) { float v = el[j];
#pragma unroll
            for (int g2 = 1; g2 < NEG; ++g2) v = (grp == g2) ? el[g2 * EPG + j] : v;
            sel[j] = v; }
        int i0 = 0; float l0 = sel[0];
#pragma unroll
        for (int j = 1; j < EPG; ++j) if (sel[j] > l0) { l0 = sel[j]; i0 = j; }
        int i1 = -1; float l1 = -3.0e38f;
#pragma unroll
        for (int j = 0; j < EPG; ++j) if (j != i0 && sel[j] > l1) { l1 = sel[j]; i1 = j; }
        const float e1 = expf(l1 - l0), g0 = gprob / (1.0f + e1), g1 = gprob * e1 / (1.0f + e1);
        const int ex0 = grp * EPG + i0, ex1 = grp * EPG + i1;
        TE[r * 2] = ex0; TE[r * 2 + 1] = ex1; TG[r * 2] = g0; TG[r * 2 + 1] = g1;
        TP[r * 2] = atomicAdd(&CNT[ex0], 1); TP[r * 2 + 1] = atomicAdd(&CNT[ex1], 1);
    }
}
__device__ __forceinline__ void d_moe_offsets(const int* CNT, int* META, int tile, long gtid) {
    if (gtid == 0) {
        int off = 0, nt = 0;
        for (int e = 0; e < NE; ++e) {
            META[1 + e] = off; const int t = (CNT[e] + tile - 1) / tile;
            for (int k = 0; k < t; ++k) META[64 + nt + k] = e;
            nt += t; off += t * tile;
        }
        META[0] = nt;
    }
}
__device__ __forceinline__ void d_moe_scatter(const int* TE, const int* TP, const int* META, int* SLOT_TOK, int* TS, int row_lo, long gtid, long gstride) {
    for (long idx = (long)row_lo * 2 + gtid; idx < (long)NTOK * 2; idx += gstride) {
        const int slot = META[1 + TE[idx]] + TP[idx];
        SLOT_TOK[slot] = (int)(idx / 2); TS[idx] = slot;
    }
}
__device__ __forceinline__ void d_moe_gather(const float* H2, const int* SLOT_TOK, bf16_t* Xg, const int* META, int tile, long gtid, long gstride) {
    const long nrows = (long)META[0] * tile;
    for (long idx = gtid; idx < nrows * (DM / 4); idx += gstride) {
        const int j = (int)(idx % (DM / 4)) * 4; const long s = idx / (DM / 4); const int tok = SLOT_TOK[s];
        for (int q = 0; q < 4; ++q) Xg[s * DM + j + q] = tok >= 0 ? f2bf(H2[(size_t)tok * DM + j + q]) : (bf16_t)0;
    }
}
__device__ __forceinline__ void d_moe_act(const float* GU, float* ACT, bf16_t* ACTb, const int* META, int tile, long gtid, long gstride) {
    const long nrows = (long)META[0] * tile;
    for (long idx = gtid; idx < nrows * EFF; idx += gstride) {
        const int j = (int)(idx % EFF); const long s = idx / EFF;
        const float v = silu_f(GU[s * 2 * EFF + j]) * GU[s * 2 * EFF + EFF + j]; if (ACT) ACT[idx] = v; if (ACTb) ACTb[idx] = f2bf(v);
    }
}
__device__ __forceinline__ void d_moe_combine(float* X, const float* Y, const int* TS, const float* TG, const float* MOD, int l, int row_lo, long gtid, long gstride) {
    for (long idx = (long)row_lo * DM + gtid; idx < (long)NTOK * DM; idx += gstride) {
        const int j = (int)(idx % DM), r = (int)(idx / DM);
        const float v = TG[r * 2] * Y[(size_t)TS[r * 2] * DM + j] + TG[r * 2 + 1] * Y[(size_t)TS[r * 2 + 1] * DM + j];
        X[idx] += MODV(MOD, l, cond_of_row(r), 5)[j] * v;
    }
}
__device__ __forceinline__ void d_final(const In& I, const float* X, float* out, long gtid, long gstride) {
    for (long r = NCTX + gtid; r < NTOK; r += gstride) {
        const float* xr = X + (size_t)r * DM; float ss = 0.f;
        for (int j = 0; j < DM; ++j) ss += xr[j] * xr[j];
        const float rs = 1.0f / sqrtf(ss / DM + NORM_EPS);
        for (int j = 0; j < DM; ++j) out[(size_t)(r - NCTX) * DM + j] = xr[j] * rs * I.final_g[j];
    }
}

struct GemmArgs { const float* A; int lda; const int* gather; const float* B; int ldb; size_t strideB; float* C; int ldc; int M, N, K; const int* META; };
#ifdef HOST_EMU
__device__ __forceinline__ void d_gemm(const GemmArgs& g, void* smem, int bid, int nblk) {
    (void)smem; (void)bid; (void)nblk;
    const int M = g.META ? g.META[0] * MOE_TILE : g.M;
    for (int m = 0; m < M; ++m) {
        const float* B = g.B + (g.META ? (size_t)g.META[64 + m / MOE_TILE] * g.strideB : 0);
        const int src = g.gather ? g.gather[m] : m;
        for (int n = 0; n < g.N; ++n) { double acc = 0;
            if (src >= 0) for (int k = 0; k < g.K; ++k) acc += (double)g.A[(size_t)src * g.lda + k] * B[(size_t)k * g.ldb + n];
            g.C[(size_t)m * g.ldc + n] = (float)acc; }
    }
}
#else
__device__ __forceinline__ void d_gemm(const GemmArgs& g, void* smem, int bid, int nblk) {
    float* As = (float*)smem;
    float* Bs = As + 16 * 132;
    const int tid = threadIdx.x, tx = tid % 16, ty = tid / 16;
    const int M = g.META ? g.META[0] * MOE_TILE : g.M;
    const int ntm = (M + 127) / 128, ntn = (g.N + 63) / 64;
    for (int tile = bid; tile < ntm * ntn; tile += nblk) {
        const int tm = tile / ntn, tn = tile % ntn, m0 = tm * 128, n0 = tn * 64;
        const float* B = g.B + (g.META ? (size_t)g.META[64 + tm] * g.strideB : 0);
        float acc[4][4];
        for (int i = 0; i < 4; ++i) for (int j = 0; j < 4; ++j) acc[i][j] = 0.f;
        for (int k0 = 0; k0 < g.K; k0 += 16) {
            for (int q = tid; q < 128 * 16; q += 512) { const int mm = q / 16, kk = q % 16; const int m = m0 + mm; float v = 0.f;
                if (m < M && k0 + kk < g.K) { const int src = g.gather ? g.gather[m] : m; if (src >= 0) v = g.A[(size_t)src * g.lda + k0 + kk]; }
                As[kk * 132 + mm] = v; }
            for (int q = tid; q < 16 * 64; q += 512) { const int kk = q / 64, nn = q % 64; float v = 0.f;
                if (k0 + kk < g.K && n0 + nn < g.N) v = B[(size_t)(k0 + kk) * g.ldb + n0 + nn];
                Bs[kk * 64 + nn] = v; }
            __syncthreads();
#pragma unroll
            for (int kk = 0; kk < 16; ++kk) { float a[4], b[4];
#pragma unroll
                for (int i = 0; i < 4; ++i) a[i] = As[kk * 132 + ty * 4 + i];
#pragma unroll
                for (int j = 0; j < 4; ++j) b[j] = Bs[kk * 64 + tx * 4 + j];
#pragma unroll
                for (int i = 0; i < 4; ++i)
#pragma unroll
                    for (int j = 0; j < 4; ++j) acc[i][j] += a[i] * b[j]; }
            __syncthreads();
        }
        for (int i = 0; i < 4; ++i) { const int m = m0 + ty * 4 + i; if (m >= M) continue;
            for (int j = 0; j < 4; ++j) { const int n = n0 + tx * 4 + j; if (n < g.N) g.C[(size_t)m * g.ldc + n] = acc[i][j]; } }
    }
}
#endif
}

#ifndef PR_GEMM
#define PR_GEMM 1
#endif
#ifndef PR_WCVT
#define PR_WCVT 1
#endif
#ifndef PR_RET
#define PR_RET 1
#endif
#ifndef PR_S5
#define PR_S5 1
#endif
#ifndef PR_ROUTE
#define PR_ROUTE 1
#endif
#ifndef PR_NORM
#define PR_NORM 1
#endif
#ifndef PR_BAR
#define PR_BAR 0
#endif
#ifndef PR_PREP
#define PR_PREP 1
#endif
#ifndef PR_FIN
#define PR_FIN 1
#endif
namespace nv {
constexpr size_t al256(size_t x) { return (x + 255) & ~(size_t)255; }
constexpr size_t cmax(size_t a, size_t b) { return a > b ? a : b; }
constexpr int NRLc = NEG + NE;
constexpr size_t OFF_CTL = 0, SZ_CTL = 4096;
constexpr size_t OFF_BAR = OFF_CTL + SZ_CTL, SZ_BAR = 16384;
constexpr size_t OFF_MOD = OFF_BAR + SZ_BAR, SZ_MOD = al256((size_t)NL * NCOND * NMOD * DM * 4);
constexpr size_t OFF_PART = OFF_MOD + SZ_MOD, SZ_PART = al256((size_t)(DM / 128) * NL * NCOND * NMOD * DM * 4);
constexpr size_t OFF_RWT = OFF_PART + SZ_PART, SZ_RWT = al256((size_t)NL * NRLc * DM * 4);
constexpr size_t OFF_LAMP = OFF_RWT + SZ_RWT, SZ_LAMP = al256((size_t)NL * 2 * NG * 17 * SP * 2 * 4);
constexpr size_t OFF_BBC = OFF_LAMP + SZ_LAMP, SZ_BBC = al256((size_t)NL * 2 * NG * SP * SG * 2 * 4);
constexpr size_t OFF_KTAU = OFF_BBC + SZ_BBC, SZ_KTAU = al256((size_t)NL * 2 * NG * 16 * SG * SG * 4);
constexpr size_t OFF_MINT = OFF_KTAU + SZ_KTAU, SZ_MINT = al256((size_t)NL * 2 * NG * 128 * 256 * 2);
constexpr size_t OFF_MOUT = OFF_MINT + SZ_MINT, SZ_MOUT = SZ_MINT;
constexpr size_t OFF_KTOT = OFF_MOUT + SZ_MOUT, SZ_KTOT = al256((size_t)NL * NG * 256 * 256 * 2);
constexpr size_t OFF_TE = OFF_KTOT + SZ_KTOT, SZ_T2I = al256((size_t)NTOK * 2 * 4);
constexpr size_t OFF_TP = OFF_TE + SZ_T2I, OFF_TG = OFF_TP + SZ_T2I, OFF_TS = OFF_TG + SZ_T2I, OFF_RSTD = OFF_TS + SZ_T2I;
constexpr size_t OFF_HIST = OFF_RSTD + SZ_T2I, SZ_HIST = al256((size_t)1024 * NE * 4);
constexpr size_t OFF_WP = OFF_HIST + SZ_HIST, SZ_WP = al256((size_t)NL * NCOND * ((NEG + NE + 15) / 16) * 16 * DM * 4);
constexpr size_t OFF_CB = OFF_WP + SZ_WP, SZ_CB = al256((size_t)NL * NCOND * ((NEG + NE + 15) / 16) * 16 * 4);
constexpr size_t OFF_X = OFF_CB + SZ_CB, SZ_X = al256((size_t)NTOK * DM * 4);
constexpr size_t OFF_QKVB = OFF_X + SZ_X, SZ_QKVB = al256((size_t)NTOK * INW * 2);
constexpr size_t OFF_ROPE = OFF_QKVB + SZ_QKVB, SZ_ROPE = al256((size_t)SQ * (HD / 2) * 2 * 4);
constexpr size_t OFF_MIXB = OFF_ROPE + SZ_ROPE, SZ_MIXB = al256((size_t)NTOK * DM * 2);
constexpr size_t OFF_ZB = OFF_MIXB + SZ_MIXB, SZ_ZB = al256((size_t)NTOK * SW * 2);
constexpr size_t OFF_HB = OFF_ZB + SZ_ZB, SZ_HB = SZ_MIXB;
constexpr size_t OFF_WIN = OFF_HB + SZ_HB, SZ_WIN = al256((size_t)INW * DM * 2);
constexpr size_t OFF_WGLU = OFF_WIN + SZ_WIN, SZ_WGLU = al256((size_t)SW * SW * 2);
constexpr size_t OFF_WOUT = OFF_WGLU + SZ_WGLU, SZ_WOUT = al256((size_t)DM * DM * 2);
constexpr size_t OFF_WGU = OFF_WOUT + SZ_WOUT, SZ_WGU = al256((size_t)NE * 2 * EFF * DM * 2);
constexpr size_t OFF_WD = OFF_WGU + SZ_WGU, SZ_WD = al256((size_t)NE * DM * EFF * 2);
constexpr size_t OFF_BIG = OFF_WD + SZ_WD;
constexpr size_t SZ_KV = al256((size_t)2 * NB * NH * NCH * HD * HD * 4);
constexpr size_t OFF_KVT = OFF_BIG, OFF_STT = OFF_KVT + SZ_KV, SZ_STT = al256((size_t)2 * NB * NH * NCH * HD * HD * 2);
constexpr size_t OFF_XG = OFF_BIG, SZ_XG = al256((size_t)MOE_CAP * DM * 2);
constexpr size_t OFF_ACTB = OFF_XG + SZ_XG, SZ_ACTB = al256((size_t)MOE_CAP * EFF * 2);
constexpr size_t OFF_YB = OFF_ACTB + SZ_ACTB, SZ_YB = al256((size_t)MOE_CAP * DM * 2);
constexpr size_t WS_NEED = cmax(OFF_STT + SZ_STT, OFF_YB + SZ_YB);

struct Params { In I; float* out; unsigned char* ws; };
}

#ifndef HOST_EMU
#ifdef HOST_EMU2
#define LAS
#endif
#define XB_TMO      128
#define XB_XCNT(j)  (256  + 64 * (j))
#define XB_XSUB(j)  (1280 + 64 * (j))
#define XB_XGEN(j)  (2304 + 64 * (j))
#define XB_TOP      3328
#define XB_TOPGEN   3392
#define XCD_BAR_WORDS 3456
#define XB_SPIN_CAP (1u << 18)
#ifndef LAS
#define LAS __attribute__((address_space(3)))
#endif

__device__ __forceinline__ unsigned xb_ld(unsigned* p)              { return __hip_atomic_load(p, __ATOMIC_RELAXED, __HIP_MEMORY_SCOPE_AGENT); }
__device__ __forceinline__ unsigned xb_add(unsigned* p, unsigned v) { return __hip_atomic_fetch_add(p, v, __ATOMIC_RELAXED, __HIP_MEMORY_SCOPE_AGENT); }
__device__ __forceinline__ unsigned xb_xcc_id() { return (unsigned)__builtin_amdgcn_s_getreg((3 << 11) | 20) & 0xFu; }
#define XB_SPIN(cond, bar) do { unsigned _sp = 0; while (cond) { __builtin_amdgcn_s_sleep(1); \
    if ((++_sp & 255u) == 0u) { if (xb_ld(&(bar)[XB_TMO])) break; if (_sp > XB_SPIN_CAP) { atomicAdd(&(bar)[XB_TMO], 1u); break; } } } } while (0)

struct XcdBarrier {
    unsigned* bar; unsigned x;
    volatile LAS unsigned* st;
};

__device__ __forceinline__ XcdBarrier xcd_barrier_post(unsigned* bar, volatile LAS unsigned* st) {
    XcdBarrier b; b.bar = bar; b.x = xb_xcc_id(); b.st = st;
    if (threadIdx.x == 0) (void)xb_add(&bar[XB_XCNT(b.x)], 1u);
    return b;
}
__device__ __forceinline__ void xcd_barrier_complete(unsigned* bar, unsigned x, unsigned& nloc, unsigned& nx) {
    const unsigned G = gridDim.x * gridDim.y * gridDim.z;
    unsigned sum, cnt, mine, sp = 0u;
    for (;;) {
        sum = 0u; cnt = 0u; mine = 0u;
#pragma unroll
        for (unsigned j = 0; j < 16; ++j) { const unsigned c = xb_ld(&bar[XB_XCNT(j)]); sum += c; cnt += (c > 0u) ? 1u : 0u; mine = (j == x) ? c : mine; }
        if (sum == G) break;
        __builtin_amdgcn_s_sleep(1);
        if ((++sp & 255u) == 0u) { if (xb_ld(&bar[XB_TMO])) break; if (sp > XB_SPIN_CAP) { atomicAdd(&bar[XB_TMO], 1u); break; } }
    }
    nloc = mine > 0u ? mine : 1u; nx = cnt > 0u ? cnt : 1u;
}

__device__ __forceinline__ void xcd_barrier(const XcdBarrier& b) {
    asm volatile("s_waitcnt vmcnt(0)" ::: "memory");
    __syncthreads();
    if (threadIdx.x == 0) {
        unsigned* bar = b.bar;
        __builtin_amdgcn_s_waitcnt(0);
        unsigned nloc = b.st[0], nx = b.st[1];
        if (nloc == 0u) { xcd_barrier_complete(bar, b.x, nloc, nx); b.st[0] = nloc; b.st[1] = nx; }
        const unsigned old = xb_add(&bar[XB_XSUB(b.x)], 1u);
        const unsigned gen = old / nloc;
        if (old + 1u == (gen + 1u) * nloc) {
            __builtin_amdgcn_fence(__ATOMIC_RELEASE, "agent");
            asm volatile("s_waitcnt vmcnt(0)" ::: "memory");
            const unsigned og = xb_add(&bar[XB_TOP], 1u);
            const unsigned tg = og / nx;
            if (og + 1u == (tg + 1u) * nx) xb_add(&bar[XB_TOPGEN], 1u);
            else XB_SPIN(xb_ld(&bar[XB_TOPGEN]) == tg, bar);
            __builtin_amdgcn_fence(__ATOMIC_ACQUIRE, "agent");
            xb_add(&bar[XB_XGEN(b.x)], 1u);
            asm volatile("s_waitcnt vmcnt(0)" ::: "memory");
        } else {
            XB_SPIN(xb_ld(&bar[XB_XGEN(b.x)]) == gen, bar);
            __builtin_amdgcn_fence(__ATOMIC_ACQUIRE, "agent");
            asm volatile("s_waitcnt vmcnt(0)" ::: "memory");
        }
    }
    __syncthreads();
}


#ifndef HOST_EMU2
#define GAS __attribute__((address_space(1)))
#else
#define GAS
#endif
typedef unsigned short bf16;
typedef unsigned v4u __attribute__((ext_vector_type(4)));
#ifdef HOST_EMU2
#define LDS_WAIT() do { emu::wave_sync(); emu::set_ids(); } while (0)
#else
#define LDS_WAIT() asm volatile("s_waitcnt lgkmcnt(0)" ::: "memory")
#endif
__device__ __forceinline__ unsigned f2bf_u(float f) { unsigned u = __builtin_bit_cast(unsigned, f); return (u + 0x7fffu + ((u >> 16) & 1u)) >> 16; }
__device__ __forceinline__ unsigned pk2(float lo, float hi) { return f2bf_u(lo) | (f2bf_u(hi) << 16); }
namespace pg8 {
#define PG8_LAS __attribute__((address_space(3)))
typedef unsigned short bf16_t;
typedef short bf16x8 __attribute__((ext_vector_type(8)));
typedef float f32x4 __attribute__((ext_vector_type(4)));
typedef unsigned u32x4 __attribute__((ext_vector_type(4)));
constexpr int BM = 256, BK = 64, HALF = 128, HTB = HALF * BK * 2  , STAGE_BYTES = 8 * HTB, NXCD = 8, WGM = 8;

__host__ __device__ __forceinline__ int lds_byte(int r, int c) { const int st = (r >> 4) * 2 + (c >> 5), rr = r & 15, cc = c & 31, ob = rr * 64 + cc * 2; return st * 1024 + (ob ^ (((ob >> 9) & 1) << 5)); }
__host__ __device__ __forceinline__ void stage_rc(int b, int& R, int& C) { const int st = b / 1024, sb = b % 1024, swz = sb ^ (((sb >> 9) & 1) << 5); R = (st >> 1) * 16 + swz / 64; C = (st & 1) * 32 + (swz % 64) / 2; }
__host__ __device__ __forceinline__ int perm32(int rho) { const int n = rho >> 4, i = rho & 15; return 8 * (i >> 2) + 4 * n + (i & 3); }

struct Unit { int pm, pn, half; };
struct Gemm { const bf16_t* A; const bf16_t* Bt; int M, N, K; };

struct StaticOrder {
    int nM, nN, nwg, G, c, rep;
    __host__ __device__ void init(int M, int N, int G_, int c_) { nM = M / BM; nN = N / BM; nwg = nM * nN; G = G_; c = c_; rep = PR_GEMM; }
    __host__ __device__ bool next(int i, Unit& u) const {
        long L = (long)i * G + c; int part = -1;
        if (rep == 1) { const int nfull = (nwg / G) * G, r = nwg - nfull;
            if (r > 0 && 2 * r <= G && L >= nfull) { if (L >= nfull + 2 * r) return false; part = (int)((L - nfull) & 1); L = nfull + (L - nfull) / 2; } }
        if (L >= (long)nwg * rep) return false;
        int wgid = (int)(L % nwg); { const int q = nwg / NXCD, r = nwg % NXCD, xcd = wgid % NXCD, off = wgid / NXCD; wgid = (xcd < r ? xcd * (q + 1) : r * (q + 1) + (xcd - r) * q) + off; }
        const int nig = WGM * nN, gid = wgid / nig, fm = gid * WGM, gsz = (nM - fm) < WGM ? (nM - fm) : WGM;
        u.pm = 2 * (fm + ((wgid % nig) % gsz)) + (part > 0 ? 1 : 0); u.pn = (wgid % nig) / gsz; u.half = part >= 0 ? 1 : 0; return true;
    }
    __device__ __forceinline__ void a_ready(const Unit&) const {}
    __device__ __forceinline__ void done(const Unit&) const {}
};

#ifdef HOST_EMU2
__device__ __forceinline__ unsigned cvt_pk_bf16(float lo, float hi) { return pk2(lo, hi); }
#else
__device__ __forceinline__ unsigned cvt_pk_bf16(float lo, float hi) { unsigned r; asm volatile("v_cvt_pk_bf16_f32 %0, %1, %2" : "=v"(r) : "v"(lo), "v"(hi)); return r; }
#endif
template <class Epi, class Sched, bool ALIGN_EPI = false, bool SP2 = false>
__device__ __forceinline__ void gemm_phase(PG8_LAS unsigned char* lds, const Gemm g, const Sched& S, const Epi& E, const int tid) {
    const int wid = __builtin_amdgcn_readfirstlane(tid >> 6), lane = tid & 63, wr = wid >> 2, wc = wid & 3, fr = lane & 15, fq = lane >> 4;
    const int K = g.K, nt = K / BK;
    unsigned voffA[2], voffB[2];
#pragma unroll
    for (int i = 0; i < 2; ++i) { int R, C; stage_rc(tid * 16 + i * 8192, R, C); const int Rb = Epi::PERM ? ((R & ~31) + perm32(R & 31)) : R;
        voffA[i] = (unsigned)(R * K + C) * 2u; voffB[i] = (unsigned)(Rb * K + C) * 2u; }
    const size_t kstep = (size_t)(BK * 2);
    const size_t hstep = (size_t)HALF * K * 2;
    const size_t tstep = 2 * hstep;
    const unsigned ldsw = (unsigned)wid * 1024u;
    const int aoff = lds_byte(wr * 64 + fr, fq * 8), boff = lds_byte(wc * 32 + fr, fq * 8);
#define PG8_SA(b, h) (((b) * 2 + (h)) * HTB)
#define PG8_SB(b, h) ((4 + (b) * 2 + (h)) * HTB)
#define PG8_STAGE(bufoff, gbase, voff) do { _Pragma("unroll") for (int _i = 0; _i < 2; ++_i) \
        __builtin_amdgcn_global_load_lds((const unsigned*)((const char*)(gbase) + (voff)[_i]), (PG8_LAS unsigned*)(lds + (bufoff) + ldsw + _i * 8192), 16, 0, 0); } while (0)
#define PG8_LDA(dst, b, h) do { _Pragma("unroll") for (int m = 0; m < 4; ++m) _Pragma("unroll") for (int k = 0; k < 2; ++k) dst[m][k] = *(const PG8_LAS bf16x8*)(lds + PG8_SA(b, h) + aoff + m * 2048 + k * 1024); } while (0)
#define PG8_LDB(dst, b, h) do { _Pragma("unroll") for (int n = 0; n < 2; ++n) _Pragma("unroll") for (int k = 0; k < 2; ++k) dst[n][k] = *(const PG8_LAS bf16x8*)(lds + PG8_SB(b, h) + boff + n * 2048 + k * 1024); } while (0)
#define PG8_MMA(ai, bj, At, Bt) do { __builtin_amdgcn_s_setprio(1); _Pragma("unroll") for (int m = 0; m < 4; ++m) _Pragma("unroll") for (int n = 0; n < 2; ++n) _Pragma("unroll") for (int k = 0; k < 2; ++k) \
        acc[ai][bj][m][n] = __builtin_amdgcn_mfma_f32_16x16x32_bf16(Bt[n][k], At[m][k], acc[ai][bj][m][n], 0, 0, 0); __builtin_amdgcn_s_setprio(0); } while (0)
#define PG8_WAIT_V(n) asm volatile("s_waitcnt vmcnt(" #n ")" ::: "memory")
#define PG8_WAIT_L(n) asm volatile("s_waitcnt lgkmcnt(" #n ")" ::: "memory")
#define PG8_BAR __builtin_amdgcn_s_barrier()
#define PG8_SCHED __builtin_amdgcn_sched_barrier(0)
    Unit cur, nxt; int ui = 0;
    if (!S.next(0, cur)) return;
    f32x4 acc[2][2][4][2];
#pragma unroll
    for (int a = 0; a < 2; ++a)
#pragma unroll
        for (int b = 0; b < 2; ++b)
#pragma unroll
            for (int m = 0; m < 4; ++m)
#pragma unroll
                for (int n = 0; n < 2; ++n) acc[a][b][m][n] = (f32x4){0.f, 0.f, 0.f, 0.f};
    bf16x8 At[4][2], B0[2][2], B1[2][2];
    const char* cA = (const char*)g.A + (size_t)cur.pm * hstep; const char* cB = (const char*)g.Bt + (size_t)cur.pn * tstep;
    S.a_ready(cur);
    if constexpr (SP2) {
        PG8_STAGE(PG8_SB(0, 0), cB, voffB); PG8_STAGE(PG8_SB(0, 1), cB + hstep, voffB); PG8_STAGE(PG8_SA(0, 0), cA, voffA); PG8_STAGE(PG8_SA(0, 1), cA + hstep, voffA);
        if (wr == 1) PG8_BAR;
        PG8_WAIT_V(2); PG8_BAR;
        PG8_STAGE(PG8_SB(1, 0), cB + kstep, voffB); PG8_STAGE(PG8_SA(1, 0), cA + kstep, voffA); PG8_STAGE(PG8_SB(1, 1), cB + hstep + kstep, voffB);
        PG8_WAIT_V(6); PG8_BAR;
    } else {
        PG8_STAGE(PG8_SB(0, 0), cB, voffB); PG8_STAGE(PG8_SA(0, 0), cA, voffA); PG8_STAGE(PG8_SB(0, 1), cB + hstep, voffB); PG8_STAGE(PG8_SA(0, 1), cA + hstep, voffA);
        if (wr == 1) PG8_BAR;
        PG8_WAIT_V(4); PG8_BAR;
        PG8_STAGE(PG8_SB(1, 0), cB + kstep, voffB); PG8_STAGE(PG8_SA(1, 0), cA + kstep, voffA); PG8_STAGE(PG8_SB(1, 1), cB + hstep + kstep, voffB);
        PG8_WAIT_V(6); PG8_BAR;
    }
    for (;;) {
        const bool has_next = S.next(ui + 1, nxt);
        const char* nA = has_next ? (const char*)g.A + (size_t)nxt.pm * hstep : cA; const char* nB = has_next ? (const char*)g.Bt + (size_t)nxt.pn * tstep : cB;
        for (int t = 0; t < nt; t += 2) {
            const bool last = (t == nt - 2);
            const char* a1 = cA + (size_t)(t + 1) * kstep;
            const char* a2 = last ? nA : cA + (size_t)(t + 2) * kstep; const char* b2 = last ? nB : cB + (size_t)(t + 2) * kstep;
            const char* a3 = a2 + kstep; const char* b3 = b2 + kstep;
            if (last && has_next) S.a_ready(nxt);
            if constexpr (SP2) {
            PG8_LDB(B0, 0, 0); PG8_LDB(B1, 0, 1); PG8_SCHED; PG8_LDA(At, 0, 0); PG8_STAGE(PG8_SA(1, 1), a1 + hstep, voffA);
            PG8_WAIT_V(8); PG8_WAIT_L(0); PG8_BAR; PG8_MMA(0, 0, At, B0); PG8_MMA(0, 1, At, B1); PG8_BAR; PG8_SCHED;
            PG8_LDA(At, 0, 1); PG8_STAGE(PG8_SB(0, 0), b2, voffB); PG8_STAGE(PG8_SB(0, 1), b2 + hstep, voffB); PG8_STAGE(PG8_SA(0, 0), a2, voffA);
            PG8_WAIT_V(8); PG8_WAIT_L(0); PG8_BAR; if (!cur.half) { PG8_MMA(1, 0, At, B0); PG8_MMA(1, 1, At, B1); } PG8_BAR; PG8_SCHED;
            PG8_LDB(B0, 1, 0); PG8_LDB(B1, 1, 1); PG8_SCHED; PG8_LDA(At, 1, 0); PG8_STAGE(PG8_SA(0, 1), a2 + hstep, voffA);
            PG8_WAIT_V(8); PG8_WAIT_L(0); PG8_BAR; PG8_MMA(0, 0, At, B0); PG8_MMA(0, 1, At, B1); PG8_BAR; PG8_SCHED;
            PG8_LDA(At, 1, 1); PG8_STAGE(PG8_SB(1, 0), b3, voffB); PG8_STAGE(PG8_SB(1, 1), b3 + hstep, voffB); PG8_STAGE(PG8_SA(1, 0), a3, voffA);
            PG8_WAIT_V(8); PG8_WAIT_L(0); PG8_BAR; if (!cur.half) { PG8_MMA(1, 0, At, B0); PG8_MMA(1, 1, At, B1); } PG8_BAR; PG8_SCHED;
            } else {
            PG8_LDB(B0, 0, 0); PG8_SCHED; PG8_LDA(At, 0, 0); PG8_STAGE(PG8_SA(1, 1), a1 + hstep, voffA);
            PG8_WAIT_L(8); PG8_BAR; PG8_WAIT_L(0); PG8_MMA(0, 0, At, B0); PG8_BAR; PG8_SCHED;
            PG8_LDB(B1, 0, 1); PG8_STAGE(PG8_SB(0, 0), b2, voffB);
            PG8_BAR; PG8_WAIT_L(0); PG8_MMA(0, 1, At, B1); PG8_BAR;
            PG8_LDA(At, 0, 1); PG8_STAGE(PG8_SA(0, 0), a2, voffA);
            PG8_BAR; PG8_WAIT_L(0); PG8_MMA(1, 0, At, B0); PG8_BAR; PG8_SCHED;
            PG8_STAGE(PG8_SB(0, 1), b2 + hstep, voffB);
            PG8_WAIT_V(6); PG8_BAR; PG8_MMA(1, 1, At, B1); PG8_BAR;
            PG8_LDB(B0, 1, 0); PG8_SCHED; PG8_LDA(At, 1, 0); PG8_STAGE(PG8_SA(0, 1), a2 + hstep, voffA);
            PG8_WAIT_L(8); PG8_BAR; PG8_WAIT_L(0); PG8_MMA(0, 0, At, B0); PG8_BAR; PG8_SCHED;
            PG8_LDB(B1, 1, 1); PG8_STAGE(PG8_SB(1, 0), b3, voffB);
            PG8_BAR; PG8_WAIT_L(0); PG8_MMA(0, 1, At, B1); PG8_BAR;
            PG8_LDA(At, 1, 1); PG8_STAGE(PG8_SA(1, 0), a3, voffA);
            PG8_BAR; PG8_WAIT_L(0); PG8_MMA(1, 0, At, B0); PG8_BAR; PG8_SCHED;
            PG8_STAGE(PG8_SB(1, 1), b3 + hstep, voffB);
            PG8_WAIT_V(6); PG8_BAR; PG8_MMA(1, 1, At, B1); PG8_BAR;
            }
        }
        if constexpr (ALIGN_EPI) { if (wr == 0) PG8_BAR; }
        if constexpr (!Epi::AFTER_DRAIN) { E(acc, cur, wr, wc, fr, fq); S.done(cur); }
        if (!has_next) break;
#pragma unroll
        for (int a = 0; a < 2; ++a)
#pragma unroll
            for (int b = 0; b < 2; ++b)
#pragma unroll
                for (int m = 0; m < 4; ++m)
#pragma unroll
                    for (int n = 0; n < 2; ++n) acc[a][b][m][n] = (f32x4){0.f, 0.f, 0.f, 0.f};
        cur = nxt; cA = nA; cB = nB; ++ui;
        if constexpr (ALIGN_EPI) { if (wr == 1) PG8_BAR; }
    }
    PG8_WAIT_V(0);
    if constexpr (!ALIGN_EPI) { if (wr == 0) PG8_BAR; }
    PG8_BAR;
    if constexpr (Epi::AFTER_DRAIN) { E.fused(acc, cur, wr, wc, fr, fq, lds, wid, lane); S.done(cur); }
#undef PG8_SA
#undef PG8_SB
#undef PG8_STAGE
#undef PG8_LDA
#undef PG8_LDB
#undef PG8_MMA
#undef PG8_WAIT_V
#undef PG8_WAIT_L
#undef PG8_BAR
#undef PG8_SCHED
}
}
__device__ __forceinline__ void p0_transpose_item(const float* W, int K, int N, bf16* WT, int row_off, LAS float* scr, int item, int lane) {
    const int nblk = N / 32, kb = item / nblk, nb = item % nblk, k0 = 64 * kb, n0 = 32 * nb;
#pragma unroll 8
    for (int i = 0; i < 32; ++i) { const int kk = 2 * i + (lane >> 5); scr[kk * 33 + (lane & 31)] = W[(size_t)(k0 + kk) * N + n0 + (lane & 31)]; }
    LDS_WAIT(); asm volatile("" ::: "memory");
    const int c = lane & 7;
#pragma unroll
    for (int j = 0; j < 4; ++j) { const int n = (lane >> 3) + 8 * j; const LAS float* s = scr + (8 * c) * 33 + n;
        v4u o; o.x = pk2(s[0 * 33], s[1 * 33]); o.y = pk2(s[2 * 33], s[3 * 33]); o.z = pk2(s[4 * 33], s[5 * 33]); o.w = pk2(s[6 * 33], s[7 * 33]);
        *(GAS v4u*)(WT + (size_t)(row_off + n0 + n) * K + k0 + 8 * c) = o; }
    LDS_WAIT(); asm volatile("" ::: "memory");
}
namespace nv {
typedef float f4 __attribute__((ext_vector_type(4)));
typedef unsigned u2v __attribute__((ext_vector_type(2)));
typedef unsigned u4v __attribute__((ext_vector_type(4)));
constexpr int ROWV = DM / 256;
constexpr int NRL = NEG + NE;
constexpr int AD_KS = 128;
constexpr int AD_NKS = DM / AD_KS;
#ifdef HOST_EMU2
#define WAVE_SYNC() do { emu::wave_sync(); emu::set_ids(); } while (0)
#else
#define WAVE_SYNC() __builtin_amdgcn_wave_barrier()
#endif
template <int CTRL> __device__ __forceinline__ float dpp_f(float v) { return __builtin_bit_cast(float, __builtin_amdgcn_update_dpp(0, __builtin_bit_cast(int, v), CTRL, 0xf, 0xf, true)); }
__device__ __forceinline__ float wave_sum(float v) {
    v += dpp_f<0xB1>(v); v += dpp_f<0x4E>(v); v += dpp_f<0x141>(v); v += dpp_f<0x140>(v);
    const int iv = __builtin_bit_cast(int, v);
    return (__builtin_bit_cast(float, __builtin_amdgcn_readlane(iv, 0)) + __builtin_bit_cast(float, __builtin_amdgcn_readlane(iv, 16))) +
           (__builtin_bit_cast(float, __builtin_amdgcn_readlane(iv, 32)) + __builtin_bit_cast(float, __builtin_amdgcn_readlane(iv, 48)));
}
__device__ __forceinline__ float bf2f(unsigned short b) { return __builtin_bit_cast(float, ((unsigned)b) << 16); }
__device__ __forceinline__ float bflo(unsigned w) { return __builtin_bit_cast(float, w << 16); }
__device__ __forceinline__ float bfhi(unsigned w) { return __builtin_bit_cast(float, w & 0xffff0000u); }
__device__ __forceinline__ void row_load(const float* p, int lane, f4 (&v)[ROWV]) {
#pragma unroll
    for (int j = 0; j < ROWV; ++j) v[j] = *(const f4*)(p + 4 * lane + 256 * j);
}
__device__ __forceinline__ float row_ss(const f4 (&v)[ROWV]) { float s = 0.f;
#pragma unroll
    for (int j = 0; j < ROWV; ++j) s += (v[j].x * v[j].x + v[j].y * v[j].y) + (v[j].z * v[j].z + v[j].w * v[j].w);
    return s; }
__device__ __forceinline__ void row_modulate(f4 (&v)[ROWV], float rstd, const float* g, const float* sc, const float* sh, int lane) {
#pragma unroll
    for (int j = 0; j < ROWV; ++j) { const int c = 4 * lane + 256 * j; const f4 gg = *(const f4*)(g + c), ss = *(const f4*)(sc + c), hh = *(const f4*)(sh + c);
        v[j] = v[j] * rstd * gg * (ss + 1.0f) + hh; }
}
__device__ __forceinline__ void row_store_bf16(bf16_t* o, const f4 (&v)[ROWV], int lane) {
#pragma unroll
    for (int j = 0; j < ROWV; ++j) { u2v w; w.x = pk2(v[j].x, v[j].y); w.y = pk2(v[j].z, v[j].w); *(u2v*)(o + 4 * lane + 256 * j) = w; }
}

__device__ __forceinline__ void ph_prep(const In& I, float* RWT, int gtid, int gstride) {
    for (int idx_ = gtid; idx_ < (NL * NRL * DM) * PR_PREP; idx_ += gstride) { const int idx = idx_ % (NL * NRL * DM);
        const int k = idx % DM, jj = (idx / DM) % NRL, l = idx / (DM * NRL);
        RWT[idx] = jj < NEG ? I.router_grp_w[((size_t)l * DM + k) * NEG + jj] : I.router_exp_w[((size_t)l * DM + k) * NE + (jj - NEG)];
    }
}
__device__ __forceinline__ void ph_adaln_part(const In& I, float* PART, const LAS float* scond, int gw, int ngw, int lane) {
    constexpr int NCH = NMOD * DM / 256;
    for (int it_ = gw; it_ < NL * NCH * AD_NKS * PR_WCVT; it_ += ngw) { const int it = it_ % (NL * NCH * AD_NKS);
        const int ks = it % AD_NKS, ch = (it / AD_NKS) % NCH, l = it / (AD_NKS * NCH);
        const float* w = I.ada_w + ((size_t)l * DM + (size_t)ks * AD_KS) * (NMOD * DM) + ch * 256 + 4 * lane;
        f4 acc[NCOND];
#pragma unroll
        for (int j = 0; j < NCOND; ++j) acc[j] = (f4){0.f, 0.f, 0.f, 0.f};
#pragma unroll 8
        for (int k = 0; k < AD_KS; ++k) { const f4 wv = *(const f4*)(w + (size_t)k * (NMOD * DM));
#pragma unroll
            for (int j = 0; j < NCOND; ++j) acc[j] += wv * scond[j * DM + ks * AD_KS + k]; }
#pragma unroll
        for (int j = 0; j < NCOND; ++j) *(f4*)(PART + (((size_t)ks * NL + l) * NCOND + j) * (NMOD * DM) + ch * 256 + 4 * lane) = acc[j];
    }
}
__device__ __forceinline__ void ph_adaln_reduce(const In& I, const float* PART, float* MOD, int gtid, int gstride) {
    for (int idx_ = gtid; idx_ < (NL * NCOND * NMOD * DM) * PR_PREP; idx_ += gstride) { const int idx = idx_ % (NL * NCOND * NMOD * DM);
        const int n = idx % (NMOD * DM), l = idx / (NCOND * NMOD * DM);
        float s = I.ada_b[(size_t)l * NMOD * DM + n];
        for (int ks = 0; ks < AD_NKS; ++ks) s += PART[(size_t)ks * NL * NCOND * NMOD * DM + idx];
        MOD[idx] = s;
    }
}

__device__ __forceinline__ void row_combine(f4 (&v)[ROWV], const bf16_t* Yb, const int* TS, const float* TG, const float* mod5, int r, int lane) {
    const int s0 = TS[2 * r], s1 = TS[2 * r + 1]; const float g0 = TG[2 * r], g1 = TG[2 * r + 1];
#pragma unroll
    for (int j = 0; j < ROWV; ++j) { const int c = 4 * lane + 256 * j;
        const u2v a = *(const u2v*)(Yb + (size_t)s0 * DM + c), b = *(const u2v*)(Yb + (size_t)s1 * DM + c); const f4 m = *(const f4*)(mod5 + c);
        f4 y; y.x = g0 * bflo(a.x) + g1 * bflo(b.x); y.y = g0 * bfhi(a.x) + g1 * bfhi(b.x); y.z = g0 * bflo(a.y) + g1 * bflo(b.y); y.w = g0 * bfhi(a.y) + g1 * bfhi(b.y);
        v[j] += m * y; }
}

template <int MODE>
__device__ __forceinline__ void ph_norm1(const In& I, int l, const float* MOD, float* X, const bf16_t* Yb, const int* TS, const float* TG, bf16_t* Hb, float* out, int gw, int ngw, int lane) {
    const int r0 = MODE == 2 ? NCTX : 0;
    for (int r_ = gw; r_ < (NTOK - r0) * (MODE == 0 ? PR_NORM : (MODE == 2 ? PR_FIN : 1)); r_ += ngw) { const int r = r0 + r_ % (NTOK - r0);
        f4 v[ROWV];
        const float* src = MODE == 0 ? (r < NCTX ? I.ctx + (size_t)r * DM : I.x + (size_t)(r - NCTX) * DM) : X + (size_t)r * DM;
        row_load(src, lane, v);
        const int cj = cond_of_row(r);
        if (MODE >= 1) {
            row_combine(v, Yb, TS, TG, MODV(MOD, (MODE == 1 ? l - 1 : NL - 1), cj, 5), r, lane);
            if (MODE == 1) {
#pragma unroll
                for (int j = 0; j < ROWV; ++j) *(f4*)(X + (size_t)r * DM + 4 * lane + 256 * j) = v[j]; }
        }
        const float rstd = 1.0f / sqrtf(wave_sum(row_ss(v)) * (1.0f / DM) + NORM_EPS);
        if (MODE == 2) {
#pragma unroll
            for (int j = 0; j < ROWV; ++j) { const int c = 4 * lane + 256 * j; *(f4*)(out + (size_t)(r - NCTX) * DM + c) = v[j] * rstd * *(const f4*)(I.final_g + c); }
        } else {
            row_modulate(v, rstd, I.norm1_g + (size_t)l * DM, MODV(MOD, l, cj, 1), MODV(MOD, l, cj, 0), lane);
            row_store_bf16(Hb + (size_t)r * DM, v, lane);
        }
    }
}
constexpr int NJT = (NRL + 15) / 16;
constexpr int RT_TG = 4;
constexpr int RT_LDS_PART = 0;
constexpr int RT_LDS_SSQ = RT_LDS_PART + 8 * RT_TG * 16 * NJT * 16 * 4;
constexpr int RT_LDS_TL = RT_LDS_SSQ + 8 * RT_TG * 4 * 16 * 4;
constexpr int RT_LDS_SE = RT_LDS_TL + 4 * 400;
static_assert(DM % 128 == 0 && RT_LDS_SE + 8192 <= 131072, "route LDS map");
__device__ __forceinline__ void route_rows(int nblk, int bid, int row_lo, int& rb0, int& rb1) {
    const int per = (NTOK - row_lo + nblk - 1) / nblk; rb0 = row_lo + bid * per; rb1 = rb0 + per < NTOK ? rb0 + per : NTOK; if (rb0 > NTOK) rb0 = NTOK;
}
__device__ __forceinline__ void ph_route_prep(const In& I, const float* MOD, const float* RWT, float* WP, float* CB, int gtid, int gstride, int gw, int ngw, int lane) {
    for (int idx = gtid; idx < NL * NCOND * NJT * 16 * (DM / 4); idx += gstride) {
        const int k4 = idx % (DM / 4), jj = (idx / (DM / 4)) % (NJT * 16), cj = (idx / ((DM / 4) * NJT * 16)) % NCOND, l = idx / ((DM / 4) * NJT * 16 * NCOND);
        f4 v = (f4){0.f, 0.f, 0.f, 0.f};
        if (jj < NRL) { const f4 g = *(const f4*)(I.norm2_g + (size_t)l * DM + 4 * k4), sc = *(const f4*)(MODV(MOD, l, cj, 4) + 4 * k4), w = *(const f4*)(RWT + ((size_t)l * NRL + jj) * DM + 4 * k4); v = g * (sc + 1.0f) * w; }
        *(f4*)(WP + (size_t)idx * 4) = v;
    }
    for (int it = gw; it < NL * NCOND * NJT * 16; it += ngw) { const int jj = it % (NJT * 16), cj = (it / (NJT * 16)) % NCOND, l = it / (NJT * 16 * NCOND); float s = 0.f;
        if (jj < NRL) { const float* sh = MODV(MOD, l, cj, 3) + 4 * lane; const float* w = RWT + ((size_t)l * NRL + jj) * DM + 4 * lane;
#pragma unroll
            for (int j = 0; j < ROWV; ++j) { const f4 a = *(const f4*)(sh + 256 * j), b = *(const f4*)(w + 256 * j); s += (a.x * b.x + a.y * b.y) + (a.z * b.z + a.w * b.w); }
            s = wave_sum(s) + (jj < NEG ? I.router_grp_b[l * NEG + jj] : I.router_exp_b[l * NE + (jj - NEG)]); }
        if (lane == 0) CB[it] = s; }
}
__device__ __forceinline__ void ph_route(const In& I, int l, const float* X, const float* WP, const float* CB, int* TE, float* TG, float* RSTD, int* TP, int* HIST, LAS unsigned char* lds,
                         int row_lo, int bid, int nblk, int tid, int lane, int wave) {
    LAS float* PART = (LAS float*)(lds + RT_LDS_PART); LAS float* SSQ = (LAS float*)(lds + RT_LDS_SSQ); LAS int* TL = (LAS int*)(lds + RT_LDS_TL); LAS int* sexp = (LAS int*)(lds + RT_LDS_SE);
    int rb0, rb1; route_rows(nblk, bid, row_lo, rb0, rb1);
    if (tid == 0) { int nt = 0, r = rb0;
        while (r < rb1 && nt < 128) { const int cj = cond_of_row(r); int n = 1; while (n < 16 && r + n < rb1 && cond_of_row(r + n) == cj) ++n; TL[nt] = r; TL[128 + nt] = n; TL[256 + nt] = cj; ++nt; r += n; }
        TL[384] = nt; }
    __syncthreads();
    const int ntiles = TL[384], fi = lane & 15, fq = lane >> 4;
    constexpr int KS = DM / 8;
    for (int rp_ = 0; rp_ < PR_ROUTE; ++rp_)
    for (int t0 = 0; t0 < ntiles; t0 += RT_TG) {
        const float* xr[RT_TG]; const float* wr[RT_TG];
#pragma unroll
        for (int t = 0; t < RT_TG; ++t) { const int tt = t0 + t < ntiles ? t0 + t : ntiles - 1; const int r0 = TL[tt], n = TL[128 + tt], cj = TL[256 + tt];
            xr[t] = X + (size_t)(r0 + (fi < n ? fi : n - 1)) * DM + wave * KS + 4 * fq; wr[t] = WP + (((size_t)l * NCOND + cj) * NJT * 16 + fi) * DM + wave * KS + 4 * fq; }
        pg8::f32x4 acc[RT_TG][NJT]; float ss[RT_TG];
#pragma unroll
        for (int t = 0; t < RT_TG; ++t) { ss[t] = 0.f;
#pragma unroll
            for (int jt = 0; jt < NJT; ++jt) acc[t][jt] = (pg8::f32x4){0.f, 0.f, 0.f, 0.f}; }
        bool same = true; int nv = 0;
#pragma unroll
        for (int t = 0; t < RT_TG; ++t) { if (t0 + t < ntiles) { ++nv; same = same && (TL[256 + t0 + t] == TL[256 + t0]); } }
#define RT_MMA(t, jt, a, bq) do { acc[t][jt] = __builtin_amdgcn_mfma_f32_16x16x4f32((a).x, (bq).x, acc[t][jt], 0, 0, 0); acc[t][jt] = __builtin_amdgcn_mfma_f32_16x16x4f32((a).y, (bq).y, acc[t][jt], 0, 0, 0); \
        acc[t][jt] = __builtin_amdgcn_mfma_f32_16x16x4f32((a).z, (bq).z, acc[t][jt], 0, 0, 0); acc[t][jt] = __builtin_amdgcn_mfma_f32_16x16x4f32((a).w, (bq).w, acc[t][jt], 0, 0, 0); } while (0)
        if (same) {
#pragma unroll 2
            for (int s = 0; s < KS / 16; ++s) { f4 bq[NJT];
#pragma unroll
                for (int jt = 0; jt < NJT; ++jt) bq[jt] = *(const f4*)(wr[0] + (size_t)jt * 16 * DM + 16 * s);
#pragma unroll
                for (int t = 0; t < RT_TG; ++t) { if (t < nv) { const f4 a = *(const f4*)(xr[t] + 16 * s); ss[t] += (a.x * a.x + a.y * a.y) + (a.z * a.z + a.w * a.w);
#pragma unroll
                    for (int jt = 0; jt < NJT; ++jt) RT_MMA(t, jt, a, bq[jt]); } } }
        } else {
#pragma unroll 1
            for (int s = 0; s < KS / 16; ++s) {
#pragma unroll
                for (int t = 0; t < RT_TG; ++t) { if (t < nv) { const f4 a = *(const f4*)(xr[t] + 16 * s); ss[t] += (a.x * a.x + a.y * a.y) + (a.z * a.z + a.w * a.w);
#pragma unroll
                    for (int jt = 0; jt < NJT; ++jt) { const f4 bq = *(const f4*)(wr[t] + (size_t)jt * 16 * DM + 16 * s); RT_MMA(t, jt, a, bq); } } } }
        }
#undef RT_MMA
#pragma unroll
        for (int t = 0; t < RT_TG; ++t) { SSQ[((wave * RT_TG + t) * 4 + fq) * 16 + fi] = ss[t];
#pragma unroll
            for (int jt = 0; jt < NJT; ++jt)
#pragma unroll
                for (int r = 0; r < 4; ++r) PART[((wave * RT_TG + t) * 16 + 4 * fq + r) * (NJT * 16) + 16 * jt + fi] = acc[t][jt][r]; }
        __syncthreads();
        if (tid < RT_TG * 16) { const int t = tid >> 4, i = tid & 15, tt = t0 + t;
            if (tt < ntiles && i < TL[128 + tt]) { const int r = TL[tt] + i, cj = TL[256 + tt];
                float sq = 0.f;
                for (int w = 0; w < 8; ++w) for (int q = 0; q < 4; ++q) sq += SSQ[((w * RT_TG + t) * 4 + q) * 16 + i];
                const float rstd = 1.0f / sqrtf(sq * (1.0f / DM) + NORM_EPS);
                float lg[NRL];
#pragma unroll
                for (int jj = 0; jj < NRL; ++jj) { float sacc = 0.f;
#pragma unroll
                    for (int w = 0; w < 8; ++w) sacc += PART[((w * RT_TG + t) * 16 + i) * (NJT * 16) + jj];
                    lg[jj] = rstd * sacc + CB[((size_t)l * NCOND + cj) * NJT * 16 + jj]; }
                int grp = 0; float gmax = lg[0];
#pragma unroll
                for (int j = 1; j < NEG; ++j) if (lg[j] > gmax) { gmax = lg[j]; grp = j; }
                float den = 0.f;
#pragma unroll
                for (int j = 0; j < NEG; ++j) den += expf(lg[j] - gmax);
                const float gprob = 1.0f / den;
                float sel[EPG];
#pragma unroll
                for (int j = 0; j < EPG; ++j) { float x = lg[NEG + j];
#pragma unroll
                    for (int g2 = 1; g2 < NEG; ++g2) x = (grp == g2) ? lg[NEG + g2 * EPG + j] : x;
                    sel[j] = x; }
                int i0 = 0; float l0 = sel[0];
#pragma unroll
                for (int j = 1; j < EPG; ++j) if (sel[j] > l0) { l0 = sel[j]; i0 = j; }
                int i1 = -1; float l1 = -3.0e38f;
#pragma unroll
                for (int j = 0; j < EPG; ++j) if (j != i0 && sel[j] > l1) { l1 = sel[j]; i1 = j; }
                const float e1 = expf(l1 - l0), g0v = gprob / (1.0f + e1), g1v = gprob * e1 / (1.0f + e1);
                const int ex0 = grp * EPG + i0, ex1 = grp * EPG + i1; TE[2 * r] = ex0; TE[2 * r + 1] = ex1; TG[2 * r] = g0v; TG[2 * r + 1] = g1v; RSTD[r] = rstd;
                sexp[2 * (r - rb0)] = ex0; sexp[2 * (r - rb0) + 1] = ex1; } }
        __syncthreads();
    }
    const int ns = 2 * (rb1 - rb0);
    for (int t = tid; t < ns; t += 512) { const int e = sexp[t]; int rank = 0; for (int q = 0; q < t; ++q) rank += (sexp[q] == e) ? 1 : 0; TP[2 * rb0 + t] = rank; }
    if (tid < NE) { int c = 0; for (int q = 0; q < ns; ++q) c += (sexp[q] == tid) ? 1 : 0; HIST[bid * NE + tid] = c; }
    __syncthreads();
}
constexpr int GA_LDS_PS = 0;
constexpr int GA_LDS_BASE = 2 * 512 * 4;
__device__ __forceinline__ void ph_gather(const In& I, int l, const float* MOD, const float* X, const float* RSTD, const int* TE, const int* TP, const int* HIST, int* TS, bf16_t* Xg,
                          LAS unsigned char* lds, LAS int* tab, LAS int* pst, int row_lo, int bid, int nblk, int tid, int lane, int wave) {
    LAS int* psum = (LAS int*)(lds + GA_LDS_PS); LAS int* base = (LAS int*)(lds + GA_LDS_BASE); LAS int* tot = base + NE;
    int rb0, rb1; route_rows(nblk, bid, row_lo, rb0, rb1);
    f4 v[ROWV];
    { const int r = rb0 + wave < rb1 ? rb0 + wave : (rb1 > rb0 ? rb1 - 1 : rb0); row_load(X + (size_t)(r < NTOK ? r : NTOK - 1) * DM, lane, v); }
    { constexpr int PARTS = 512 / NE; const int e = tid % NE, part = tid / NE; const int per = (nblk + PARTS - 1) / PARTS; int sb = 0, st = 0;
        for (int k = 0; k < per; k += 4) { int h[4];
#pragma unroll
            for (int q = 0; q < 4; ++q) { const int bb = part * per + k + q; h[q] = HIST[(bb < nblk ? bb : nblk - 1) * NE + e]; }
#pragma unroll
            for (int q = 0; q < 4; ++q) { const int bb = part * per + k + q; if (k + q < per && bb < nblk) { st += h[q]; if (bb < bid) sb += h[q]; } } }
        psum[tid] = sb; psum[512 + tid] = st; }
    __syncthreads();
    if (tid < NE) { int sb = 0, st = 0; for (int part = 0; part < 512 / NE; ++part) { sb += psum[part * NE + tid]; st += psum[512 + part * NE + tid]; } base[tid] = sb; tot[tid] = st; }
    __syncthreads();
    if (tid == 0) { int off = 0, nru = 0;
        for (int e = 0; e < NE; ++e) { pst[e] = off; off += ((tot[e] + MOE_TILE - 1) / MOE_TILE) * MOE_TILE; }
        int nfr = 0, nhr = 0;
        for (int e = 0; e < NE; ++e) { const int n128 = (tot[e] + MOE_TILE - 1) / MOE_TILE; for (int k = 0; k + 1 < n128; k += 2) tab[2 + nfr++] = (pst[e] / MOE_TILE + k) | (e << 16); }
        for (int e = 0; e < NE; ++e) { const int n128 = (tot[e] + MOE_TILE - 1) / MOE_TILE; if (n128 & 1) tab[2 + nfr + nhr++] = (pst[e] / MOE_TILE + n128 - 1) | (e << 16); }
        tab[0] = nfr; tab[1] = nhr; }
    __syncthreads();
    for (int r = rb0 + wave; r < rb1; r += 8) {
        f4 vn[ROWV]; const int rn = r + 8 < rb1 ? r + 8 : r; row_load(X + (size_t)rn * DM, lane, vn);
        const int cj = cond_of_row(r);
        row_modulate(v, RSTD[r], I.norm2_g + (size_t)l * DM, MODV(MOD, l, cj, 4), MODV(MOD, l, cj, 3), lane);
        const int e0 = TE[2 * r], e1 = TE[2 * r + 1]; const int s0 = pst[e0] + base[e0] + TP[2 * r], s1 = pst[e1] + base[e1] + TP[2 * r + 1];
        row_store_bf16(Xg + (size_t)s0 * DM, v, lane); row_store_bf16(Xg + (size_t)s1 * DM, v, lane);
        if (lane == 0) { TS[2 * r] = s0; TS[2 * r + 1] = s1; }
#pragma unroll
        for (int j = 0; j < ROWV; ++j) v[j] = vn[j];
    }
}
__device__ __forceinline__ float fsilu(float v) { return v / (1.0f + __expf(-v)); }
__device__ __forceinline__ float fsigm(float v) { return 1.0f / (1.0f + __expf(-v)); }
struct EpiAct {
    static constexpr bool PERM = true, AFTER_DRAIN = false;
    bf16_t* O; int ldc; int ncol;
    __device__ __forceinline__ void operator()(const pg8::f32x4 (&acc)[2][2][4][2], const pg8::Unit& u, int wr, int wc, int fr, int fq) const {
        const int row0 = u.pm * 128 + wr * 64 + fr, col0 = (u.pn % ncol) * 128 + wc * 32 + 8 * fq;
#pragma unroll
        for (int ai = 0; ai < 2; ++ai)
#pragma unroll
            for (int m = 0; m < 4; ++m) { if (ai == 1 && u.half) continue; bf16_t* rowp = O + (size_t)(row0 + ai * 128 + m * 16) * ldc + col0;
                const pg8::f32x4 g0 = acc[ai][0][m][0], g1 = acc[ai][0][m][1], u0 = acc[ai][1][m][0], u1 = acc[ai][1][m][1];
                u4v w; w.x = pk2(fsilu(g0[0]) * u0[0], fsilu(g0[1]) * u0[1]); w.y = pk2(fsilu(g0[2]) * u0[2], fsilu(g0[3]) * u0[3]);
                w.z = pk2(fsilu(g1[0]) * u1[0], fsilu(g1[1]) * u1[1]); w.w = pk2(fsilu(g1[2]) * u1[2], fsilu(g1[3]) * u1[3]);
                *(u4v*)rowp = w; }
    }
};
struct EpiBf16N {
    static constexpr bool PERM = true, AFTER_DRAIN = false;
    bf16_t* O; int ldc; int ncol;
    __device__ __forceinline__ void operator()(const pg8::f32x4 (&acc)[2][2][4][2], const pg8::Unit& u, int wr, int wc, int fr, int fq) const {
        const int row0 = u.pm * 128 + wr * 64 + fr, col0 = (u.pn % ncol) * 256 + wc * 32 + 8 * fq;
#pragma unroll
        for (int ai = 0; ai < 2; ++ai)
#pragma unroll
            for (int m = 0; m < 4; ++m) { if (ai == 1 && u.half) continue; bf16_t* rowp = O + (size_t)(row0 + ai * 128 + m * 16) * ldc + col0;
#pragma unroll
                for (int bj = 0; bj < 2; ++bj) { const pg8::f32x4 a = acc[ai][bj][m][0], b = acc[ai][bj][m][1];
                    u4v w; w.x = pk2(a[0], a[1]); w.y = pk2(a[2], a[3]); w.z = pk2(b[0], b[1]); w.w = pk2(b[2], b[3]); *(u4v*)(rowp + bj * 128) = w; } }
    }
};
struct EpiGlu {
    static constexpr bool PERM = true, AFTER_DRAIN = false;
    bf16_t* O; int ldc; int ocol; const bf16_t* Zb; int ldz; const float* bias;
    __device__ __forceinline__ void operator()(const pg8::f32x4 (&acc)[2][2][4][2], const pg8::Unit& u, int wr, int wc, int fr, int fq) const {
        const int row0 = u.pm * 128 + wr * 64 + fr, col0 = u.pn * 256 + wc * 32 + 8 * fq;
#pragma unroll
        for (int ai = 0; ai < 2; ++ai)
#pragma unroll
            for (int m = 0; m < 4; ++m) { if (ai == 1 && u.half) continue; const int row = row0 + ai * 128 + m * 16;
#pragma unroll
                for (int bj = 0; bj < 2; ++bj) { const int c = col0 + bj * 128; const u4v z = *(const u4v*)(Zb + (size_t)row * ldz + c);
                    const f4 b0 = *(const f4*)(bias + c), b1 = *(const f4*)(bias + c + 4); const pg8::f32x4 a = acc[ai][bj][m][0], b = acc[ai][bj][m][1];
                    u4v w; w.x = pk2(bflo(z.x) * fsigm(a[0] + b0.x), bfhi(z.x) * fsigm(a[1] + b0.y)); w.y = pk2(bflo(z.y) * fsigm(a[2] + b0.z), bfhi(z.y) * fsigm(a[3] + b0.w));
                    w.z = pk2(bflo(z.z) * fsigm(b[0] + b1.x), bfhi(z.z) * fsigm(b[1] + b1.y)); w.w = pk2(bflo(z.w) * fsigm(b[2] + b1.z), bfhi(z.w) * fsigm(b[3] + b1.w));
                    *(u4v*)(O + (size_t)row * ldc + ocol + c) = w; } }
    }
};
struct EpiResid {
    static constexpr bool PERM = false, AFTER_DRAIN = false;
    float* Xo; const float* res_ctx; const float* res_lat; const float* MOD; int l; int row_base;
    __device__ __forceinline__ void operator()(const pg8::f32x4 (&acc)[2][2][4][2], const pg8::Unit& u, int wr, int wc, int fr, int fq) const {
        const int row0 = row_base + u.pm * 128 + wr * 64 + fr, col0 = u.pn * 256 + wc * 32 + 4 * fq;
#pragma unroll
        for (int ai = 0; ai < 2; ++ai)
#pragma unroll
            for (int m = 0; m < 4; ++m) { if (ai == 1 && u.half) continue; const int row = row0 + ai * 128 + m * 16;
                const float* rp = (row < NCTX ? res_ctx + (size_t)row * DM : res_lat + (size_t)(row - NCTX) * DM) + col0;
                const float* mp = MODV(MOD, l, cond_of_row(row), 2) + col0; float* op = Xo + (size_t)row * DM + col0;
#pragma unroll
                for (int bj = 0; bj < 2; ++bj)
#pragma unroll
                    for (int n = 0; n < 2; ++n) { const int o = bj * 128 + n * 16; const f4 r4 = *(const f4*)(rp + o), m4 = *(const f4*)(mp + o); const pg8::f32x4 a = acc[ai][bj][m][n];
                        f4 x; x.x = r4.x + m4.x * a[0]; x.y = r4.y + m4.y * a[1]; x.z = r4.z + m4.z * a[2]; x.w = r4.w + m4.w * a[3]; *(f4*)(op + o) = x; } }
    }
};
}
namespace nv {
typedef short s8v __attribute__((ext_vector_type(8)));
constexpr int RPAD = 136;
constexpr float LOG2E = 1.4426950408889634f;
__device__ __forceinline__ float shfl_xor_f(float v, int lane, int m) { return __builtin_bit_cast(float, __builtin_amdgcn_ds_bpermute((lane ^ m) << 2, __builtin_bit_cast(int, v))); }

__device__ __forceinline__ void ph_rope_table(float* ROPE, int gtid, int gstride) {
    constexpr int NF = HD / 4;
    for (int idx_ = gtid; idx_ < (SQ * (HD / 2)) * PR_PREP; idx_ += gstride) { const int idx = idx_ % (SQ * (HD / 2));
        const int i = idx % (HD / 2), pos = idx / (HD / 2), rowp = pos / GW, colp = pos % GW, f = i < NF ? i : i - NF;
        const float inv = powf(10000.0f, -(float)f / (float)NF), ang = (i < NF ? (float)rowp : (float)colp) * inv;
        ROPE[2 * idx] = cosf(ang); ROPE[2 * idx + 1] = sinf(ang);
    }
}
struct EpiQKV {
    static constexpr bool PERM = true, AFTER_DRAIN = false;
    bf16_t* O; const float* ROPE;
    __device__ __forceinline__ void operator()(const pg8::f32x4 (&acc)[2][2][4][2], const pg8::Unit& u, int wr, int wc, int fr, int fq) const {
        const int row0 = u.pm * 128 + wr * 64 + fr, col0 = u.pn * 256 + wc * 32 + 8 * fq;
        const int region = (u.pn * 256) / RW;
        const float ksc = region == 1 ? 1.0f / sqrtf((float)HD) : 1.0f;
#pragma unroll
        for (int ai = 0; ai < 2; ++ai)
#pragma unroll
            for (int m = 0; m < 4; ++m) { if (ai == 1 && u.half) continue; const int row = row0 + ai * 128 + m * 16; bf16_t* rowp = O + (size_t)row * INW + col0;
                const bool rope = region < 2 && row >= NCTX; const int pos = rope ? (row - NCTX) % SQ : 0;
#pragma unroll
                for (int bj = 0; bj < 2; ++bj) { pg8::f32x4 a = acc[ai][bj][m][0], b = acc[ai][bj][m][1];
                    if (rope) { const int i0 = ((col0 + bj * 128) % HD) / 2; const f4* rp = (const f4*)(ROPE + ((size_t)pos * (HD / 2) + i0) * 2); const f4 c0 = rp[0], c1 = rp[1];
                        pg8::f32x4 x, y; x[0] = a[0] * c0.x - a[1] * c0.y; x[1] = a[0] * c0.y + a[1] * c0.x; x[2] = a[2] * c0.z - a[3] * c0.w; x[3] = a[2] * c0.w + a[3] * c0.z;
                        y[0] = b[0] * c1.x - b[1] * c1.y; y[1] = b[0] * c1.y + b[1] * c1.x; y[2] = b[2] * c1.z - b[3] * c1.w; y[3] = b[2] * c1.w + b[3] * c1.z; a = x; b = y; }
                    a = a * ksc; b = b * ksc;
                    u4v w; w.x = pk2(a[0], a[1]); w.y = pk2(a[2], a[3]); w.z = pk2(b[0], b[1]); w.w = pk2(b[2], b[3]); *(u4v*)(rowp + bj * 128) = w; } }
    }
};
__device__ __forceinline__ pg8::f32x4 mfma16(const s8v a, const s8v b, const pg8::f32x4 c) { return __builtin_amdgcn_mfma_f32_16x16x32_bf16(a, b, c, 0, 0, 0); }

__device__ __forceinline__ void ph_ret_kv(const In& I, int l, const bf16_t* QKVb, bf16_t* KVT, LAS unsigned char* lds, int bid, int nblk, int tid, int lane, int wave) {
    LAS bf16_t* KTf = (LAS bf16_t*)lds; LAS bf16_t* KTb = KTf + HD * RPAD; LAS bf16_t* VT = KTb + HD * RPAD;
    const int fr = lane & 15, fq = lane >> 4;
    for (int u_ = bid; u_ < NB * NH * NCH * PR_RET; u_ += nblk) { const int u = u_ % (NB * NH * NCH);
        const int n = u % NCH, h = (u / NCH) % NH, b = u / (NCH * NH);
        const float lgf = logg(I, l, 0, h), lgb = logg(I, l, 1, h);
        { const int p = tid & 127, row = row_of(b, n, p); const float wf = expf(lgf * (float)(RC - 1 - p)), wb = expf(lgb * (float)p);
            const bf16_t* kp = QKVb + (size_t)row * INW + RW + h * HD; const bf16_t* vp = QKVb + (size_t)row * INW + 2 * RW + h * HD;
#pragma unroll
            for (int i = 0; i < 4; ++i) { const int dg = (tid >> 7) + 4 * i; const u4v kk = *(const u4v*)(kp + 8 * dg), vv = *(const u4v*)(vp + 8 * dg);
#pragma unroll
                for (int j = 0; j < 8; ++j) { const unsigned kw = kk[j >> 1], vw = vv[j >> 1]; const float kf = (j & 1) ? bfhi(kw) : bflo(kw);
                    KTf[(8 * dg + j) * RPAD + p] = (bf16_t)f2bf_u(kf * wf); KTb[(8 * dg + j) * RPAD + p] = (bf16_t)f2bf_u(kf * wb);
                    VT[(8 * dg + j) * RPAD + p] = (bf16_t)((j & 1) ? (vw >> 16) : (vw & 0xffffu)); } } }
        __syncthreads();
        pg8::f32x4 acc[2][8];
#pragma unroll
        for (int d = 0; d < 2; ++d)
#pragma unroll
            for (int k = 0; k < 8; ++k) acc[d][k] = (pg8::f32x4){0.f, 0.f, 0.f, 0.f};
#pragma unroll
        for (int s = 0; s < 4; ++s) { const s8v bfrag = *(const LAS s8v*)(VT + (16 * wave + fr) * RPAD + 32 * s + 8 * fq);
#pragma unroll
            for (int db = 0; db < 8; ++db) { const s8v af = *(const LAS s8v*)(KTf + (16 * db + fr) * RPAD + 32 * s + 8 * fq), ab = *(const LAS s8v*)(KTb + (16 * db + fr) * RPAD + 32 * s + 8 * fq);
                acc[0][db] = mfma16(af, bfrag, acc[0][db]); acc[1][db] = mfma16(ab, bfrag, acc[1][db]); } }
        const int e = 16 * wave + fr;
#pragma unroll
        for (int d = 0; d < 2; ++d)
#pragma unroll
            for (int db = 0; db < 8; ++db) { u2v w; w.x = pk2(acc[d][db][0], acc[d][db][1]); w.y = pk2(acc[d][db][2], acc[d][db][3]);
                *(u2v*)(KVT + (((((size_t)d * NB + b) * NH + h) * NCH + n) * HD + e) * HD + 16 * db + 4 * fq) = w; }
        __syncthreads();
    }
}
__device__ __forceinline__ void ph_ret_scan(const In& I, int l, const bf16_t* KVT, bf16_t* STT, int gtid, int gstride) {
    for (int idx_ = gtid; idx_ < 2 * NB * NH * HD * (HD / 4) * PR_RET; idx_ += gstride) { const int idx = idx_ % (2 * NB * NH * HD * (HD / 4));
        const int ed = idx % (HD * HD / 4); int t = idx / (HD * HD / 4); const int h = t % NH; t /= NH; const int b = t % NB, dir = t / NB;
        const float dec = expf(logg(I, l, dir, h) * (float)RC); f4 s = (f4){0.f, 0.f, 0.f, 0.f};
#pragma unroll 1
        for (int step = 0; step < NCH; ++step) { const int n = chain_chunk(dir, step);
            const size_t o = ((((size_t)dir * NB + b) * NH + h) * NCH + n) * HD * HD + 4 * (size_t)ed;
            u2v w; w.x = pk2(s.x, s.y); w.y = pk2(s.z, s.w); *(u2v*)(STT + o) = w;
            const u2v kw = *(const u2v*)(KVT + o); const f4 kv = (f4){bflo(kw.x), bfhi(kw.x), bflo(kw.y), bfhi(kw.y)}; s = s * dec + kv; }
    }
}
__device__ __forceinline__ void ph_ret_out(const In& I, int l, const bf16_t* QKVb, const bf16_t* STT, bf16_t* MIXb, LAS unsigned char* lds, int n_lo, int bid, int nblk, int tid, int lane, int wave) {
    LAS bf16_t* Kt = (LAS bf16_t*)lds; LAS bf16_t* VT = Kt + RC * RPAD; LAS bf16_t* ST = VT + HD * RPAD;
    const int fr = lane & 15, fq = lane >> 4, ncn = NCH - n_lo;
    for (int u_ = bid; u_ < NB * NH * ncn * PR_RET; u_ += nblk) { const int u = u_ % (NB * NH * ncn);
        const int n = n_lo + u % ncn, h = (u / ncn) % NH, b = u / (ncn * NH);
        const float lgf = logg(I, l, 0, h), lgb = logg(I, l, 1, h);
#pragma unroll
        for (int i = 0; i < 4; ++i) { const int q = i * 512 + tid, dgq = q & 15, p = q >> 4; const int row = row_of(b, n, p);
            *(LAS u4v*)(Kt + p * RPAD + 8 * dgq) = *(const u4v*)(QKVb + (size_t)row * INW + RW + h * HD + 8 * dgq);
            *(LAS u4v*)(ST + p * RPAD + 8 * dgq) = *(const u4v*)(STT + ((((size_t)0 * NB + b) * NH + h) * NCH + n) * HD * HD + (size_t)p * HD + 8 * dgq); }
        { const int p = tid & 127, row = row_of(b, n, p); const bf16_t* vp = QKVb + (size_t)row * INW + 2 * RW + h * HD;
#pragma unroll
            for (int i = 0; i < 4; ++i) { const int dg = (tid >> 7) + 4 * i; const u4v vv = *(const u4v*)(vp + 8 * dg);
#pragma unroll
                for (int j = 0; j < 8; ++j) { const unsigned vw = vv[j >> 1]; VT[(8 * dg + j) * RPAD + p] = (bf16_t)((j & 1) ? (vw >> 16) : (vw & 0xffffu)); } } }
        __syncthreads();
        const int ipos = 16 * wave + fr, rowq = row_of(b, n, ipos);
        s8v qf[4];
#pragma unroll
        for (int s = 0; s < 4; ++s) qf[s] = *(const s8v*)(QKVb + (size_t)rowq * INW + h * HD + 32 * s + 8 * fq);
        pg8::f32x4 st[8];
#pragma unroll
        for (int jt = 0; jt < 8; ++jt) { st[jt] = (pg8::f32x4){0.f, 0.f, 0.f, 0.f};
#pragma unroll
            for (int s = 0; s < 4; ++s) st[jt] = mfma16(*(const LAS s8v*)(Kt + (16 * jt + fr) * RPAD + 32 * s + 8 * fq), qf[s], st[jt]); }
        const float lf2 = lgf * LOG2E, lb2 = lgb * LOG2E;
#pragma unroll
        for (int jt = 0; jt < 8; ++jt)
#pragma unroll
            for (int r = 0; r < 4; ++r) { const int diff = ipos - (16 * jt + 4 * fq + r); st[jt][r] *= diff >= 0 ? exp2f(lf2 * (float)diff) : exp2f(lb2 * (float)(-diff)); }
        s8v pf[4];
#pragma unroll
        for (int s = 0; s < 4; ++s) { u4v w; w.x = pk2(st[2 * s][0], st[2 * s][1]); w.y = pk2(st[2 * s][2], st[2 * s][3]); w.z = pk2(st[2 * s + 1][0], st[2 * s + 1][1]); w.w = pk2(st[2 * s + 1][2], st[2 * s + 1][3]);
            pf[s] = __builtin_bit_cast(s8v, w); }
        pg8::f32x4 o0[8], oF[8], oB[8];
#pragma unroll
        for (int eb = 0; eb < 8; ++eb) { o0[eb] = (pg8::f32x4){0.f, 0.f, 0.f, 0.f}; oF[eb] = o0[eb]; oB[eb] = o0[eb]; }
        const bf16_t* stb = STT + ((((size_t)1 * NB + b) * NH + h) * NCH + n) * HD * HD;
        u4v sb[4];
#pragma unroll
        for (int i = 0; i < 4; ++i) { const int q = i * 512 + tid, dgq = q & 15, e = q >> 4; sb[i] = *(const u4v*)(stb + (size_t)e * HD + 8 * dgq); }
#pragma unroll
        for (int eb = 0; eb < 8; ++eb)
#pragma unroll
            for (int s = 0; s < 4; ++s) { const LAS bf16_t* vr = VT + (16 * eb + fr) * RPAD + 32 * s + 4 * fq; const u2v lo = *(const LAS u2v*)vr, hi = *(const LAS u2v*)(vr + 16);
                u4v a; a.x = lo.x; a.y = lo.y; a.z = hi.x; a.w = hi.y; o0[eb] = mfma16(__builtin_bit_cast(s8v, a), pf[s], o0[eb]);
                oF[eb] = mfma16(*(const LAS s8v*)(ST + (16 * eb + fr) * RPAD + 32 * s + 8 * fq), qf[s], oF[eb]); }
        __syncthreads();
#pragma unroll
        for (int i = 0; i < 4; ++i) { const int q = i * 512 + tid, dgq = q & 15, e = q >> 4; *(LAS u4v*)(ST + e * RPAD + 8 * dgq) = sb[i]; }
        __syncthreads();
#pragma unroll
        for (int eb = 0; eb < 8; ++eb)
#pragma unroll
            for (int s = 0; s < 4; ++s) oB[eb] = mfma16(*(const LAS s8v*)(ST + (16 * eb + fr) * RPAD + 32 * s + 8 * fq), qf[s], oB[eb]);
        const float qwf = expf(lgf * (float)(ipos + 1)), qwb = expf(lgb * (float)(RC - ipos));
        float sum = 0.f;
#pragma unroll
        for (int eb = 0; eb < 8; ++eb) { o0[eb] = o0[eb] + oF[eb] * qwf + oB[eb] * qwb; sum += (o0[eb][0] + o0[eb][1]) + (o0[eb][2] + o0[eb][3]); }
        sum += shfl_xor_f(sum, lane, 16); sum += shfl_xor_f(sum, lane, 32);
        const float mu = sum * (1.0f / HD); float var = 0.f;
#pragma unroll
        for (int eb = 0; eb < 8; ++eb) { o0[eb] = o0[eb] - mu; var += (o0[eb][0] * o0[eb][0] + o0[eb][1] * o0[eb][1]) + (o0[eb][2] * o0[eb][2] + o0[eb][3] * o0[eb][3]); }
        var += shfl_xor_f(var, lane, 16); var += shfl_xor_f(var, lane, 32);
        const float rs = 1.0f / sqrtf(var * (1.0f / HD) + GN_EPS);
        const bf16_t* gp = QKVb + (size_t)rowq * INW + 3 * RW + h * HD + 4 * fq; bf16_t* op = MIXb + (size_t)rowq * DM + h * HD + 4 * fq;
#pragma unroll
        for (int eb = 0; eb < 8; ++eb) { const u2v g = *(const u2v*)(gp + 16 * eb);
            u2v w; w.x = pk2(o0[eb][0] * rs * fsilu(bflo(g.x)), o0[eb][1] * rs * fsilu(bfhi(g.x))); w.y = pk2(o0[eb][2] * rs * fsilu(bflo(g.y)), o0[eb][3] * rs * fsilu(bfhi(g.y)));
            *(u2v*)(op + 16 * eb) = w; }
        __syncthreads();
    }
}
}
namespace nv {
constexpr int MCT = 16;
constexpr int NMC = (CTXL + SQ) / MCT;
constexpr int NTL = NMC / 16;
constexpr int CTL = CTXL / 256;
static_assert(CTXL % 256 == 0 && SQ % 256 == 0 && SG == 16 && SP == 64 && NG % 8 == 0, "S5 phase geometry");
constexpr int UP = 264;
constexpr int S5_LDS_LOC = ((NMC * UP * 2 + 15) / 16) * 16, LOCP = 132, S5_LDS_HIN = S5_LDS_LOC + 2 * 16 * LOCP * 4, S5_LDS_END = S5_LDS_HIN + 2 * 16 * RPAD * 2;
static_assert(S5_LDS_END <= 131072, "S5 LDS map");
__device__ __forceinline__ void ph_s5_prep1(const In& I, float* LAMP, float* BBc, int gtid, int gstride) {
    for (int idx_ = gtid; idx_ < (NL * 2 * NG * SP) * PR_PREP; idx_ += gstride) { const int idx = idx_ % (NL * 2 * NG * SP);
        const int p = idx % SP, g = (idx / SP) % NG, ld = idx / (SP * NG);
        const size_t ia = ((size_t)ld * NG + g) * SP + p;
        const double are = I.s5_a_re[ia], aim = I.s5_a_im[ia], dt = exp((double)I.s5_log_step[(size_t)ld * NG + g]);
        for (int tau = 0; tau <= 16; ++tau) { const double mag = exp(tau * are * dt), ang = tau * aim * dt;
            float* o = LAMP + ((((size_t)ld * NG + g) * 17 + tau) * SP + p) * 2; o[0] = (float)(mag * cos(ang)); o[1] = (float)(mag * sin(ang)); }
        const double mag = exp(are * dt), ang = aim * dt, abr = mag * cos(ang), abi = mag * sin(ang), den = are * are + aim * aim, nr = abr - 1.0;
        const double fr = (nr * are + abi * aim) / den, fi = (abi * are - nr * aim) / den;
        for (int c = 0; c < SG; ++c) { const double br = I.s5_b_re[ia * SG + c], bi = I.s5_b_im[ia * SG + c];
            BBc[(ia * SG + c) * 2] = (float)(fr * br - fi * bi); BBc[(ia * SG + c) * 2 + 1] = (float)(fr * bi + fi * br); }
    }
}
__device__ __forceinline__ void ph_s5_prep2a(const In& I, const float* LAMP, const float* BBc, float* KTAU, int gtid, int gstride) {
    for (int idx_ = gtid; idx_ < NL * 2 * NG * 16 * SG * PR_PREP; idx_ += gstride) { const int idx = idx_ % (NL * 2 * NG * 16 * SG);
        const int co = idx % SG, tau = (idx / SG) % 16, g = (idx / (SG * 16)) % NG, ld = idx / (SG * 16 * NG);
        const float* lam = LAMP + (((size_t)ld * NG + g) * 17 + tau) * SP * 2; const float* bb = BBc + ((size_t)ld * NG + g) * SP * SG * 2;
        const float* cr = I.s5_c_re + (((size_t)ld * NG + g) * SG + co) * SP; const float* cim = I.s5_c_im + (((size_t)ld * NG + g) * SG + co) * SP;
        float acc[SG];
#pragma unroll
        for (int ci = 0; ci < SG; ++ci) acc[ci] = 0.f;
#pragma unroll 2
        for (int p = 0; p < SP; ++p) { const float wr = cr[p] * lam[2 * p] - cim[p] * lam[2 * p + 1], wi = cr[p] * lam[2 * p + 1] + cim[p] * lam[2 * p];
            const f4* b4 = (const f4*)(bb + (size_t)p * SG * 2);
#pragma unroll
            for (int q = 0; q < SG / 2; ++q) { const f4 x = b4[q]; acc[2 * q] += wr * x.x - wi * x.y; acc[2 * q + 1] += wr * x.z - wi * x.w; } }
        f4* o = (f4*)(KTAU + (size_t)idx * SG);
#pragma unroll
        for (int q = 0; q < SG / 4; ++q) o[q] = (f4){acc[4 * q], acc[4 * q + 1], acc[4 * q + 2], acc[4 * q + 3]};
    }
}
__device__ __forceinline__ void ph_s5_prep2b(const In& I, const float* LAMP, const float* BBc, bf16_t* MINT, bf16_t* MOUT, int gtid, int gstride) {
    for (int idx_ = gtid; idx_ < NL * 2 * NG * 128 * 32 * PR_PREP; idx_ += gstride) { const int idx = idx_ % (NL * 2 * NG * 128 * 32);
        const int k8 = idx % 32, n = (idx / 32) % 128, g = (idx / (32 * 128)) % NG, ld = idx / (32 * 128 * NG), dir = ld & 1;
        const int reim = n >> 6, p = n & 63, t = k8 >> 1, ci0 = (k8 & 1) * 8, e = dir == 0 ? 15 - t : t;
        const float* lam = LAMP + ((((size_t)ld * NG + g) * 17 + e) * SP + p) * 2; const f4* b4 = (const f4*)(BBc + ((((size_t)ld * NG + g) * SP + p) * SG + ci0) * 2);
        const float lr = lam[0], li = lam[1]; float v[8];
#pragma unroll
        for (int q = 0; q < 4; ++q) { const f4 x = b4[q]; v[2 * q] = reim ? lr * x.y + li * x.x : lr * x.x - li * x.y; v[2 * q + 1] = reim ? lr * x.w + li * x.z : lr * x.z - li * x.w; }
        u4v w; w.x = pk2(v[0], v[1]); w.y = pk2(v[2], v[3]); w.z = pk2(v[4], v[5]); w.w = pk2(v[6], v[7]);
        *(u4v*)(MINT + (size_t)idx * 8) = w;
    }
    for (int idx_ = gtid; idx_ < NL * 2 * NG * 256 * 16 * PR_PREP; idx_ += gstride) { const int idx = idx_ % (NL * 2 * NG * 256 * 16);
        const int k8 = idx % 16, n2 = (idx / 16) % 256, g = (idx / (16 * 256)) % NG, ld = idx / (16 * 256 * NG), dir = ld & 1;
        const int reim = k8 >> 3, p0 = (k8 & 7) * 8, t = n2 >> 4, co = n2 & 15, f = dir == 0 ? t + 1 : 16 - t;
        const f4* l4 = (const f4*)(LAMP + ((((size_t)ld * NG + g) * 17 + f) * SP + p0) * 2);
        const f4* cr4 = (const f4*)(I.s5_c_re + (((size_t)ld * NG + g) * SG + co) * SP + p0); const f4* ci4 = (const f4*)(I.s5_c_im + (((size_t)ld * NG + g) * SG + co) * SP + p0);
        float crv[8], civ[8], v[8];
#pragma unroll
        for (int q = 0; q < 2; ++q) { const f4 a = cr4[q], b = ci4[q]; crv[4 * q] = a.x; crv[4 * q + 1] = a.y; crv[4 * q + 2] = a.z; crv[4 * q + 3] = a.w; civ[4 * q] = b.x; civ[4 * q + 1] = b.y; civ[4 * q + 2] = b.z; civ[4 * q + 3] = b.w; }
#pragma unroll
        for (int q = 0; q < 4; ++q) { const f4 x = l4[q];
            v[2 * q] = reim ? -(crv[2 * q] * x.y + civ[2 * q] * x.x) : crv[2 * q] * x.x - civ[2 * q] * x.y;
            v[2 * q + 1] = reim ? -(crv[2 * q + 1] * x.w + civ[2 * q + 1] * x.z) : crv[2 * q + 1] * x.z - civ[2 * q + 1] * x.w; }
        u4v w; w.x = pk2(v[0], v[1]); w.y = pk2(v[2], v[3]); w.z = pk2(v[4], v[5]); w.w = pk2(v[6], v[7]);
        *(u4v*)(MOUT + (size_t)idx * 8) = w;
    }
}
__device__ __forceinline__ void ph_s5_prep3(const In& I, const float* KTAU, bf16_t* KTOT, int gtid, int gstride) {
    for (int idx_ = gtid; idx_ < NL * NG * 256 * 32 * PR_PREP; idx_ += gstride) { const int idx = idx_ % (NL * NG * 256 * 32);
        const int k8 = idx % 32, n = (idx / 32) % 256, g = (idx / (32 * 256)) % NG, l = idx / (32 * 256 * NG);
        const int t = n >> 4, co = n & 15, tp = k8 >> 1, ci0 = (k8 & 1) * 8;
        float v[8];
#pragma unroll
        for (int q = 0; q < 8; ++q) v[q] = 0.f;
        if (tp <= t) { const f4* s = (const f4*)(KTAU + (((((size_t)l * 2 + 0) * NG + g) * 16 + (t - tp)) * SG + co) * SG + ci0); const f4 a = s[0], b = s[1];
            v[0] += a.x; v[1] += a.y; v[2] += a.z; v[3] += a.w; v[4] += b.x; v[5] += b.y; v[6] += b.z; v[7] += b.w; }
        if (tp >= t) { const f4* s = (const f4*)(KTAU + (((((size_t)l * 2 + 1) * NG + g) * 16 + (tp - t)) * SG + co) * SG + ci0); const f4 a = s[0], b = s[1];
            v[0] += a.x; v[1] += a.y; v[2] += a.z; v[3] += a.w; v[4] += b.x; v[5] += b.y; v[6] += b.z; v[7] += b.w; }
        if (tp == t && co >= ci0 && co < ci0 + 8) { const float dd = I.s5_d[((size_t)l * NG + g) * SG + co];
#pragma unroll
            for (int q = 0; q < 8; ++q) if (q == co - ci0) v[q] += dd; }
        u4v w; w.x = pk2(v[0], v[1]); w.y = pk2(v[2], v[3]); w.z = pk2(v[4], v[5]); w.w = pk2(v[6], v[7]);
        *(u4v*)(KTOT + (size_t)idx * 8) = w;
    }
}
__device__ __forceinline__ int s5_token(int b, int m, int t) { return m < CTXL / MCT ? b * CTXL + MCT * m + t : NCTX + b * SQ + MCT * (m - CTXL / MCT) + t; }

__device__ __forceinline__ int s5_chain_m(int dir, int c) { return dir == 0 ? c : (c < CTXL / MCT ? CTXL / MCT - 1 - c : NMC - 1 - (c - CTXL / MCT)); }
__device__ __forceinline__ void ph_s5(int l, const bf16_t* QKVb, const float* LAMP, const bf16_t* MINT, const bf16_t* MOUT, const bf16_t* KTOT, bf16_t* Zb, LAS unsigned char* lds,
                      int mt_lo, int bid, int nblk, int tid, int lane, int wave) {
    LAS bf16_t* U = (LAS bf16_t*)lds;
    const int fr = lane & 15, fq = lane >> 4;
    for (int u_ = bid; u_ < NG * NB * PR_S5; u_ += nblk) { const int u = u_ % (NG * NB);
        const int g = (u % 8) + 8 * (u / (8 * NB)), b = (u / 8) % NB;
        for (int q = tid; q < NMC * MCT * 2; q += 512) { const int half = q & 1, tok = q >> 1, m = tok / MCT, t = tok % MCT;
            *(LAS u4v*)(U + m * UP + t * 16 + 8 * half) = *(const u4v*)(QKVb + (size_t)s5_token(b, m, t) * INW + 4 * RW + g * SG + 8 * half); }
        __syncthreads();
        unsigned Lp[NTL][2][2];
        { pg8::f32x4 L[NTL][2];
#pragma unroll
            for (int mt = 0; mt < NTL; ++mt) { L[mt][0] = (pg8::f32x4){0.f, 0.f, 0.f, 0.f}; L[mt][1] = L[mt][0]; }
            const int ldir = wave >> 2; const bf16_t* mi = MINT + ((((size_t)l * 2 + ldir) * NG + g) * 128 + 32 * (wave & 3) + fr) * 256 + 8 * fq;
            s8v q[4][2];
#pragma unroll
            for (int s = 0; s < 4; ++s) { q[s][0] = *(const s8v*)(mi + 32 * s); q[s][1] = *(const s8v*)(mi + 16 * 256 + 32 * s); }
#pragma unroll 1
            for (int h = 0; h < 2; ++h) { s8v n[4][2];
#pragma unroll
                for (int s = 0; s < 4; ++s) { n[s][0] = q[s][0]; n[s][1] = q[s][1]; }
                if (h == 0) {
#pragma unroll
                    for (int s = 0; s < 4; ++s) { n[s][0] = *(const s8v*)(mi + 32 * (4 + s)); n[s][1] = *(const s8v*)(mi + 16 * 256 + 32 * (4 + s)); } }
#pragma unroll
                for (int s = 0; s < 4; ++s) {
#pragma unroll
                    for (int mt = 0; mt < NTL; ++mt) { const s8v a = *(const LAS s8v*)(U + (16 * mt + fr) * UP + 128 * h + 32 * s + 8 * fq); L[mt][0] = mfma16(a, q[s][0], L[mt][0]); L[mt][1] = mfma16(a, q[s][1], L[mt][1]); } }
#pragma unroll
                for (int s = 0; s < 4; ++s) { q[s][0] = n[s][0]; q[s][1] = n[s][1]; } }
#pragma unroll
            for (int mt = 0; mt < NTL; ++mt)
#pragma unroll
                for (int c = 0; c < 2; ++c) { Lp[mt][c][0] = pk2(L[mt][c][0], L[mt][c][1]); Lp[mt][c][1] = pk2(L[mt][c][2], L[mt][c][3]); } }
        pg8::f32x4 Y[NTL][2];
#pragma unroll
        for (int mt = 0; mt < NTL; ++mt) { Y[mt][0] = (pg8::f32x4){0.f, 0.f, 0.f, 0.f}; Y[mt][1] = Y[mt][0]; }
        { const bf16_t* kt = KTOT + (((size_t)l * NG + g) * 256 + 32 * wave + fr) * 256 + 8 * fq;
            s8v q[4][2];
#pragma unroll
            for (int s = 0; s < 4; ++s) { q[s][0] = *(const s8v*)(kt + 32 * s); q[s][1] = *(const s8v*)(kt + 16 * 256 + 32 * s); }
#pragma unroll 1
            for (int h = 0; h < 2; ++h) { s8v n[4][2];
#pragma unroll
                for (int s = 0; s < 4; ++s) { n[s][0] = q[s][0]; n[s][1] = q[s][1]; }
                if (h == 0) {
#pragma unroll
                    for (int s = 0; s < 4; ++s) { n[s][0] = *(const s8v*)(kt + 32 * (4 + s)); n[s][1] = *(const s8v*)(kt + 16 * 256 + 32 * (4 + s)); } }
#pragma unroll
                for (int s = 0; s < 4; ++s) {
#pragma unroll
                    for (int mt = 0; mt < NTL; ++mt) { const s8v a = *(const LAS s8v*)(U + (16 * mt + fr) * UP + 128 * h + 32 * s + 8 * fq); Y[mt][0] = mfma16(a, q[s][0], Y[mt][0]); Y[mt][1] = mfma16(a, q[s][1], Y[mt][1]); } }
#pragma unroll
                for (int s = 0; s < 4; ++s) { q[s][0] = n[s][0]; q[s][1] = n[s][1]; } } }
        __syncthreads();
        int fr2 = fr, fq2 = fq; asm volatile("" : "+v"(fr2), "+v"(fq2));
#pragma unroll
        for (int mt = 0; mt < NTL; ++mt)
#pragma unroll
            for (int c = 0; c < 2; ++c)
#pragma unroll
                for (int r = 0; r < 4; ++r) { const unsigned w = Lp[mt][c][r >> 1]; U[(16 * mt + 4 * fq2 + r) * UP + 32 * wave + 16 * c + fr2] = (bf16_t)((r & 1) ? (w >> 16) : (w & 0xffffu)); }
        __syncthreads();
        int tid2 = tid; asm volatile("" : "+v"(tid2));
        if (tid2 < 128) { const int dir = tid2 >> 6, p = tid2 & 63; const float* lam = LAMP + (((((size_t)l * 2 + dir) * NG + g) * 17 + 16) * SP + p) * 2; const float l16r = lam[0], l16i = lam[1];
            float hre = 0.f, him = 0.f; LAS bf16_t* col = U + dir * 128 + p;
#pragma unroll 1
            for (int c0 = 0; c0 < NMC; c0 += 16) { float lr[16], li[16];
#pragma unroll
                for (int i = 0; i < 16; ++i) { const int m = s5_chain_m(dir, c0 + i); lr[i] = bf2f(col[m * UP]); li[i] = bf2f(col[m * UP + 64]); }
#pragma unroll
                for (int i = 0; i < 16; ++i) { const int m = s5_chain_m(dir, c0 + i); col[m * UP] = (bf16_t)f2bf_u(hre); col[m * UP + 64] = (bf16_t)f2bf_u(him);
                    const float nr = l16r * hre - l16i * him + lr[i], ni = l16r * him + l16i * hre + li[i]; hre = nr; him = ni; } } }
        __syncthreads();
        int fr3 = fr, fq3 = fq; asm volatile("" : "+v"(fr3), "+v"(fq3));
#pragma unroll
        for (int dir = 0; dir < 2; ++dir) { const bf16_t* mo = MOUT + ((((size_t)l * 2 + dir) * NG + g) * 256 + 32 * wave + fr3) * 128 + 8 * fq3;
            s8v bo[4][2];
#pragma unroll
            for (int s = 0; s < 4; ++s) { bo[s][0] = *(const s8v*)(mo + 32 * s); bo[s][1] = *(const s8v*)(mo + 16 * 128 + 32 * s); }
#pragma unroll
            for (int s = 0; s < 4; ++s) {
#pragma unroll
                for (int mt = 0; mt < NTL; ++mt) { const s8v a = *(const LAS s8v*)(U + (16 * mt + fr3) * UP + dir * 128 + 32 * s + 8 * fq3); Y[mt][0] = mfma16(a, bo[s][0], Y[mt][0]); Y[mt][1] = mfma16(a, bo[s][1], Y[mt][1]); } } }
        int fr4 = fr, fq4 = fq; asm volatile("" : "+v"(fr4), "+v"(fq4));
#pragma unroll
        for (int mt = 0; mt < NTL; ++mt) { if (mt < mt_lo) continue;
#pragma unroll
            for (int c = 0; c < 2; ++c)
#pragma unroll
                for (int r = 0; r < 4; ++r) { const int m = 16 * mt + 4 * fq4 + r, t = 2 * wave + c;
                    Zb[(size_t)s5_token(b, m, t) * SW + g * SG + fr4] = (bf16_t)f2bf_u(gelu_tanh_f(Y[mt][c][r])); } }
        __syncthreads();
    }
}
}
namespace nv {
constexpr int MK_THREADS = 512;
constexpr int MK_LDS_BYTES = 147456;
constexpr int MK_LDS_MISC = 131072;
constexpr int MK_LDS_TAB = MK_LDS_MISC + 64;
constexpr int MK_LDS_PST = MK_LDS_TAB + 1024;

struct EpiF32N {
    static constexpr bool PERM = false, AFTER_DRAIN = false;
    float* C; int ldc; int ncol;
    __device__ __forceinline__ void operator()(const pg8::f32x4 (&acc)[2][2][4][2], const pg8::Unit& u, int wr, int wc, int fr, int fq) const {
        const int row0 = u.pm * 128 + wr * 64 + fr, col0 = (u.pn % ncol) * 256 + wc * 32 + 4 * fq;
#pragma unroll
        for (int ai = 0; ai < 2; ++ai)
#pragma unroll
            for (int m = 0; m < 4; ++m) { if (ai == 1 && u.half) continue; float* rowp = C + (size_t)(row0 + ai * 128 + m * 16) * ldc + col0;
#pragma unroll
                for (int bj = 0; bj < 2; ++bj)
#pragma unroll
                    for (int n = 0; n < 2; ++n) *(pg8::f32x4*)(rowp + bj * 128 + n * 16) = acc[ai][bj][m][n]; }
    }
};
struct MoeOrder {
    const LAS int* tab; int ncol, G, v, nfu, nhu, exr, nfr, nf, j, nb, p1;
    __device__ __forceinline__ void init(const LAS int* tab_, int ncol_, int G_, int c_) {
        tab = tab_; ncol = ncol_; G = G_; v = (G_ % 8 == 0) ? (c_ % 8) * (G_ / 8) + c_ / 8 : c_;
        nfr = tab_[0]; const int nhr = tab_[1]; int uf = nfr * ncol_, uh = nhr * ncol_; exr = 0;
        { const int a = uf / G_, ex = uf % G_;
          if (ex > 0) { const int keep = 2 * (a + 1) + (uh > 2 * (G_ - ex) ? (uh - 2 * (G_ - ex) + G_ - 1) / G_ : 0), dem = 2 * a + (uh + 2 * ex + G_ - 1) / G_;
              if (dem < keep) { exr = ex / ncol_; uf -= ex; uh += 2 * ex; } } }
        nfu = uf; nhu = uh;
        const int r = nfu % G_; nf = nfu / G_ + (v < r ? 1 : 0);
        nb = G_ - r; j = v - r; p1 = 0;
        if (j >= 0) { const int lim = nhu < 2 * nb ? nhu : 2 * nb; p1 = (j < lim ? 1 : 0) + (j + nb < lim ? 1 : 0); }
    }
    __device__ __forceinline__ void half_unit(int hu, pg8::Unit& u) const {
        const int hr = hu / ncol, jc = hu % ncol; int en, part = 0;
        if (hr < 2 * exr) { en = tab[2 + (nfr - exr) + hr / 2]; part = hr & 1; } else en = tab[2 + nfr + (hr - 2 * exr)];
        u.pm = (en & 0xffff) + part; u.pn = ((en >> 16) & 0xff) * ncol + jc; u.half = 1;
    }
    __device__ __forceinline__ bool next(int i, pg8::Unit& u) const {
        if (i < nf) { const int fu = v + i * G; const int en = tab[2 + fu / ncol]; u.pm = en & 0xffff; u.pn = ((en >> 16) & 0xff) * ncol + fu % ncol; u.half = 0; return true; }
        int k = i - nf;
        if (k < p1) { half_unit(j + k * nb, u); return true; }
        k -= p1;
        const int hu = 2 * nb + v + k * G;
        if (nhu > 2 * nb && hu < nhu) { half_unit(hu, u); return true; }
        return false;
    }
    __device__ __forceinline__ void a_ready(const pg8::Unit&) const {}
    __device__ __forceinline__ void done(const pg8::Unit&) const {}
};
constexpr int I_IN = (DM / 64) * (INW / 32), I_GLU = (SW / 64) * (SW / 32), I_OUT = (DM / 64) * (DM / 32), I_G = (DM / 64) * (EFF / 32), I_D = (EFF / 64) * (DM / 32);
constexpr int NITEMS_L = I_IN + I_GLU + I_OUT + NE * (2 * I_G + I_D);
__device__ __forceinline__ void wcvt_item(const In& I, int l, unsigned char* ws, LAS float* scr, int it, int lane) {
    int r = it;
    if (r < I_IN) { p0_transpose_item(I.w_in + (size_t)l * DM * INW, DM, INW, (bf16*)(ws + OFF_WIN), 0, scr, r, lane); return; } r -= I_IN;
    if (r < I_GLU) { p0_transpose_item(I.s5_glu_w + (size_t)l * SW * SW, SW, SW, (bf16*)(ws + OFF_WGLU), 0, scr, r, lane); return; } r -= I_GLU;
    if (r < I_OUT) { p0_transpose_item(I.w_out + (size_t)l * DM * DM, DM, DM, (bf16*)(ws + OFF_WOUT), 0, scr, r, lane); return; } r -= I_OUT;
    const int e = r / (2 * I_G + I_D); r -= e * (2 * I_G + I_D);
    bf16* wgu = (bf16*)(ws + OFF_WGU) + (size_t)e * 2 * EFF * DM; bf16* wd = (bf16*)(ws + OFF_WD) + (size_t)e * DM * EFF;
    if (r < 2 * I_G) { const int up = r >= I_G ? 1 : 0; r -= up * I_G; const int n0 = 32 * (r % (EFF / 32));
        p0_transpose_item((up ? I.exp_w_up : I.exp_w_gate) + ((size_t)l * NE + e) * DM * EFF, DM, EFF, wgu, (n0 / 128) * 128 + up * 128, scr, r, lane); return; }
    r -= 2 * I_G;
    p0_transpose_item(I.exp_w_down + ((size_t)l * NE + e) * EFF * DM, EFF, DM, wd, 0, scr, r, lane);
}
__device__ __forceinline__ void wcvt_item_l0(const In& I, unsigned char* ws, LAS float* scr, int it, int lane) { wcvt_item(I, 0, ws, scr, it, lane); }
__device__ __forceinline__ void d_wcvt(const In& I, int l, unsigned char* ws, LAS unsigned char* lds, int gw, int ngw, int wave, int lane) {
    LAS float* scr = (LAS float*)(lds + wave * 16384);
    for (int it_ = gw; it_ < NITEMS_L * PR_WCVT; it_ += ngw) wcvt_item(I, l, ws, scr, it_ % NITEMS_L, lane);
}

typedef const __attribute__((address_space(4))) Params* KP;
#define KPARAMS() ({ KP kp_ = (KP)__builtin_amdgcn_kernarg_segment_ptr(); asm volatile("" : "+s"(kp_)); kp_; })
#define IN_FIELDS(F) F(x) F(c) F(ctx) F(c_ctx) F(ada_w) F(ada_b) F(norm1_g) F(w_in) F(ret_decay) F(s5_a_re) F(s5_a_im) F(s5_log_step) F(s5_b_re) F(s5_b_im) \
    F(s5_c_re) F(s5_c_im) F(s5_d) F(s5_glu_w) F(s5_glu_b) F(w_out) F(norm2_g) F(router_grp_w) F(router_grp_b) F(router_exp_w) F(router_exp_b) \
    F(exp_w_gate) F(exp_w_up) F(exp_w_down) F(final_g)
__device__ __forceinline__ In load_in(KP kp) { In I;
#define F(n) I.n = kp->I.n;
    IN_FIELDS(F)
#undef F
    return I; }

__global__ void __launch_bounds__(MK_THREADS, 2) k_mega(Params p_unused) {
#ifdef HOST_EMU2
    unsigned char* lds_raw = emu::block_lds();
#else
    extern __shared__ __attribute__((aligned(16))) unsigned char lds_raw[];
#endif
    LAS unsigned char* lds = (LAS unsigned char*)lds_raw;
    const int tid0 = threadIdx.x;
    if (tid0 < 16) ((LAS unsigned*)(lds + MK_LDS_MISC))[tid0] = 0u;
    __syncthreads();
    XcdBarrier bar;
    { KP kp = KPARAMS(); bar = xcd_barrier_post((unsigned*)(kp->ws + OFF_BAR), (volatile LAS unsigned*)(lds + MK_LDS_MISC)); }
    const int bid = blockIdx.x, nblk = gridDim.x, gstride = nblk * MK_THREADS, wave0 = __builtin_amdgcn_readfirstlane(tid0 >> 6);
    const int ngw = nblk * 8;
#define BAR() do { XcdBarrier b_ = bar; asm volatile("" : "+s"(b_.x)); xcd_barrier(b_); } while (0)
#ifdef HOST_EMU2
#define LANE_ID(v) int v = threadIdx.x & 63
#else
#define LANE_ID(v) int v; asm volatile("v_mbcnt_lo_u32_b32 %0, -1, 0\n\tv_mbcnt_hi_u32_b32 %0, -1, %0" : "=v"(v))
#endif
#define PH_BEGIN { KP kp = KPARAMS(); unsigned char* ws = kp->ws; const In I = load_in(kp); (void)I; (void)ws; LANE_ID(lane); \
        const int wave = wave0, tid = wave0 * 64 + lane, gtid = bid * MK_THREADS + tid, gw = bid * 8 + wave; (void)tid; (void)gtid; (void)lane; (void)wave; (void)gw;
#define PH_END }
#define WSF(off) ((float*)(ws + (off)))
#define WSB(off) ((bf16_t*)(ws + (off)))
#define WSI(off) ((int*)(ws + (off)))
#define LTAB ((LAS int*)(lds + MK_LDS_TAB))
#define LPST ((LAS int*)(lds + MK_LDS_PST))
    PH_BEGIN { LAS float* scond = (LAS float*)lds;
        for (int i = tid; i < NCOND * DM; i += MK_THREADS) { const int j = i / DM, k = i % DM; scond[i] = silu_f(j < NB ? I.c[j * DM + k] : I.c_ctx[k]); }
        __syncthreads();
        ph_adaln_part(I, WSF(OFF_PART), scond, gw, ngw, lane);
        __syncthreads(); } PH_END
    PH_BEGIN if (wave < 6) { LAS float* scr = (LAS float*)(lds + wave * 16384); for (int it_ = bid * 6 + wave; it_ < NITEMS_L * PR_WCVT; it_ += nblk * 6) wcvt_item_l0(I, ws, scr, it_ % NITEMS_L, lane); }
      else { const int g2 = bid * 128 + (wave - 6) * 64 + lane, s2 = nblk * 128; ph_prep(I, WSF(OFF_RWT), g2, s2); ph_rope_table(WSF(OFF_ROPE), g2, s2); ph_s5_prep1(I, WSF(OFF_LAMP), WSF(OFF_BBC), g2, s2); } PH_END
    BAR();
    PH_BEGIN ph_adaln_reduce(I, WSF(OFF_PART), WSF(OFF_MOD), gtid, gstride); PH_END
    PH_BEGIN ph_s5_prep2a(I, WSF(OFF_LAMP), WSF(OFF_BBC), WSF(OFF_KTAU), gtid, gstride); PH_END
    BAR();
    for (int l = 0; l < NL; ++l) {
        const int row_lo = (l == NL - 1) ? NCTX : 0;
        if (l > 0) BAR();
        for (int q_ = 0; q_ < PR_BAR; ++q_) BAR();
        if (l > 0) { PH_BEGIN d_wcvt(I, l, ws, lds, gw, ngw, wave, lane); PH_END }
        if (l == 0) { PH_BEGIN ph_route_prep(I, WSF(OFF_MOD), WSF(OFF_RWT), WSF(OFF_WP), WSF(OFF_CB), gtid, gstride, gw, ngw, lane); PH_END }
        if (l == 0) { PH_BEGIN ph_norm1<0>(I, l, WSF(OFF_MOD), WSF(OFF_X), WSB(OFF_YB), WSI(OFF_TS), WSF(OFF_TG), WSB(OFF_HB), nullptr, gw, ngw, lane); PH_END }
        else        { PH_BEGIN ph_norm1<1>(I, l, WSF(OFF_MOD), WSF(OFF_X), WSB(OFF_YB), WSI(OFF_TS), WSF(OFF_TG), WSB(OFF_HB), nullptr, gw, ngw, lane); PH_END }
        BAR();
        PH_BEGIN pg8::Gemm g{WSB(OFF_HB), WSB(OFF_WIN), NTOK, INW, DM}; pg8::StaticOrder S; S.init(NTOK, INW, nblk, bid); EpiQKV E{WSB(OFF_QKVB), WSF(OFF_ROPE)};
          pg8::gemm_phase<EpiQKV, pg8::StaticOrder, true, true>(lds, g, S, E, tid); PH_END
        BAR();
        PH_BEGIN ph_ret_kv(I, l, WSB(OFF_QKVB), WSB(OFF_KVT), lds, bid, nblk, tid, lane, wave); PH_END
        if (l == 0) { PH_BEGIN const int nu = NB * NH * NCH, f = nu % nblk == 0 ? 0 : nu % nblk;
            if (bid >= f) { ph_s5_prep2b(I, WSF(OFF_LAMP), WSF(OFF_BBC), WSB(OFF_MINT), WSB(OFF_MOUT), (bid - f) * MK_THREADS + tid, (nblk - f) * MK_THREADS);
                ph_s5_prep3(I, WSF(OFF_KTAU), WSB(OFF_KTOT), (bid - f) * MK_THREADS + tid, (nblk - f) * MK_THREADS); } PH_END }
        BAR();
        PH_BEGIN ph_ret_scan(I, l, WSB(OFF_KVT), WSB(OFF_STT), gtid, gstride); PH_END
        PH_BEGIN ph_s5(l, WSB(OFF_QKVB), WSF(OFF_LAMP), WSB(OFF_MINT), WSB(OFF_MOUT), WSB(OFF_KTOT), WSB(OFF_ZB), lds, (l == NL - 1) ? CTL : 0, bid, nblk, tid, lane, wave); PH_END
        BAR();
        PH_BEGIN ph_ret_out(I, l, WSB(OFF_QKVB), WSB(OFF_STT), WSB(OFF_MIXB), lds, (l == NL - 1) ? CC : 0, bid, nblk, tid, lane, wave); PH_END
        PH_BEGIN const int nru = NB * NH * (NCH - ((l == NL - 1) ? CC : 0)), shift = nru % nblk;
          pg8::Gemm g{WSB(OFF_ZB), WSB(OFF_WGLU), NTOK, SW, SW}; pg8::StaticOrder S; S.init(NTOK, SW, nblk, (bid - shift + nblk) % nblk);
          EpiGlu E{WSB(OFF_MIXB), DM, RW, WSB(OFF_ZB), SW, I.s5_glu_b + (size_t)l * SW};
          pg8::gemm_phase<EpiGlu, pg8::StaticOrder, true, true>(lds, g, S, E, tid); PH_END
        BAR();
        PH_BEGIN const int rbase = (l == NL - 1) ? NCTX : 0;
          pg8::Gemm g{WSB(OFF_MIXB) + (size_t)rbase * DM, WSB(OFF_WOUT), NTOK - rbase, DM, DM}; pg8::StaticOrder S; S.init(NTOK - rbase, DM, nblk, bid); if (l > 0) S.rep = 1;
          EpiResid E{WSF(OFF_X), l == 0 ? I.ctx : WSF(OFF_X), l == 0 ? I.x : WSF(OFF_X) + (size_t)NCTX * DM, WSF(OFF_MOD), l, rbase};
          pg8::gemm_phase<EpiResid, pg8::StaticOrder, true, true>(lds, g, S, E, tid); PH_END
        BAR();
        PH_BEGIN ph_route(I, l, WSF(OFF_X), WSF(OFF_WP), WSF(OFF_CB), WSI(OFF_TE), WSF(OFF_TG), WSF(OFF_RSTD), WSI(OFF_TP), WSI(OFF_HIST), lds, row_lo, bid, nblk, tid, lane, wave); PH_END
        BAR();
        PH_BEGIN ph_gather(I, l, WSF(OFF_MOD), WSF(OFF_X), WSF(OFF_RSTD), WSI(OFF_TE), WSI(OFF_TP), WSI(OFF_HIST), WSI(OFF_TS), WSB(OFF_XG), lds, LTAB, LPST, row_lo, bid, nblk, tid, lane, wave); PH_END
        BAR();
        PH_BEGIN pg8::Gemm g{WSB(OFF_XG), WSB(OFF_WGU), 0, 0, DM}; MoeOrder S; S.init(LTAB, (2 * EFF) / 256, nblk, bid); EpiAct E{WSB(OFF_ACTB), EFF, (2 * EFF) / 256};
          pg8::gemm_phase<EpiAct, MoeOrder, true, true>(lds, g, S, E, tid); PH_END
        BAR();
        PH_BEGIN pg8::Gemm g{WSB(OFF_ACTB), WSB(OFF_WD), 0, 0, EFF}; MoeOrder S; S.init(LTAB, DM / 256, nblk, bid); EpiBf16N E{WSB(OFF_YB), DM, DM / 256};
          pg8::gemm_phase<EpiBf16N, MoeOrder, true, true>(lds, g, S, E, tid); PH_END
    }
    BAR();
    PH_BEGIN ph_norm1<2>(I, NL, WSF(OFF_MOD), WSF(OFF_X), WSB(OFF_YB), WSI(OFF_TS), WSF(OFF_TG), nullptr, kp->out, gw, ngw, lane); PH_END
#undef BAR
}
}
#endif

static nv::Params make_params(void* const* d_in, void* d_out, void* d_ws) {
    nv::Params p{};
    const float** f = (const float**)&p.I;
    for (int i = 0; i < 29; ++i) f[i] = (const float*)d_in[i];
    p.out = (float*)d_out; p.ws = (unsigned char*)d_ws;
    return p;
}

extern "C" void kernel_launch(void* const* d_in, const int* in_sizes, int n_in, void* d_out, int out_size, void* d_ws, size_t ws_size, hipStream_t stream) {
    using namespace nv;
    (void)in_sizes; (void)out_size;
    Params p = make_params(d_in, d_out, d_ws);
#if defined(HOST_EMU2)
    (void)n_in; (void)ws_size; (void)stream;
    memset((char*)d_ws + OFF_CTL, 0, SZ_CTL + SZ_BAR);
    static Params pk; pk = p; emu_kernarg = &pk;
    emu::run_grid([]() { k_mega(pk); }, EMU_GRID, MK_THREADS, MK_LDS_BYTES);
#elif !defined(HOST_EMU)
    static int grid = 0;
    if (grid == 0) {
        if (n_in != 29 || ws_size < WS_NEED) { fprintf(stderr, "kernel_launch: n_in %d ws %zu need %zu\n", n_in, ws_size, (size_t)WS_NEED); grid = -1; return; }
        int dev = 0, cus = 0, per_cu = 0;
        if (hipGetDevice(&dev) != hipSuccess || hipDeviceGetAttribute(&cus, hipDeviceAttributeMultiprocessorCount, dev) != hipSuccess) { grid = -1; return; }
        if (hipFuncSetAttribute((const void*)k_mega, hipFuncAttributeMaxDynamicSharedMemorySize, MK_LDS_BYTES) != hipSuccess) { fprintf(stderr, "kernel_launch: hipFuncSetAttribute failed\n"); grid = -1; return; }
        if (hipOccupancyMaxActiveBlocksPerMultiprocessor(&per_cu, (const void*)k_mega, MK_THREADS, MK_LDS_BYTES) != hipSuccess || per_cu < 1) { fprintf(stderr, "kernel_launch: occupancy query says %d\n", per_cu); grid = -1; (void)hipGetLastError(); return; }
        (void)hipGetLastError();
        grid = cus;
    }
    if (grid < 0) return;
    (void)hipMemsetAsync((char*)d_ws + OFF_CTL, 0, SZ_CTL + SZ_BAR, stream);
    hipLaunchKernelGGL(k_mega, dim3(grid), dim3(MK_THREADS), MK_LDS_BYTES, stream, p);
#endif
}
```

```cpp
#ifdef HOST_EMU
#include <cstdio>
#include <cstdlib>
#include <cstring>
#include <cmath>
#include <vector>
#include <cstdint>
#define __global__
#define __device__
#define __host__
#define __forceinline__ inline
#define __launch_bounds__(...)
struct emu_dim3 { unsigned x, y, z; };
static emu_dim3 threadIdx = {0, 0, 0}, blockIdx = {0, 0, 0}, blockDim = {1, 1, 1}, gridDim = {1, 1, 1};
static inline int atomicAdd(int* p, int v) { int o = *p; *p += v; return o; }
typedef void* hipStream_t;
static inline void __syncthreads() {}
#else
#include <hip/hip_runtime.h>
#include <cstdio>
#include <cstdint>
#endif

#ifndef D_MODEL
#define D_MODEL 2048
#define BATCH 4
#define SEQ 2048
#define DEPTH 2
#define GRID_W 64
#define CTX_LEN 256
#define RET_HEADS 8
#define RET_CHUNK 128
#define S5_GROUP 16
#define S5_STATE 64
#define N_EXPERT_GROUPS 4
#define EXPERTS_PER_GROUP 8
#define EXPERT_FF 512
#endif

namespace nv {
constexpr int DM = D_MODEL, NB = BATCH, SQ = SEQ, CTXL = CTX_LEN, NL = DEPTH, GW = GRID_W;
constexpr int RW = DM / 2, SW = DM - RW, NH = RET_HEADS, HD = RW / NH, RC = RET_CHUNK;
constexpr int SG = S5_GROUP, NG = SW / SG, SP = S5_STATE;
constexpr int INW = 4 * RW + SW;
constexpr int NEG = N_EXPERT_GROUPS, EPG = EXPERTS_PER_GROUP, NE = NEG * EPG, EFF = EXPERT_FF;
constexpr int NMOD = 6;
constexpr int NCTX = NB * CTXL, NLAT = NB * SQ, NTOK = NCTX + NLAT;
constexpr int CC = CTXL / RC, LC = SQ / RC, NCH = CC + LC;
constexpr int NCOND = NB + 1;
constexpr float NORM_EPS = 1e-6f, GN_EPS = 1e-5f;
constexpr int MOE_TILE = 128;
constexpr int MOE_CAP = ((2 * NTOK + NE * (MOE_TILE - 1)) / MOE_TILE) * MOE_TILE + MOE_TILE;

struct In {
    const float *x, *c, *ctx, *c_ctx, *ada_w, *ada_b, *norm1_g, *w_in, *ret_decay, *s5_a_re, *s5_a_im, *s5_log_step, *s5_b_re, *s5_b_im,
        *s5_c_re, *s5_c_im, *s5_d, *s5_glu_w, *s5_glu_b, *w_out, *norm2_g, *router_grp_w, *router_grp_b, *router_exp_w, *router_exp_b,
        *exp_w_gate, *exp_w_up, *exp_w_down, *final_g;
};

typedef unsigned short bf16_t;
__device__ __forceinline__ bf16_t f2bf(float f) { unsigned u; __builtin_memcpy(&u, &f, 4); u = (u + 0x7fffu + ((u >> 16) & 1u)) >> 16; return (bf16_t)u; }
__device__ __forceinline__ float nbf2f(bf16_t b) { unsigned u = ((unsigned)b) << 16; float f; __builtin_memcpy(&f, &u, 4); return f; }
__device__ __forceinline__ float silu_f(float v) { return v / (1.0f + expf(-v)); }
__device__ __forceinline__ float sigmoid_f(float v) { return 1.0f / (1.0f + expf(-v)); }
__device__ __forceinline__ float gelu_tanh_f(float v) { return 0.5f * v * (1.0f + tanhf(0.7978845608028654f * (v + 0.044715f * v * v * v))); }
__device__ __forceinline__ int cond_of_row(int r) { return r < NCTX ? NB : (r - NCTX) / SQ; }
__device__ __forceinline__ int row_of(int b, int n, int p) { return n < CC ? b * CTXL + n * RC + p : NCTX + b * SQ + (n - CC) * RC + p; }
__device__ __forceinline__ void bnp_of_row(int r, int& b, int& n, int& p) {
    if (r < NCTX) { b = r / CTXL; const int t = r % CTXL; n = t / RC; p = t % RC; }
    else { const int q = r - NCTX; b = q / SQ; const int t = q % SQ; n = CC + t / RC; p = t % RC; }
}
#define MODV(MOD, l, j, m) ((MOD) + ((size_t)((l) * NCOND + (j)) * NMOD + (m)) * DM)

__device__ __forceinline__ void d_adaln(const In& I, float* MOD, long gtid, long gstride) {
    for (long idx = gtid; idx < (long)NL * NMOD * DM; idx += gstride) {
        const int l = (int)(idx / (NMOD * DM)), n = (int)(idx % (NMOD * DM));
        float acc[NCOND];
#pragma unroll
        for (int j = 0; j < NCOND; ++j) acc[j] = 0.f;
        const float* w = I.ada_w + (size_t)l * DM * NMOD * DM + n;
        for (int k = 0; k < DM; ++k) {
            const float wv = w[(size_t)k * NMOD * DM];
#pragma unroll
            for (int j = 0; j < NB; ++j) acc[j] += silu_f(I.c[j * DM + k]) * wv;
            acc[NB] += silu_f(I.c_ctx[k]) * wv;
        }
        const float bv = I.ada_b[(size_t)l * NMOD * DM + n];
#pragma unroll
        for (int j = 0; j < NCOND; ++j) MOD[(size_t)(l * NCOND + j) * NMOD * DM + n] = acc[j] + bv;
    }
}
__device__ __forceinline__ void d_copy_x(const In& I, float* X, long gtid, long gstride) {
    for (long idx = gtid; idx < (long)NTOK * DM; idx += gstride) {
        const int r = (int)(idx / DM), j = (int)(idx % DM);
        X[idx] = r < NCTX ? I.ctx[(size_t)r * DM + j] : I.x[(size_t)(r - NCTX) * DM + j];
    }
}
__device__ __forceinline__ void d_norm_mod(const float* X, const float* g, const float* MOD, int l, int mshift, int mscale, float* H, bf16_t* Hb, long gtid, long gstride) {
    for (long r = gtid; r < NTOK; r += gstride) {
        const float* xr = X + (size_t)r * DM; float ss = 0.f;
        for (int j = 0; j < DM; ++j) ss += xr[j] * xr[j];
        const float rs = 1.0f / sqrtf(ss / DM + NORM_EPS);
        const int cj = cond_of_row((int)r);
        const float* sh = MODV(MOD, l, cj, mshift); const float* sc = MODV(MOD, l, cj, mscale);
        for (int j = 0; j < DM; ++j) { const float v = xr[j] * rs * g[j] * (1.0f + sc[j]) + sh[j]; H[(size_t)r * DM + j] = v; if (Hb) Hb[(size_t)r * DM + j] = f2bf(v); }
    }
}
__device__ __forceinline__ void d_rope(float* QKV, long gtid, long gstride) {
    const float kscale = 1.0f / sqrtf((float)HD);
    constexpr int NF = HD / 4;
    for (long idx = gtid; idx < (long)NTOK * 2 * NH * (HD / 2); idx += gstride) {
        const int i = (int)(idx % (HD / 2)); long t = idx / (HD / 2);
        const int h = (int)(t % NH); t /= NH; const int which = (int)(t % 2); const int r = (int)(t / 2);
        float* p = QKV + (size_t)r * INW + which * RW + h * HD + 2 * i;
        float t0 = p[0], t1 = p[1];
        if (r >= NCTX) {
            const int pos = (r - NCTX) % SQ, rowp = pos / GW, colp = pos % GW;
            const int f = i < NF ? i : i - NF;
            const float inv = powf(10000.0f, -(float)f / (float)NF);
            const float ang = (i < NF ? (float)rowp : (float)colp) * inv;
            const float cs = cosf(ang), sn = sinf(ang);
            const float a = t0 * cs - t1 * sn, b = t0 * sn + t1 * cs; t0 = a; t1 = b;
        }
        if (which == 1) { t0 *= kscale; t1 *= kscale; }
        p[0] = t0; p[1] = t1;
    }
}
__device__ __forceinline__ float logg(const In& I, int l, int dir, int h) { return -expf(I.ret_decay[(l * 2 + dir) * NH + h]); }
__device__ __forceinline__ void d_ret_kv(const In& I, int l, const float* QKV, float* KV, long gtid, long gstride) {
    for (long idx = gtid; idx < (long)2 * NB * NH * NCH * HD * HD; idx += gstride) {
        const int e = (int)(idx % HD); long t = idx / HD; const int d = (int)(t % HD); t /= HD; const int n = (int)(t % NCH); t /= NCH;
        const int h = (int)(t % NH); t /= NH; const int b = (int)(t % NB); const int dir = (int)(t / NB);
        const float lg = logg(I, l, dir, h); float acc = 0.f;
        for (int p = 0; p < RC; ++p) {
            const int row = row_of(b, n, p);
            const float w = expf(lg * (float)(dir == 0 ? RC - 1 - p : p));
            acc += w * QKV[(size_t)row * INW + RW + h * HD + d] * QKV[(size_t)row * INW + 2 * RW + h * HD + e];
        }
        KV[idx] = acc;
    }
}
__device__ __forceinline__ int chain_chunk(int dir, int step) { return dir == 0 ? step : (step < CC ? CC - 1 - step : NCH - 1 - (step - CC)); }
__device__ __forceinline__ void d_ret_scan(const In& I, int l, const float* KV, float* ST, long gtid, long gstride) {
    for (long idx = gtid; idx < (long)2 * NB * NH * HD * HD; idx += gstride) {
        const int de = (int)(idx % (HD * HD)); long t = idx / (HD * HD); const int h = (int)(t % NH); t /= NH; const int b = (int)(t % NB); const int dir = (int)(t / NB);
        const float dec = expf(logg(I, l, dir, h) * (float)RC); float s = 0.f;
        for (int step = 0; step < NCH; ++step) {
            const int n = chain_chunk(dir, step);
            const size_t o = ((((size_t)dir * NB + b) * NH + h) * NCH + n) * HD * HD + de;
            ST[o] = s; s = dec * s + KV[o];
        }
    }
}
__device__ __forceinline__ void d_ret_scores(const In& I, int l, const float* QKV, float* SC, long gtid, long gstride) {
    for (long idx = gtid; idx < (long)NTOK * NH * RC; idx += gstride) {
        const int j = (int)(idx % RC); long t = idx / RC; const int h = (int)(t % NH); const int r = (int)(t / NH);
        int b, n, p; bnp_of_row(r, b, n, p);
        const int rj = row_of(b, n, j);
        const float* q = QKV + (size_t)r * INW + h * HD; const float* k = QKV + (size_t)rj * INW + RW + h * HD;
        float dot = 0.f;
        for (int d = 0; d < HD; ++d) dot += q[d] * k[d];
        const float D = j <= p ? expf(logg(I, l, 0, h) * (float)(p - j)) : expf(logg(I, l, 1, h) * (float)(j - p));
        SC[idx] = dot * D;
    }
}
__device__ __forceinline__ void d_ret_out(const In& I, int l, const float* QKV, const float* SC, const float* ST, float* RO, long gtid, long gstride) {
    for (long idx = gtid; idx < (long)NTOK * NH * HD; idx += gstride) {
        const int e = (int)(idx % HD); long t = idx / HD; const int h = (int)(t % NH); const int r = (int)(t / NH);
        int b, n, p; bnp_of_row(r, b, n, p);
        float acc = 0.f;
        const float* sc = SC + ((size_t)r * NH + h) * RC;
        for (int j = 0; j < RC; ++j) acc += sc[j] * QKV[(size_t)row_of(b, n, j) * INW + 2 * RW + h * HD + e];
        const float qwf = expf(logg(I, l, 0, h) * (float)(p + 1)), qwb = expf(logg(I, l, 1, h) * (float)(RC - p));
        const float* sf = ST + ((((size_t)0 * NB + b) * NH + h) * NCH + n) * HD * HD + e;
        const float* sb = ST + ((((size_t)1 * NB + b) * NH + h) * NCH + n) * HD * HD + e;
        const float* q = QKV + (size_t)r * INW + h * HD;
        for (int d = 0; d < HD; ++d) acc += q[d] * (qwf * sf[(size_t)d * HD] + qwb * sb[(size_t)d * HD]);
        RO[(size_t)r * RW + h * HD + e] = acc;
    }
}
__device__ __forceinline__ void d_ret_norm(const float* RO, const float* QKV, float* MIX, bf16_t* MIXb, long gtid, long gstride) {
    for (long idx = gtid; idx < (long)NTOK * NH; idx += gstride) {
        const int h = (int)(idx % NH), r = (int)(idx / NH);
        const float* o = RO + (size_t)r * RW + h * HD; float mu = 0.f;
        for (int e = 0; e < HD; ++e) mu += o[e];
        mu /= HD; float var = 0.f;
        for (int e = 0; e < HD; ++e) var += (o[e] - mu) * (o[e] - mu);
        var /= HD; const float rs = 1.0f / sqrtf(var + GN_EPS);
        for (int e = 0; e < HD; ++e) { const float v = (o[e] - mu) * rs * silu_f(QKV[(size_t)r * INW + 3 * RW + h * HD + e]); MIX[(size_t)r * DM + h * HD + e] = v; if (MIXb) MIXb[(size_t)r * DM + h * HD + e] = f2bf(v); }
    }
}
__device__ __forceinline__ void d_s5_disc(const In& I, int l, float* ABAR, float* BBAR, long gtid, long gstride) {
    for (long idx = gtid; idx < (long)2 * NG * SP; idx += gstride) {
        const int p = (int)(idx % SP); long t = idx / SP; const int g = (int)(t % NG); const int dir = (int)(t / NG);
        const size_t ia = (((size_t)l * 2 + dir) * NG + g) * SP + p;
        const float are = I.s5_a_re[ia], aim = I.s5_a_im[ia], dt = expf(I.s5_log_step[((size_t)l * 2 + dir) * NG + g]);
        const float mag = expf(are * dt), ang = aim * dt;
        const float abr = mag * cosf(ang), abi = mag * sinf(ang);
        const float den = are * are + aim * aim, nr = abr - 1.0f;
        const float fr = (nr * are + abi * aim) / den, fi = (abi * are - nr * aim) / den;
        ABAR[idx * 2] = abr; ABAR[idx * 2 + 1] = abi;
#pragma unroll
        for (int c = 0; c < SG; ++c) {
            const float br = I.s5_b_re[ia * SG + c], bi = I.s5_b_im[ia * SG + c];
            BBAR[(idx * SG + c) * 2] = fr * br - fi * bi; BBAR[(idx * SG + c) * 2 + 1] = fr * bi + fi * br;
        }
    }
}
__device__ __forceinline__ int chain_row(int dir, int b, int step) {
    if (dir == 0) return step < CTXL ? b * CTXL + step : NCTX + b * SQ + (step - CTXL);
    return step < CTXL ? b * CTXL + (CTXL - 1 - step) : NCTX + b * SQ + (SQ - 1 - (step - CTXL));
}
__device__ __forceinline__ void d_s5_scan(int dir, const bf16_t* QKV, const float* ABAR, const float* BBAR, float* HS, long gtid, long gstride) {
    for (long idx = gtid; idx < (long)NB * NG * SP; idx += gstride) {
        const int p = (int)(idx % SP); long t = idx / SP; const int g = (int)(t % NG); const int b = (int)(t / NG);
        const size_t ip = ((size_t)dir * NG + g) * SP + p;
        const float ar = ABAR[ip * 2], ai = ABAR[ip * 2 + 1];
        float br[SG], bi[SG];
#pragma unroll
        for (int c = 0; c < SG; ++c) { br[c] = BBAR[(ip * SG + c) * 2]; bi[c] = BBAR[(ip * SG + c) * 2 + 1]; }
        float hr = 0.f, hi = 0.f;
        for (int step = 0; step < CTXL + SQ; ++step) {
            const int row = chain_row(dir, b, step);
            const bf16_t* u = QKV + (size_t)row * INW + 4 * RW + g * SG;
            float ur = 0.f, ui = 0.f;
#pragma unroll
            for (int c = 0; c < SG; ++c) { const float uv = nbf2f(u[c]); ur += br[c] * uv; ui += bi[c] * uv; }
            const float nr = ar * hr - ai * hi + ur, ni = ar * hi + ai * hr + ui; hr = nr; hi = ni;
            float* o = HS + (((size_t)row * NG + g) * SP + p) * 2; o[0] = hr; o[1] = hi;
        }
    }
}
__device__ __forceinline__ void d_s5_y(const In& I, int l, int dir, const bf16_t* QKV, const float* HS, float* Z, bf16_t* Zb, long gtid, long gstride) {
    for (long idx = gtid; idx < (long)NTOK * SW; idx += gstride) {
        const int ch = (int)(idx % SW), row = (int)(idx / SW), g = ch / SG, c = ch % SG;
        float y = dir == 0 ? I.s5_d[((size_t)l * NG + g) * SG + c] * nbf2f(QKV[(size_t)row * INW + 4 * RW + ch]) : Z[idx];
        const float* cr = I.s5_c_re + ((((size_t)l * 2 + dir) * NG + g) * SG + c) * SP;
        const float* ci = I.s5_c_im + ((((size_t)l * 2 + dir) * NG + g) * SG + c) * SP;
        const float* h = HS + ((size_t)row * NG + g) * SP * 2;
        for (int p = 0; p < SP; ++p) y += cr[p] * h[2 * p] - ci[p] * h[2 * p + 1];
        if (dir == 1) { y = gelu_tanh_f(y); if (Zb) Zb[idx] = f2bf(y); }
        Z[idx] = y;
    }
}
__device__ __forceinline__ void d_glu_ep(const In& I, int l, const float* Z, const float* T, float* MIX, bf16_t* MIXb, long gtid, long gstride) {
    for (long idx = gtid; idx < (long)NTOK * SW; idx += gstride) {
        const int j = (int)(idx % SW), r = (int)(idx / SW);
        const float v = Z[idx] * sigmoid_f(T[idx] + I.s5_glu_b[(size_t)l * SW + j]); MIX[(size_t)r * DM + RW + j] = v; if (MIXb) MIXb[(size_t)r * DM + RW + j] = f2bf(v);
    }
}
__device__ __forceinline__ void d_resid(float* X, const float* T2, const float* MOD, int l, int m, long gtid, long gstride) {
    for (long idx = gtid; idx < (long)NTOK * DM; idx += gstride) {
        const int j = (int)(idx % DM), r = (int)(idx / DM);
        X[idx] += MODV(MOD, l, cond_of_row(r), m)[j] * T2[idx];
    }
}
__device__ __forceinline__ void d_route(const In& I, int l, const float* H2, int* TE, int* TP, float* TG, int* CNT, int row_lo, long gtid, long gstride) {
    for (long r = row_lo + gtid; r < NTOK; r += gstride) {
        float gl[NEG], el[NE];
#pragma unroll
        for (int j = 0; j < NEG; ++j) gl[j] = 0.f;
#pragma unroll
        for (int j = 0; j < NE; ++j) el[j] = 0.f;
        const float* h = H2 + (size_t)r * DM;
        const float* gw = I.router_grp_w + (size_t)l * DM * NEG; const float* ew = I.router_exp_w + (size_t)l * DM * NE;
        for (int k = 0; k < DM; ++k) {
            const float hv = h[k];
#pragma unroll
            for (int j = 0; j < NEG; ++j) gl[j] += hv * gw[(size_t)k * NEG + j];
#pragma unroll
            for (int j = 0; j < NE; ++j) el[j] += hv * ew[(size_t)k * NE + j];
        }
#pragma unroll
        for (int j = 0; j < NEG; ++j) gl[j] += I.router_grp_b[l * NEG + j];
#pragma unroll
        for (int j = 0; j < NE; ++j) el[j] += I.router_exp_b[l * NE + j];
        int grp = 0; float gmax = gl[0];
#pragma unroll
        for (int j = 1; j < NEG; ++j) if (gl[j] > gmax) { gmax = gl[j]; grp = j; }
        float den = 0.f;
#pragma unroll
        for (int j = 0; j < NEG; ++j) den += expf(gl[j] - gmax);
        const float gprob = 1.0f / den;
        float sel[EPG];
#pragma unroll
        for (int j = 0; j < EPG; ++j) { float v = el[j];
#pragma unroll
            for (int g2 = 1; g2 < NEG; ++g2) v = (grp == g2) ? el[g2 * EPG + j] : v;
            sel[j] = v; }
        int i0 = 0; float l0 = sel[0];
#pragma unroll
        for (int j = 1; j < EPG; ++j) if (sel[j] > l0) { l0 = sel[j]; i0 = j; }
        int i1 = -1; float l1 = -3.0e38f;
#pragma unroll
        for (int j = 0; j < EPG; ++j) if (j != i0 && sel[j] > l1) { l1 = sel[j]; i1 = j; }
        const float e1 = expf(l1 - l0), g0 = gprob / (1.0f + e1), g1 = gprob * e1 / (1.0f + e1);
        const int ex0 = grp * EPG + i0, ex1 = grp * EPG + i1;
        TE[r * 2] = ex0; TE[r * 2 + 1] = ex1; TG[r * 2] = g0; TG[r * 2 + 1] = g1;
        TP[r * 2] = atomicAdd(&CNT[ex0], 1); TP[r * 2 + 1] = atomicAdd(&CNT[ex1], 1);
    }
}
__device__ __forceinline__ void d_moe_offsets(const int* CNT, int* META, int tile, long gtid) {
    if (gtid == 0) {
        int off = 0, nt = 0;
        for (int e = 0; e < NE; ++e) {
            META[1 + e] = off; const int t = (CNT[e] + tile - 1) / tile;
            for (int k = 0; k < t; ++k) META[64 + nt + k] = e;
            nt += t; off += t * tile;
        }
        META[0] = nt;
    }
}
__device__ __forceinline__ void d_moe_scatter(const int* TE, const int* TP, const int* META, int* SLOT_TOK, int* TS, int row_lo, long gtid, long gstride) {
    for (long idx = (long)row_lo * 2 + gtid; idx < (long)NTOK * 2; idx += gstride) {
        const int slot = META[1 + TE[idx]] + TP[idx];
        SLOT_TOK[slot] = (int)(idx / 2); TS[idx] = slot;
    }
}
__device__ __forceinline__ void d_moe_gather(const float* H2, const int* SLOT_TOK, bf16_t* Xg, const int* META, int tile, long gtid, long gstride) {
    const long nrows = (long)META[0] * tile;
    for (long idx = gtid; idx < nrows * (DM / 4); idx += gstride) {
        const int j = (int)(idx % (DM / 4)) * 4; const long s = idx / (DM / 4); const int tok = SLOT_TOK[s];
        for (int q = 0; q < 4; ++q) Xg[s * DM + j + q] = tok >= 0 ? f2bf(H2[(size_t)tok * DM + j + q]) : (bf16_t)0;
    }
}
__device__ __forceinline__ void d_moe_act(const float* GU, float* ACT, bf16_t* ACTb, const int* META, int tile, long gtid, long gstride) {
    const long nrows = (long)META[0] * tile;
    for (long idx = gtid; idx < nrows * EFF; idx += gstride) {
        const int j = (int)(idx % EFF); const long s = idx / EFF;
        const float v = silu_f(GU[s * 2 * EFF + j]) * GU[s * 2 * EFF + EFF + j]; if (ACT) ACT[idx] = v; if (ACTb) ACTb[idx] = f2bf(v);
    }
}
__device__ __forceinline__ void d_moe_combine(float* X, const float* Y, const int* TS, const float* TG, const float* MOD, int l, int row_lo, long gtid, long gstride) {
    for (long idx = (long)row_lo * DM + gtid; idx < (long)NTOK * DM; idx += gstride) {
        const int j = (int)(idx % DM), r = (int)(idx / DM);
        const float v = TG[r * 2] * Y[(size_t)TS[r * 2] * DM + j] + TG[r * 2 + 1] * Y[(size_t)TS[r * 2 + 1] * DM + j];
        X[idx] += MODV(MOD, l, cond_of_row(r), 5)[j] * v;
    }
}
__device__ __forceinline__ void d_final(const In& I, const float* X, float* out, long gtid, long gstride) {
    for (long r = NCTX + gtid; r < NTOK; r += gstride) {
        const float* xr = X + (size_t)r * DM; float ss = 0.f;
        for (int j = 0; j < DM; ++j) ss += xr[j] * xr[j];
        const float rs = 1.0f / sqrtf(ss / DM + NORM_EPS);
        for (int j = 0; j < DM; ++j) out[(size_t)(r - NCTX) * DM + j] = xr[j] * rs * I.final_g[j];
    }
}

struct GemmArgs { const float* A; int lda; const int* gather; const float* B; int ldb; size_t strideB; float* C; int ldc; int M, N, K; const int* META; };
#ifdef HOST_EMU
__device__ __forceinline__ void d_gemm(const GemmArgs& g, void* smem, int bid, int nblk) {
    (void)smem; (void)bid; (void)nblk;
    const int M = g.META ? g.META[0] * MOE_TILE : g.M;
    for (int m = 0; m < M; ++m) {
        const float* B = g.B + (g.META ? (size_t)g.META[64 + m / MOE_TILE] * g.strideB : 0);
        const int src = g.gather ? g.gather[m] : m;
        for (int n = 0; n < g.N; ++n) { double acc = 0;
            if (src >= 0) for (int k = 0; k < g.K; ++k) acc += (double)g.A[(size_t)src * g.lda + k] * B[(size_t)k * g.ldb + n];
            g.C[(size_t)m * g.ldc + n] = (float)acc; }
    }
}
#else
__device__ __forceinline__ void d_gemm(const GemmArgs& g, void* smem, int bid, int nblk) {
    float* As = (float*)smem;
    float* Bs = As + 16 * 132;
    const int tid = threadIdx.x, tx = tid % 16, ty = tid / 16;
    const int M = g.META ? g.META[0] * MOE_TILE : g.M;
    const int ntm = (M + 127) / 128, ntn = (g.N + 63) / 64;
    for (int tile = bid; tile < ntm * ntn; tile += nblk) {
        const int tm = tile / ntn, tn = tile % ntn, m0 = tm * 128, n0 = tn * 64;
        const float* B = g.B + (g.META ? (size_t)g.META[64 + tm] * g.strideB : 0);
        float acc[4][4];
        for (int i = 0; i < 4; ++i) for (int j = 0; j < 4; ++j) acc[i][j] = 0.f;
        for (int k0 = 0; k0 < g.K; k0 += 16) {
            for (int q = tid; q < 128 * 16; q += 512) { const int mm = q / 16, kk = q % 16; const int m = m0 + mm; float v = 0.f;
                if (m < M && k0 + kk < g.K) { const int src = g.gather ? g.gather[m] : m; if (src >= 0) v = g.A[(size_t)src * g.lda + k0 + kk]; }
                As[kk * 132 + mm] = v; }
            for (int q = tid; q < 16 * 64; q += 512) { const int kk = q / 64, nn = q % 64; float v = 0.f;
                if (k0 + kk < g.K && n0 + nn < g.N) v = B[(size_t)(k0 + kk) * g.ldb + n0 + nn];
                Bs[kk * 64 + nn] = v; }
            __syncthreads();
#pragma unroll
            for (int kk = 0; kk < 16; ++kk) { float a[4], b[4];
#pragma unroll
                for (int i = 0; i < 4; ++i) a[i] = As[kk * 132 + ty * 4 + i];
#pragma unroll
                for (int j = 0; j < 4; ++j) b[j] = Bs[kk * 64 + tx * 4 + j];
#pragma unroll
                for (int i = 0; i < 4; ++i)
#pragma unroll
                    for (int j = 0; j < 4; ++j) acc[i][j] += a[i] * b[j]; }
            __syncthreads();
        }
        for (int i = 0; i < 4; ++i) { const int m = m0 + ty * 4 + i; if (m >= M) continue;
            for (int j = 0; j < 4; ++j) { const int n = n0 + tx * 4 + j; if (n < g.N) g.C[(size_t)m * g.ldc + n] = acc[i][j]; } }
    }
}
#endif
}
#ifndef EARLY_IN
#define EARLY_IN 0
#endif
#ifndef EARLY_OUT
#define EARLY_OUT 0
#endif
#ifndef NO_DEMOTE
#define NO_DEMOTE 0
#endif
#ifndef AUX_D
#define AUX_D 16
#endif

#ifndef PR_GEMM
#define PR_GEMM 1
#endif
#ifndef PR_WCVT
#define PR_WCVT 1
#endif
#ifndef PR_RET
#define PR_RET 1
#endif
#ifndef PR_KV
#define PR_KV 1
#endif
#ifndef PR_OUT
#define PR_OUT 1
#endif
#ifndef PR_SCAN
#define PR_SCAN 1
#endif
#ifndef PR_S5
#define PR_S5 1
#endif
#ifndef PR_ROUTE
#define PR_ROUTE 1
#endif
#ifndef PR_NORM
#define PR_NORM 1
#endif
#ifndef PR_BAR
#define PR_BAR 0
#endif
#ifndef PR_PREP
#define PR_PREP 1
#endif
#ifndef PR_FIN
#define PR_FIN 1
#endif
namespace nv {
constexpr size_t al256(size_t x) { return (x + 255) & ~(size_t)255; }
constexpr size_t cmax(size_t a, size_t b) { return a > b ? a : b; }
constexpr int NRLc = NEG + NE;
constexpr size_t OFF_CTL = 0, SZ_CTL = 4096;
constexpr size_t OFF_BAR = OFF_CTL + SZ_CTL, SZ_BAR = 16384;
constexpr size_t OFF_MOD = OFF_BAR + SZ_BAR, SZ_MOD = al256((size_t)NL * NCOND * NMOD * DM * 4);
constexpr size_t OFF_PART = OFF_MOD + SZ_MOD, SZ_PART = al256((size_t)(DM / 128) * NL * NCOND * NMOD * DM * 4);
constexpr size_t OFF_RWT = OFF_PART + SZ_PART, SZ_RWT = al256((size_t)NL * NRLc * DM * 4);
constexpr size_t OFF_LAMP = OFF_RWT + SZ_RWT, SZ_LAMP = al256((size_t)NL * 2 * NG * 17 * SP * 2 * 4);
constexpr size_t OFF_BBC = OFF_LAMP + SZ_LAMP, SZ_BBC = al256((size_t)NL * 2 * NG * SP * SG * 2 * 4);
constexpr size_t OFF_KTAU = OFF_BBC + SZ_BBC, SZ_KTAU = al256((size_t)NL * 2 * NG * 16 * SG * SG * 4);
constexpr size_t OFF_MINT = OFF_KTAU + SZ_KTAU, SZ_MINT = al256((size_t)NL * 2 * NG * 128 * 256 * 2);
constexpr size_t OFF_MOUT = OFF_MINT + SZ_MINT, SZ_MOUT = SZ_MINT;
constexpr size_t OFF_KTOT = OFF_MOUT + SZ_MOUT, SZ_KTOT = al256((size_t)NL * NG * 256 * 256 * 2);
constexpr size_t OFF_TE = OFF_KTOT + SZ_KTOT, SZ_T2I = al256((size_t)NTOK * 2 * 4);
constexpr size_t OFF_TP = OFF_TE + SZ_T2I, OFF_TG = OFF_TP + SZ_T2I, OFF_TS = OFF_TG + SZ_T2I, OFF_RSTD = OFF_TS + SZ_T2I;
constexpr size_t OFF_HIST = OFF_RSTD + SZ_T2I, SZ_HIST = al256((size_t)1024 * NE * 4);
constexpr size_t OFF_WP = OFF_HIST + SZ_HIST, SZ_WP = al256((size_t)NL * NCOND * ((NEG + NE + 15) / 16) * 16 * DM * 4);
constexpr size_t OFF_CB = OFF_WP + SZ_WP, SZ_CB = al256((size_t)NL * NCOND * ((NEG + NE + 15) / 16) * 16 * 4);
constexpr size_t OFF_X = OFF_CB + SZ_CB, SZ_X = al256((size_t)NTOK * DM * 4);
constexpr size_t OFF_QKVB = OFF_X + SZ_X, SZ_QKVB = al256((size_t)NTOK * INW * 2);
constexpr size_t OFF_ROPE = OFF_QKVB + SZ_QKVB, SZ_ROPE = al256((size_t)SQ * (HD / 2) * 2 * 4);
constexpr size_t OFF_MIXB = OFF_ROPE + SZ_ROPE, SZ_MIXB = al256((size_t)NTOK * DM * 2);
constexpr size_t OFF_ZB = OFF_MIXB + SZ_MIXB, SZ_ZB = al256((size_t)NTOK * SW * 2);
constexpr size_t OFF_HB = OFF_ZB + SZ_ZB, SZ_HB = SZ_MIXB;
constexpr size_t OFF_WIN = OFF_HB + SZ_HB, SZ_WIN = al256((size_t)INW * DM * 2);
constexpr size_t OFF_WGLU = OFF_WIN + SZ_WIN, SZ_WGLU = al256((size_t)SW * SW * 2);
constexpr size_t OFF_WOUT = OFF_WGLU + SZ_WGLU, SZ_WOUT = al256((size_t)DM * DM * 2);
constexpr size_t OFF_WGU = OFF_WOUT + SZ_WOUT, SZ_WGU = al256((size_t)NE * 2 * EFF * DM * 2);
constexpr size_t OFF_WD = OFF_WGU + SZ_WGU, SZ_WD = al256((size_t)NE * DM * EFF * 2);
constexpr size_t SZ_WALL = (EARLY_IN + EARLY_OUT > 0) ? OFF_WD + SZ_WD - OFF_WIN : 0;
constexpr size_t OFF_BIG = OFF_WD + SZ_WD + SZ_WALL;
#define WOFF(l) ((size_t)((l) & 1) * SZ_WALL)
constexpr size_t SZ_KV = al256((size_t)2 * NB * NH * NCH * HD * HD * 4);
constexpr size_t OFF_KVT = OFF_BIG, OFF_STT = OFF_KVT + SZ_KV, SZ_STT = al256((size_t)2 * NB * NH * NCH * HD * HD * 2);
constexpr size_t OFF_XG = OFF_BIG, SZ_XG = al256((size_t)MOE_CAP * DM * 2);
constexpr size_t OFF_ACTB = OFF_XG + SZ_XG, SZ_ACTB = al256((size_t)MOE_CAP * EFF * 2);
constexpr size_t OFF_YB = OFF_ACTB + SZ_ACTB, SZ_YB = al256((size_t)MOE_CAP * DM * 2);
constexpr size_t WS_NEED = cmax(OFF_STT + SZ_STT, OFF_YB + SZ_YB);

struct Params { In I; float* out; unsigned char* ws; };
}

#ifndef HOST_EMU
#ifdef HOST_EMU2
#define LAS
#endif
#define XB_TMO      128
#define XB_XCNT(j)  (256  + 64 * (j))
#define XB_XSUB(j)  (1280 + 64 * (j))
#define XB_XGEN(j)  (2304 + 64 * (j))
#define XB_TOP      3328
#define XB_TOPGEN   3392
#define XCD_BAR_WORDS 3456
#define XB_SPIN_CAP (1u << 18)
#ifndef LAS
#define LAS __attribute__((address_space(3)))
#endif

__device__ __forceinline__ unsigned xb_ld(unsigned* p)              { return __hip_atomic_load(p, __ATOMIC_RELAXED, __HIP_MEMORY_SCOPE_AGENT); }
__device__ __forceinline__ unsigned xb_add(unsigned* p, unsigned v) { return __hip_atomic_fetch_add(p, v, __ATOMIC_RELAXED, __HIP_MEMORY_SCOPE_AGENT); }
__device__ __forceinline__ unsigned xb_xcc_id() { return (unsigned)__builtin_amdgcn_s_getreg((3 << 11) | 20) & 0xFu; }
#define XB_SPIN(cond, bar) do { unsigned _sp = 0; while (cond) { __builtin_amdgcn_s_sleep(1); \
    if ((++_sp & 255u) == 0u) { if (xb_ld(&(bar)[XB_TMO])) break; if (_sp > XB_SPIN_CAP) { atomicAdd(&(bar)[XB_TMO], 1u); break; } } } } while (0)

struct XcdBarrier {
    unsigned* bar; unsigned x;
    volatile LAS unsigned* st;
};

__device__ __forceinline__ XcdBarrier xcd_barrier_post(unsigned* bar, volatile LAS unsigned* st) {
    XcdBarrier b; b.bar = bar; b.x = xb_xcc_id(); b.st = st;
    if (threadIdx.x == 0) (void)xb_add(&bar[XB_XCNT(b.x)], 1u);
    return b;
}
__device__ __forceinline__ void xcd_barrier_complete(unsigned* bar, unsigned x, unsigned& nloc, unsigned& nx) {
    const unsigned G = gridDim.x * gridDim.y * gridDim.z;
    unsigned sum, cnt, mine, sp = 0u;
    for (;;) {
        sum = 0u; cnt = 0u; mine = 0u;
#pragma unroll
        for (unsigned j = 0; j < 16; ++j) { const unsigned c = xb_ld(&bar[XB_XCNT(j)]); sum += c; cnt += (c > 0u) ? 1u : 0u; mine = (j == x) ? c : mine; }
        if (sum == G) break;
        __builtin_amdgcn_s_sleep(1);
        if ((++sp & 255u) == 0u) { if (xb_ld(&bar[XB_TMO])) break; if (sp > XB_SPIN_CAP) { atomicAdd(&bar[XB_TMO], 1u); break; } }
    }
    nloc = mine > 0u ? mine : 1u; nx = cnt > 0u ? cnt : 1u;
}

__device__ __forceinline__ void xcd_barrier(const XcdBarrier& b) {
    asm volatile("s_waitcnt vmcnt(0)" ::: "memory");
    __syncthreads();
    if (threadIdx.x == 0) {
        unsigned* bar = b.bar;
        __builtin_amdgcn_s_waitcnt(0);
        unsigned nloc = b.st[0], nx = b.st[1];
        if (nloc == 0u) { xcd_barrier_complete(bar, b.x, nloc, nx); b.st[0] = nloc; b.st[1] = nx; }
        const unsigned old = xb_add(&bar[XB_XSUB(b.x)], 1u);
        const unsigned gen = old / nloc;
        if (old + 1u == (gen + 1u) * nloc) {
            __builtin_amdgcn_fence(__ATOMIC_RELEASE, "agent");
            asm volatile("s_waitcnt vmcnt(0)" ::: "memory");
            const unsigned og = xb_add(&bar[XB_TOP], 1u);
            const unsigned tg = og / nx;
#ifdef BAR_TOPGEN
            if (og + 1u == (tg + 1u) * nx) xb_add(&bar[XB_TOPGEN], 1u);
            else XB_SPIN(xb_ld(&bar[XB_TOPGEN]) == tg, bar);
#else
            if (og + 1u != (tg + 1u) * nx) XB_SPIN(xb_ld(&bar[XB_TOP]) < (tg + 1u) * nx, bar);
#endif
            __builtin_amdgcn_fence(__ATOMIC_ACQUIRE, "agent");
            xb_add(&bar[XB_XGEN(b.x)], 1u);
            asm volatile("s_waitcnt vmcnt(0)" ::: "memory");
        } else {
#ifdef BAR_LOCALGEN
            XB_SPIN(xb_ld(&bar[XB_XGEN(b.x)]) == gen, bar);
#else
            XB_SPIN(xb_ld(&bar[XB_TOP]) < (gen + 1u) * nx, bar);
#endif
            __builtin_amdgcn_fence(__ATOMIC_ACQUIRE, "agent");
            asm volatile("s_waitcnt vmcnt(0)" ::: "memory");
        }
    }
    __syncthreads();
}


#ifndef HOST_EMU2
#define GAS __attribute__((address_space(1)))
#else
#define GAS
#endif
typedef unsigned short bf16;
typedef unsigned v4u __attribute__((ext_vector_type(4)));
#ifdef HOST_EMU2
#define LDS_WAIT() do { emu::wave_sync(); emu::set_ids(); } while (0)
#else
#define LDS_WAIT() asm volatile("s_waitcnt lgkmcnt(0)" ::: "memory")
#endif
#ifdef HOST_EMU2
__device__ __forceinline__ unsigned f2bf_u(float f) { unsigned u = __builtin_bit_cast(unsigned, f); return (u + 0x7fffu + ((u >> 16) & 1u)) >> 16; }
#else
__device__ __forceinline__ unsigned f2bf_u(float f) { return (unsigned)__builtin_bit_cast(unsigned short, (__bf16)f); }
#endif
#ifdef HOST_EMU2
__device__ __forceinline__ unsigned pk2(float lo, float hi) { return f2bf_u(lo) | (f2bf_u(hi) << 16); }
#else
typedef __bf16 bf16x2_hw __attribute__((ext_vector_type(2)));
__device__ __forceinline__ unsigned pk2(float lo, float hi) { bf16x2_hw v; v.x = (__bf16)lo; v.y = (__bf16)hi; return __builtin_bit_cast(unsigned, v); }
#endif
namespace pg8 {
#define PG8_LAS __attribute__((address_space(3)))
typedef unsigned short bf16_t;
typedef short bf16x8 __attribute__((ext_vector_type(8)));
typedef float f32x4 __attribute__((ext_vector_type(4)));
typedef unsigned u32x4 __attribute__((ext_vector_type(4)));
constexpr int BM = 256, BK = 64, HALF = 128, HTB = HALF * BK * 2  , STAGE_BYTES = 8 * HTB, NXCD = 8, WGM = 8;

__host__ __device__ __forceinline__ int lds_byte(int r, int c) { const int st = (r >> 4) * 2 + (c >> 5), rr = r & 15, cc = c & 31, ob = rr * 64 + cc * 2; return st * 1024 + (ob ^ (((ob >> 9) & 1) << 5)); }
__host__ __device__ __forceinline__ void stage_rc(int b, int& R, int& C) { const int st = b / 1024, sb = b % 1024, swz = sb ^ (((sb >> 9) & 1) << 5); R = (st >> 1) * 16 + swz / 64; C = (st & 1) * 32 + (swz % 64) / 2; }
__host__ __device__ __forceinline__ int perm32(int rho) { const int n = rho >> 4, i = rho & 15; return 8 * (i >> 2) + 4 * n + (i & 3); }

struct Unit { int pm, pn, half; };
struct Gemm { const bf16_t* A; const bf16_t* Bt; int M, N, K; };

struct StaticOrder {
    static constexpr bool DYN = false, LAZY = false;
    int nM, nN, nwg, G, c, rep;
    __host__ __device__ void init(int M, int N, int G_, int c_) { nM = M / BM; nN = N / BM; nwg = nM * nN; G = G_; c = c_; rep = PR_GEMM; }
    __host__ __device__ bool next(int i, Unit& u) const {
        long L = (long)i * G + c; int part = -1;
        if (rep == 1) { const int nfull = (nwg / G) * G, r = nwg - nfull;
            if (r > 0 && 2 * r <= G && L >= nfull) { if (L >= nfull + 2 * r) return false; part = (int)((L - nfull) & 1); L = nfull + (L - nfull) / 2; } }
        if (L >= (long)nwg * rep) return false;
        int wgid = (int)(L % nwg); { const int q = nwg / NXCD, r = nwg % NXCD, xcd = wgid % NXCD, off = wgid / NXCD; wgid = (xcd < r ? xcd * (q + 1) : r * (q + 1) + (xcd - r) * q) + off; }
        const int nig = WGM * nN, gid = wgid / nig, fm = gid * WGM, gsz = (nM - fm) < WGM ? (nM - fm) : WGM;
        u.pm = 2 * (fm + ((wgid % nig) % gsz)) + (part > 0 ? 1 : 0); u.pn = (wgid % nig) / gsz; u.half = part >= 0 ? 1 : 0; return true;
    }
    __device__ __forceinline__ void a_ready(const Unit&) const {}
    __device__ __forceinline__ void done(const Unit&) const {}
};

#ifdef HOST_EMU2
__device__ __forceinline__ unsigned cvt_pk_bf16(float lo, float hi) { return pk2(lo, hi); }
#else
__device__ __forceinline__ unsigned cvt_pk_bf16(float lo, float hi) { unsigned r; asm volatile("v_cvt_pk_bf16_f32 %0, %1, %2" : "=v"(r) : "v"(lo), "v"(hi)); return r; }
#endif
template <class Epi, class Sched, bool ALIGN_EPI = false, bool SP2 = false, int AUXA = 0>
__device__ __forceinline__ void gemm_phase(PG8_LAS unsigned char* lds, const Gemm g, const Sched& S, const Epi& E, const int tid) {
    const int wid = __builtin_amdgcn_readfirstlane(tid >> 6), lane = tid & 63, wr = wid >> 2, wc = wid & 3, fr = lane & 15, fq = lane >> 4;
    const int K = g.K, nt = K / BK;
    unsigned voffA[2], voffB[2];
#pragma unroll
    for (int i = 0; i < 2; ++i) { int R, C; stage_rc(tid * 16 + i * 8192, R, C); const int Rb = Epi::PERM ? ((R & ~31) + perm32(R & 31)) : R;
        voffA[i] = (unsigned)(R * K + C) * 2u; voffB[i] = (unsigned)(Rb * K + C) * 2u; }
    const size_t kstep = (size_t)(BK * 2);
    const size_t hstep = (size_t)HALF * K * 2;
    const size_t tstep = 2 * hstep;
    const unsigned ldsw = (unsigned)wid * 1024u;
    const int aoff = lds_byte(wr * 64 + fr, fq * 8), boff = lds_byte(wc * 32 + fr, fq * 8);
#define PG8_SA(b, h) (((b) * 2 + (h)) * HTB)
#define PG8_SB(b, h) ((4 + (b) * 2 + (h)) * HTB)
#define PG8_STAGE(bufoff, gbase, voff, aux) do { _Pragma("unroll") for (int _i = 0; _i < 2; ++_i) \
        __builtin_amdgcn_global_load_lds((const unsigned*)((const char*)(gbase) + (voff)[_i]), (PG8_LAS unsigned*)(lds + (bufoff) + ldsw + _i * 8192), 16, 0, aux); } while (0)
#define PG8_LDA(dst, b, h) do { _Pragma("unroll") for (int m = 0; m < 4; ++m) _Pragma("unroll") for (int k = 0; k < 2; ++k) dst[m][k] = *(const PG8_LAS bf16x8*)(lds + PG8_SA(b, h) + aoff + m * 2048 + k * 1024); } while (0)
#define PG8_LDB(dst, b, h) do { _Pragma("unroll") for (int n = 0; n < 2; ++n) _Pragma("unroll") for (int k = 0; k < 2; ++k) dst[n][k] = *(const PG8_LAS bf16x8*)(lds + PG8_SB(b, h) + boff + n * 2048 + k * 1024); } while (0)
#define PG8_MMA(ai, bj, At, Bt) do { __builtin_amdgcn_s_setprio(1); _Pragma("unroll") for (int m = 0; m < 4; ++m) _Pragma("unroll") for (int n = 0; n < 2; ++n) _Pragma("unroll") for (int k = 0; k < 2; ++k) \
        acc[ai][bj][m][n] = __builtin_amdgcn_mfma_f32_16x16x32_bf16(Bt[n][k], At[m][k], acc[ai][bj][m][n], 0, 0, 0); __builtin_amdgcn_s_setprio(0); } while (0)
#define PG8_WAIT_V(n) asm volatile("s_waitcnt vmcnt(" #n ")" ::: "memory")
#define PG8_WAIT_L(n) asm volatile("s_waitcnt lgkmcnt(" #n ")" ::: "memory")
#define PG8_BAR __builtin_amdgcn_s_barrier()
#define PG8_SCHED __builtin_amdgcn_sched_barrier(0)
    Unit cur, nxt; int ui = 0; int pend_pm = -1, pend_half = 0; (void)pend_pm; (void)pend_half;
    if constexpr (Sched::DYN) { S.prefetch(0, wid); __syncthreads(); }
    if (!S.next(0, cur)) return;
    f32x4 acc[2][2][4][2];
#pragma unroll
    for (int a = 0; a < 2; ++a)
#pragma unroll
        for (int b = 0; b < 2; ++b)
#pragma unroll
            for (int m = 0; m < 4; ++m)
#pragma unroll
                for (int n = 0; n < 2; ++n) acc[a][b][m][n] = (f32x4){0.f, 0.f, 0.f, 0.f};
    bf16x8 At[4][2], B0[2][2], B1[2][2];
    const char* cA = (const char*)g.A + (size_t)cur.pm * hstep; const char* cB = (const char*)g.Bt + (size_t)cur.pn * tstep;
    S.a_ready(cur);
    if constexpr (SP2) {
        PG8_STAGE(PG8_SB(0, 0), cB, voffB, 0); PG8_STAGE(PG8_SB(0, 1), cB + hstep, voffB, 0); PG8_STAGE(PG8_SA(0, 0), cA, voffA, AUXA); PG8_STAGE(PG8_SA(0, 1), cA + hstep, voffA, AUXA);
        if (wr == 1) PG8_BAR;
        PG8_WAIT_V(2); PG8_BAR;
        PG8_STAGE(PG8_SB(1, 0), cB + kstep, voffB, 0); PG8_STAGE(PG8_SA(1, 0), cA + kstep, voffA, AUXA); PG8_STAGE(PG8_SB(1, 1), cB + hstep + kstep, voffB, 0);
        PG8_WAIT_V(6); PG8_BAR;
    } else {
        PG8_STAGE(PG8_SB(0, 0), cB, voffB, 0); PG8_STAGE(PG8_SA(0, 0), cA, voffA, AUXA); PG8_STAGE(PG8_SB(0, 1), cB + hstep, voffB, 0); PG8_STAGE(PG8_SA(0, 1), cA + hstep, voffA, AUXA);
        if (wr == 1) PG8_BAR;
        PG8_WAIT_V(4); PG8_BAR;
        PG8_STAGE(PG8_SB(1, 0), cB + kstep, voffB, 0); PG8_STAGE(PG8_SA(1, 0), cA + kstep, voffA, AUXA); PG8_STAGE(PG8_SB(1, 1), cB + hstep + kstep, voffB, 0);
        PG8_WAIT_V(6); PG8_BAR;
    }
    for (;;) {
        bool has_next; const char* nA; const char* nB;
        if constexpr (!Sched::DYN) { has_next = S.next(ui + 1, nxt); nA = has_next ? (const char*)g.A + (size_t)nxt.pm * hstep : cA; nB = has_next ? (const char*)g.Bt + (size_t)nxt.pn * tstep : cB; }
        int tk = 0;
        if constexpr (Sched::DYN) { if (nt >= 8) tk = S.take(wid); else S.prefetch(ui + 1, wid); has_next = false; nA = cA; nB = cB; }
        for (int t = 0; t < nt; t += 2) {
            const bool last = (t == nt - 2);
            if constexpr (Sched::DYN) { if (nt >= 8 && t == 2) S.publish(ui + 1, tk, wid); }
            if constexpr (Sched::LAZY) { if (t == 2 && pend_pm >= 0) { PG8_WAIT_V(0); S.done_late(pend_pm, pend_half); pend_pm = -1; } }
            if constexpr (Sched::DYN) { if (last) { has_next = S.next(ui + 1, nxt); if (has_next) { nA = (const char*)g.A + (size_t)nxt.pm * hstep; nB = (const char*)g.Bt + (size_t)nxt.pn * tstep; } } }
            const char* a1 = cA + (size_t)(t + 1) * kstep;
            const char* a2 = last ? nA : cA + (size_t)(t + 2) * kstep; const char* b2 = last ? nB : cB + (size_t)(t + 2) * kstep;
            const char* a3 = a2 + kstep; const char* b3 = b2 + kstep;
            if (last && has_next) S.a_ready(nxt);
            if constexpr (SP2) {
            PG8_LDB(B0, 0, 0); PG8_LDB(B1, 0, 1); PG8_SCHED; PG8_LDA(At, 0, 0); PG8_STAGE(PG8_SA(1, 1), a1 + hstep, voffA, AUXA);
            PG8_WAIT_V(8); PG8_WAIT_L(0); PG8_BAR; PG8_MMA(0, 0, At, B0); PG8_MMA(0, 1, At, B1); PG8_BAR; PG8_SCHED;
            if (!cur.half) PG8_LDA(At, 0, 1); PG8_STAGE(PG8_SB(0, 0), b2, voffB, 0); PG8_STAGE(PG8_SB(0, 1), b2 + hstep, voffB, 0); PG8_STAGE(PG8_SA(0, 0), a2, voffA, AUXA);
            PG8_WAIT_V(8); PG8_WAIT_L(0); PG8_BAR; if (!cur.half) { PG8_MMA(1, 0, At, B0); PG8_MMA(1, 1, At, B1); } PG8_BAR; PG8_SCHED;
            PG8_LDB(B0, 1, 0); PG8_LDB(B1, 1, 1); PG8_SCHED; PG8_LDA(At, 1, 0); PG8_STAGE(PG8_SA(0, 1), a2 + hstep, voffA, AUXA);
            PG8_WAIT_V(8); PG8_WAIT_L(0); PG8_BAR; PG8_MMA(0, 0, At, B0); PG8_MMA(0, 1, At, B1); PG8_BAR; PG8_SCHED;
            if (!cur.half) PG8_LDA(At, 1, 1); PG8_STAGE(PG8_SB(1, 0), b3, voffB, 0); PG8_STAGE(PG8_SB(1, 1), b3 + hstep, voffB, 0); PG8_STAGE(PG8_SA(1, 0), a3, voffA, AUXA);
            PG8_WAIT_V(8); PG8_WAIT_L(0); PG8_BAR; if (!cur.half) { PG8_MMA(1, 0, At, B0); PG8_MMA(1, 1, At, B1); } PG8_BAR; PG8_SCHED;
            } else {
            PG8_LDB(B0, 0, 0); PG8_SCHED; PG8_LDA(At, 0, 0); PG8_STAGE(PG8_SA(1, 1), a1 + hstep, voffA, AUXA);
            PG8_WAIT_L(8); PG8_BAR; PG8_WAIT_L(0); PG8_MMA(0, 0, At, B0); PG8_BAR; PG8_SCHED;
            PG8_LDB(B1, 0, 1); PG8_STAGE(PG8_SB(0, 0), b2, voffB, 0);
            PG8_BAR; PG8_WAIT_L(0); PG8_MMA(0, 1, At, B1); PG8_BAR;
            PG8_LDA(At, 0, 1); PG8_STAGE(PG8_SA(0, 0), a2, voffA, AUXA);
            PG8_BAR; PG8_WAIT_L(0); PG8_MMA(1, 0, At, B0); PG8_BAR; PG8_SCHED;
            PG8_STAGE(PG8_SB(0, 1), b2 + hstep, voffB, 0);
            PG8_WAIT_V(6); PG8_BAR; PG8_MMA(1, 1, At, B1); PG8_BAR;
            PG8_LDB(B0, 1, 0); PG8_SCHED; PG8_LDA(At, 1, 0); PG8_STAGE(PG8_SA(0, 1), a2 + hstep, voffA, AUXA);
            PG8_WAIT_L(8); PG8_BAR; PG8_WAIT_L(0); PG8_MMA(0, 0, At, B0); PG8_BAR; PG8_SCHED;
            PG8_LDB(B1, 1, 1); PG8_STAGE(PG8_SB(1, 0), b3, voffB, 0);
            PG8_BAR; PG8_WAIT_L(0); PG8_MMA(0, 1, At, B1); PG8_BAR;
            PG8_LDA(At, 1, 1); PG8_STAGE(PG8_SA(1, 0), a3, voffA, AUXA);
            PG8_BAR; PG8_WAIT_L(0); PG8_MMA(1, 0, At, B0); PG8_BAR; PG8_SCHED;
            PG8_STAGE(PG8_SB(1, 1), b3 + hstep, voffB, 0);
            PG8_WAIT_V(6); PG8_BAR; PG8_MMA(1, 1, At, B1); PG8_BAR;
            }
        }
        if constexpr (ALIGN_EPI) { if (wr == 0) PG8_BAR; }
        if constexpr (!Epi::AFTER_DRAIN) { E(acc, cur, wr, wc, fr, fq); S.done(cur); }
        if constexpr (Sched::LAZY) { pend_pm = __builtin_amdgcn_readfirstlane(cur.pm); pend_half = __builtin_amdgcn_readfirstlane(cur.half); }
        if (!has_next) break;
#pragma unroll
        for (int a = 0; a < 2; ++a)
#pragma unroll
            for (int b = 0; b < 2; ++b)
#pragma unroll
                for (int m = 0; m < 4; ++m)
#pragma unroll
                    for (int n = 0; n < 2; ++n) acc[a][b][m][n] = (f32x4){0.f, 0.f, 0.f, 0.f};
        cur = nxt; cA = nA; cB = nB; ++ui;
        if constexpr (ALIGN_EPI) { if (wr == 1) PG8_BAR; }
    }
    PG8_WAIT_V(0);
    if constexpr (Sched::LAZY) { if (pend_pm >= 0) S.done_late(pend_pm, pend_half); }
    if constexpr (!ALIGN_EPI) { if (wr == 0) PG8_BAR; }
    PG8_BAR;
    if constexpr (Epi::AFTER_DRAIN) { E.fused(acc, cur, wr, wc, fr, fq, lds, wid, lane); S.done(cur); }
#undef PG8_SA
#undef PG8_SB
#undef PG8_STAGE
#undef PG8_LDA
#undef PG8_LDB
#undef PG8_MMA
#undef PG8_WAIT_V
#undef PG8_WAIT_L
#undef PG8_BAR
#undef PG8_SCHED
}
}
__device__ __forceinline__ void p0_transpose_item(const float* W, int K, int N, bf16* WT, int row_off, LAS float* scr, int item, int lane) {
    const int nblk = N / 32, kb = item / nblk, nb = item % nblk, k0 = 64 * kb, n0 = 32 * nb;
#pragma unroll 8
    for (int i = 0; i < 32; ++i) { const int kk = 2 * i + (lane >> 5); scr[kk * 33 + (lane & 31)] = __builtin_nontemporal_load(&W[(size_t)(k0 + kk) * N + n0 + (lane & 31)]); }
    LDS_WAIT(); asm volatile("" ::: "memory");
    const int c = lane & 7;
#pragma unroll
    for (int j = 0; j < 4; ++j) { const int n = (lane >> 3) + 8 * j; const LAS float* s = scr + (8 * c) * 33 + n;
        v4u o; o.x = pk2(s[0 * 33], s[1 * 33]); o.y = pk2(s[2 * 33], s[3 * 33]); o.z = pk2(s[4 * 33], s[5 * 33]); o.w = pk2(s[6 * 33], s[7 * 33]);
        __builtin_nontemporal_store(o, (GAS v4u*)(WT + (size_t)(row_off + n0 + n) * K + k0 + 8 * c)); }
    LDS_WAIT(); asm volatile("" ::: "memory");
}
namespace nv {
typedef float f4 __attribute__((ext_vector_type(4)));
typedef unsigned u2v __attribute__((ext_vector_type(2)));
typedef unsigned u4v __attribute__((ext_vector_type(4)));
typedef short s8v __attribute__((ext_vector_type(8)));
__device__ __forceinline__ pg8::f32x4 mfma16(const s8v a, const s8v b, const pg8::f32x4 c) { return __builtin_amdgcn_mfma_f32_16x16x32_bf16(a, b, c, 0, 0, 0); }
constexpr int ROWV = DM / 256;
constexpr int NRL = NEG + NE;
constexpr int AD_KS = 128;
constexpr int AD_NKS = DM / AD_KS;
#ifdef HOST_EMU2
#define WAVE_SYNC() do { emu::wave_sync(); emu::set_ids(); } while (0)
#else
#define WAVE_SYNC() __builtin_amdgcn_wave_barrier()
#endif
template <int CTRL> __device__ __forceinline__ float dpp_f(float v) { return __builtin_bit_cast(float, __builtin_amdgcn_update_dpp(0, __builtin_bit_cast(int, v), CTRL, 0xf, 0xf, true)); }
__device__ __forceinline__ float wave_sum(float v) {
    v += dpp_f<0xB1>(v); v += dpp_f<0x4E>(v); v += dpp_f<0x141>(v); v += dpp_f<0x140>(v);
    const int iv = __builtin_bit_cast(int, v);
    return (__builtin_bit_cast(float, __builtin_amdgcn_readlane(iv, 0)) + __builtin_bit_cast(float, __builtin_amdgcn_readlane(iv, 16))) +
           (__builtin_bit_cast(float, __builtin_amdgcn_readlane(iv, 32)) + __builtin_bit_cast(float, __builtin_amdgcn_readlane(iv, 48)));
}
__device__ __forceinline__ float bf2f(unsigned short b) { return __builtin_bit_cast(float, ((unsigned)b) << 16); }
__device__ __forceinline__ float bflo(unsigned w) { return __builtin_bit_cast(float, w << 16); }
__device__ __forceinline__ float bfhi(unsigned w) { return __builtin_bit_cast(float, w & 0xffff0000u); }
__device__ __forceinline__ void row_load(const float* p, int lane, f4 (&v)[ROWV]) {
#pragma unroll
    for (int j = 0; j < ROWV; ++j) v[j] = *(const f4*)(p + 4 * lane + 256 * j);
}
__device__ __forceinline__ void row_load_bf16(const bf16_t* p, int lane, f4 (&v)[ROWV]) {
#pragma unroll
    for (int j = 0; j < ROWV; ++j) { const u2v w = *(const u2v*)(p + 4 * lane + 256 * j); v[j] = (f4){bflo(w.x), bfhi(w.x), bflo(w.y), bfhi(w.y)}; }
}
__device__ __forceinline__ float row_ss(const f4 (&v)[ROWV]) { float s = 0.f;
#pragma unroll
    for (int j = 0; j < ROWV; ++j) s += (v[j].x * v[j].x + v[j].y * v[j].y) + (v[j].z * v[j].z + v[j].w * v[j].w);
    return s; }
__device__ __forceinline__ void row_modulate(f4 (&v)[ROWV], float rstd, const float* g, const float* sc, const float* sh, int lane) {
#pragma unroll
    for (int j = 0; j < ROWV; ++j) { const int c = 4 * lane + 256 * j; const f4 gg = *(const f4*)(g + c), ss = *(const f4*)(sc + c), hh = *(const f4*)(sh + c);
        v[j] = v[j] * rstd * gg * (ss + 1.0f) + hh; }
}
__device__ __forceinline__ void row_store_bf16(bf16_t* o, const f4 (&v)[ROWV], int lane) {
#pragma unroll
    for (int j = 0; j < ROWV; ++j) { u2v w; w.x = pk2(v[j].x, v[j].y); w.y = pk2(v[j].z, v[j].w); *(u2v*)(o + 4 * lane + 256 * j) = w; }
}

__device__ __forceinline__ void ph_prep(const In& I, float* RWT, int gtid, int gstride) {
    for (int idx_ = gtid; idx_ < (NL * NRL * DM) * PR_PREP; idx_ += gstride) { const int idx = idx_ % (NL * NRL * DM);
        const int k = idx % DM, jj = (idx / DM) % NRL, l = idx / (DM * NRL);
        RWT[idx] = jj < NEG ? I.router_grp_w[((size_t)l * DM + k) * NEG + jj] : I.router_exp_w[((size_t)l * DM + k) * NE + (jj - NEG)];
    }
}
__device__ __forceinline__ void ph_adaln_part(const In& I, float* PART, const LAS float* scond, int gw, int ngw, int lane) {
    constexpr int NCH = NMOD * DM / 256;
    for (int it_ = gw; it_ < NL * NCH * AD_NKS * PR_WCVT; it_ += ngw) { const int it = it_ % (NL * NCH * AD_NKS);
        const int ks = it % AD_NKS, ch = (it / AD_NKS) % NCH, l = it / (AD_NKS * NCH);
        const float* w = I.ada_w + ((size_t)l * DM + (size_t)ks * AD_KS) * (NMOD * DM) + ch * 256 + 4 * lane;
        f4 acc[NCOND];
#pragma unroll
        for (int j = 0; j < NCOND; ++j) acc[j] = (f4){0.f, 0.f, 0.f, 0.f};
#pragma unroll 8
        for (int k = 0; k < AD_KS; ++k) { const f4 wv = __builtin_nontemporal_load((const f4*)(w + (size_t)k * (NMOD * DM)));
#pragma unroll
            for (int j = 0; j < NCOND; ++j) acc[j] += wv * scond[j * DM + ks * AD_KS + k]; }
#pragma unroll
        for (int j = 0; j < NCOND; ++j) { unsigned long long* pp = (unsigned long long*)(PART + (((size_t)ks * NL + l) * NCOND + j) * (NMOD * DM) + ch * 256 + 4 * lane);
            const float a0 = acc[j][0], a1 = acc[j][1], a2 = acc[j][2], a3 = acc[j][3];
            __hip_atomic_store(pp, (unsigned long long)__builtin_bit_cast(unsigned, a0) | ((unsigned long long)__builtin_bit_cast(unsigned, a1) << 32), __ATOMIC_RELAXED, __HIP_MEMORY_SCOPE_AGENT);
            __hip_atomic_store(pp + 1, (unsigned long long)__builtin_bit_cast(unsigned, a2) | ((unsigned long long)__builtin_bit_cast(unsigned, a3) << 32), __ATOMIC_RELAXED, __HIP_MEMORY_SCOPE_AGENT); }
    }
}
__device__ __forceinline__ void ph_adaln_reduce(const In& I, const float* PART, float* MOD, int gtid, int gstride) {
    for (int idx_ = gtid; idx_ < (NL * NCOND * NMOD * DM) * PR_PREP; idx_ += gstride) { const int idx = idx_ % (NL * NCOND * NMOD * DM);
        const int n = idx % (NMOD * DM), l = idx / (NCOND * NMOD * DM);
        float s = I.ada_b[(size_t)l * NMOD * DM + n];
        for (int ks = 0; ks < AD_NKS; ++ks) s += __builtin_bit_cast(float, __hip_atomic_load((const unsigned*)PART + (size_t)ks * NL * NCOND * NMOD * DM + idx, __ATOMIC_RELAXED, __HIP_MEMORY_SCOPE_AGENT));
        MOD[idx] = s;
    }
}

__device__ __forceinline__ void row_combine(f4 (&v)[ROWV], const bf16_t* Yb, const int* TS, const float* TG, const float* mod5, int r, int lane) {
    const int s0 = TS[2 * r], s1 = TS[2 * r + 1]; const float g0 = TG[2 * r], g1 = TG[2 * r + 1];
#pragma unroll
    for (int j = 0; j < ROWV; ++j) { const int c = 4 * lane + 256 * j;
        const u2v a = __builtin_nontemporal_load((const u2v*)(Yb + (size_t)s0 * DM + c)), b = __builtin_nontemporal_load((const u2v*)(Yb + (size_t)s1 * DM + c)); const f4 m = *(const f4*)(mod5 + c);
        f4 y; y.x = g0 * bflo(a.x) + g1 * bflo(b.x); y.y = g0 * bfhi(a.x) + g1 * bfhi(b.x); y.z = g0 * bflo(a.y) + g1 * bflo(b.y); y.w = g0 * bfhi(a.y) + g1 * bfhi(b.y);
        v[j] += m * y; }
}

template <int MODE>
__device__ __forceinline__ void ph_norm1(const In& I, int l, const float* MOD, bf16_t* X, const bf16_t* Yb, const int* TS, const float* TG, bf16_t* Hb, float* out, int gw, int ngw, int lane) {
    const int r0 = MODE == 2 ? NCTX : 0;
    for (int r_ = gw; r_ < (NTOK - r0) * (MODE == 0 ? PR_NORM : (MODE == 2 ? PR_FIN : 1)); r_ += ngw) { const int r = r0 + r_ % (NTOK - r0);
        f4 v[ROWV];
        if (MODE == 0) row_load(r < NCTX ? I.ctx + (size_t)r * DM : I.x + (size_t)(r - NCTX) * DM, lane, v); else row_load_bf16(X + (size_t)r * DM, lane, v);
        const int cj = cond_of_row(r);
        if (MODE >= 1) {
            row_combine(v, Yb, TS, TG, MODV(MOD, (MODE == 1 ? l - 1 : NL - 1), cj, 5), r, lane);
            if (MODE == 1) {
#pragma unroll
                for (int j = 0; j < ROWV; ++j) { u2v w; w.x = pk2(v[j].x, v[j].y); w.y = pk2(v[j].z, v[j].w); *(u2v*)(X + (size_t)r * DM + 4 * lane + 256 * j) = w; } }
        }
        const float rstd = 1.0f / sqrtf(wave_sum(row_ss(v)) * (1.0f / DM) + NORM_EPS);
        if (MODE == 2) {
#pragma unroll
            for (int j = 0; j < ROWV; ++j) { const int c = 4 * lane + 256 * j; __builtin_nontemporal_store(v[j] * rstd * *(const f4*)(I.final_g + c), (f4*)(out + (size_t)(r - NCTX) * DM + c)); }
        } else {
            row_modulate(v, rstd, I.norm1_g + (size_t)l * DM, MODV(MOD, l, cj, 1), MODV(MOD, l, cj, 0), lane);
            row_store_bf16(Hb + (size_t)r * DM, v, lane);
        }
    }
}
constexpr int NJT = (NRL + 15) / 16;
constexpr int RT_TG = 4;
constexpr int RT_LDS_PART = 0;
constexpr int RT_LDS_SSQ = RT_LDS_PART + 8 * RT_TG * 16 * NJT * 16 * 4;
constexpr int RT_LDS_TL = RT_LDS_SSQ + 8 * RT_TG * 4 * 16 * 4;
constexpr int RT_LDS_SE = RT_LDS_TL + 4 * 400;
static_assert(DM % 128 == 0 && RT_LDS_SE + 8192 <= 131072, "route LDS map");
__device__ __forceinline__ void route_rows(int nblk, int bid, int row_lo, int& rb0, int& rb1) {
    const int per = (NTOK - row_lo + nblk - 1) / nblk; rb0 = row_lo + bid * per; rb1 = rb0 + per < NTOK ? rb0 + per : NTOK; if (rb0 > NTOK) rb0 = NTOK;
}
__device__ __forceinline__ void ph_route_prep(const In& I, const float* MOD, const float* RWT, bf16_t* WPH, bf16_t* WPL, float* CB, int gtid, int gstride, int gw, int ngw, int lane) {
    for (int idx = gtid; idx < NL * NCOND * NJT * 16 * (DM / 4); idx += gstride) {
        const int k4 = idx % (DM / 4), jj = (idx / (DM / 4)) % (NJT * 16), cj = (idx / ((DM / 4) * NJT * 16)) % NCOND, l = idx / ((DM / 4) * NJT * 16 * NCOND);
        f4 v = (f4){0.f, 0.f, 0.f, 0.f};
        if (jj < NRL) { const f4 g = *(const f4*)(I.norm2_g + (size_t)l * DM + 4 * k4), sc = *(const f4*)(MODV(MOD, l, cj, 4) + 4 * k4), w = *(const f4*)(RWT + ((size_t)l * NRL + jj) * DM + 4 * k4); v = g * (sc + 1.0f) * w; }
        const unsigned h0 = f2bf_u(v.x), h1 = f2bf_u(v.y), h2 = f2bf_u(v.z), h3 = f2bf_u(v.w);
        u2v hi; hi.x = h0 | (h1 << 16); hi.y = h2 | (h3 << 16);
        u2v lo; lo.x = pk2(v.x - bflo(hi.x), v.y - bfhi(hi.x)); lo.y = pk2(v.z - bflo(hi.y), v.w - bfhi(hi.y));
        *(u2v*)(WPH + (size_t)idx * 4) = hi; *(u2v*)(WPL + (size_t)idx * 4) = lo;
    }
    for (int it = gw; it < NL * NCOND * NJT * 16; it += ngw) { const int jj = it % (NJT * 16), cj = (it / (NJT * 16)) % NCOND, l = it / (NJT * 16 * NCOND); float s = 0.f;
        if (jj < NRL) { const float* sh = MODV(MOD, l, cj, 3) + 4 * lane; const float* w = RWT + ((size_t)l * NRL + jj) * DM + 4 * lane;
#pragma unroll
            for (int j = 0; j < ROWV; ++j) { const f4 a = *(const f4*)(sh + 256 * j), b = *(const f4*)(w + 256 * j); s += (a.x * b.x + a.y * b.y) + (a.z * b.z + a.w * b.w); }
            s = wave_sum(s) + (jj < NEG ? I.router_grp_b[l * NEG + jj] : I.router_exp_b[l * NE + (jj - NEG)]); }
        if (lane == 0) CB[it] = s; }
}
__device__ __forceinline__ void ph_route(const In& I, int l, const bf16_t* X, const bf16_t* WPH, const bf16_t* WPL, const float* CB, int* TE, float* TG, float* RSTD, int* TP, int* HIST, LAS unsigned char* lds,
                         int row_lo, int bid, int nblk, int tid, int lane, int wave) {
    LAS float* PART = (LAS float*)(lds + RT_LDS_PART); LAS float* SSQ = (LAS float*)(lds + RT_LDS_SSQ); LAS int* TL = (LAS int*)(lds + RT_LDS_TL); LAS int* sexp = (LAS int*)(lds + RT_LDS_SE);
    int rb0, rb1; route_rows(nblk, bid, row_lo, rb0, rb1);
    if (tid == 0) { int nt = 0, r = rb0;
        while (r < rb1 && nt < 128) { const int cj = cond_of_row(r); int n = 1; while (n < 16 && r + n < rb1 && cond_of_row(r + n) == cj) ++n; TL[nt] = r; TL[128 + nt] = n; TL[256 + nt] = cj; ++nt; r += n; }
        TL[384] = nt; }
    __syncthreads();
    const int ntiles = TL[384], fi = lane & 15, fq = lane >> 4;
    constexpr int KS = DM / 8;
    for (int rp_ = 0; rp_ < PR_ROUTE; ++rp_)
    for (int t0 = 0; t0 < ntiles; t0 += RT_TG) {
        const bf16_t* xr[RT_TG]; size_t wo[RT_TG];
#pragma unroll
        for (int t = 0; t < RT_TG; ++t) { const int tt = t0 + t < ntiles ? t0 + t : ntiles - 1; const int r0 = TL[tt], n = TL[128 + tt], cj = TL[256 + tt];
            xr[t] = X + (size_t)(r0 + (fi < n ? fi : n - 1)) * DM + wave * KS + 8 * fq; wo[t] = (((size_t)l * NCOND + cj) * NJT * 16 + fi) * DM + wave * KS + 8 * fq; }
        pg8::f32x4 acc[RT_TG][NJT]; float ss[RT_TG];
#pragma unroll
        for (int t = 0; t < RT_TG; ++t) { ss[t] = 0.f;
#pragma unroll
            for (int jt = 0; jt < NJT; ++jt) acc[t][jt] = (pg8::f32x4){0.f, 0.f, 0.f, 0.f}; }
        bool same = true; int nv = 0;
#pragma unroll
        for (int t = 0; t < RT_TG; ++t) { if (t0 + t < ntiles) { ++nv; same = same && (TL[256 + t0 + t] == TL[256 + t0]); } }
#define RT_SS(t, aw) do { ss[t] += (bflo(aw.x) * bflo(aw.x) + bfhi(aw.x) * bfhi(aw.x)) + (bflo(aw.y) * bflo(aw.y) + bfhi(aw.y) * bfhi(aw.y)) + (bflo(aw.z) * bflo(aw.z) + bfhi(aw.z) * bfhi(aw.z)) + (bflo(aw.w) * bflo(aw.w) + bfhi(aw.w) * bfhi(aw.w)); } while (0)
        if (same) {
#pragma unroll 2
            for (int s = 0; s < KS / 32; ++s) { s8v bh[NJT], bl[NJT];
#pragma unroll
                for (int jt = 0; jt < NJT; ++jt) { bh[jt] = *(const s8v*)(WPH + wo[0] + (size_t)jt * 16 * DM + 32 * s); bl[jt] = *(const s8v*)(WPL + wo[0] + (size_t)jt * 16 * DM + 32 * s); }
#pragma unroll
                for (int t = 0; t < RT_TG; ++t) { if (t < nv) { const u4v aw = *(const u4v*)(xr[t] + 32 * s); RT_SS(t, aw); const s8v a = __builtin_bit_cast(s8v, aw);
#pragma unroll
                    for (int jt = 0; jt < NJT; ++jt) { acc[t][jt] = mfma16(a, bh[jt], acc[t][jt]); acc[t][jt] = mfma16(a, bl[jt], acc[t][jt]); } } } }
        } else {
#pragma unroll 1
            for (int s = 0; s < KS / 32; ++s) {
#pragma unroll
                for (int t = 0; t < RT_TG; ++t) { if (t < nv) { const u4v aw = *(const u4v*)(xr[t] + 32 * s); RT_SS(t, aw); const s8v a = __builtin_bit_cast(s8v, aw);
#pragma unroll
                    for (int jt = 0; jt < NJT; ++jt) { acc[t][jt] = mfma16(a, *(const s8v*)(WPH + wo[t] + (size_t)jt * 16 * DM + 32 * s), acc[t][jt]); acc[t][jt] = mfma16(a, *(const s8v*)(WPL + wo[t] + (size_t)jt * 16 * DM + 32 * s), acc[t][jt]); } } } }
        }
#undef RT_SS
#pragma unroll
        for (int t = 0; t < RT_TG; ++t) { SSQ[((wave * RT_TG + t) * 4 + fq) * 16 + fi] = ss[t];
#pragma unroll
            for (int jt = 0; jt < NJT; ++jt)
#pragma unroll
                for (int r = 0; r < 4; ++r) PART[((wave * RT_TG + t) * 16 + 4 * fq + r) * (NJT * 16) + 16 * jt + fi] = acc[t][jt][r]; }
        __syncthreads();
        if (tid < RT_TG * 16) { const int t = tid >> 4, i = tid & 15, tt = t0 + t;
            if (tt < ntiles && i < TL[128 + tt]) { const int r = TL[tt] + i, cj = TL[256 + tt];
                float sq = 0.f;
                for (int w = 0; w < 8; ++w) for (int q = 0; q < 4; ++q) sq += SSQ[((w * RT_TG + t) * 4 + q) * 16 + i];
                const float rstd = 1.0f / sqrtf(sq * (1.0f / DM) + NORM_EPS);
                float lg[NRL];
#pragma unroll
                for (int jj = 0; jj < NRL; ++jj) { float sacc = 0.f;
#pragma unroll
                    for (int w = 0; w < 8; ++w) sacc += PART[((w * RT_TG + t) * 16 + i) * (NJT * 16) + jj];
                    lg[jj] = rstd * sacc + CB[((size_t)l * NCOND + cj) * NJT * 16 + jj]; }
                int grp = 0; float gmax = lg[0];
#pragma unroll
                for (int j = 1; j < NEG; ++j) if (lg[j] > gmax) { gmax = lg[j]; grp = j; }
                float den = 0.f;
#pragma unroll
                for (int j = 0; j < NEG; ++j) den += expf(lg[j] - gmax);
                const float gprob = 1.0f / den;
                float sel[EPG];
#pragma unroll
                for (int j = 0; j < EPG; ++j) { float x = lg[NEG + j];
#pragma unroll
                    for (int g2 = 1; g2 < NEG; ++g2) x = (grp == g2) ? lg[NEG + g2 * EPG + j] : x;
                    sel[j] = x; }
                int i0 = 0; float l0 = sel[0];
#pragma unroll
                for (int j = 1; j < EPG; ++j) if (sel[j] > l0) { l0 = sel[j]; i0 = j; }
                int i1 = -1; float l1 = -3.0e38f;
#pragma unroll
                for (int j = 0; j < EPG; ++j) if (j != i0 && sel[j] > l1) { l1 = sel[j]; i1 = j; }
                const float e1 = expf(l1 - l0), g0v = gprob / (1.0f + e1), g1v = gprob * e1 / (1.0f + e1);
                const int ex0 = grp * EPG + i0, ex1 = grp * EPG + i1; TE[2 * r] = ex0; TE[2 * r + 1] = ex1; TG[2 * r] = g0v; TG[2 * r + 1] = g1v; RSTD[r] = rstd;
                sexp[2 * (r - rb0)] = ex0; sexp[2 * (r - rb0) + 1] = ex1; } }
        __syncthreads();
    }
    const int ns = 2 * (rb1 - rb0);
    for (int t = tid; t < ns; t += 512) { const int e = sexp[t]; int rank = 0; for (int q = 0; q < t; ++q) rank += (sexp[q] == e) ? 1 : 0; TP[2 * rb0 + t] = rank; }
    if (tid < NE) { int c = 0; for (int q = 0; q < ns; ++q) c += (sexp[q] == tid) ? 1 : 0; HIST[bid * NE + tid] = c; }
    __syncthreads();
}
constexpr int GA_LDS_PS = 0;
constexpr int GA_LDS_BASE = 2 * 512 * 4;
__device__ __forceinline__ void ph_gather(const In& I, int l, const float* MOD, const bf16_t* X, const float* RSTD, const int* TE, const int* TP, const int* HIST, int* TS, bf16_t* Xg,
                          LAS unsigned char* lds, LAS int* tab, LAS int* pst, int row_lo, int bid, int nblk, int tid, int lane, int wave) {
    LAS int* psum = (LAS int*)(lds + GA_LDS_PS); LAS int* base = (LAS int*)(lds + GA_LDS_BASE); LAS int* tot = base + NE;
    int rb0, rb1; route_rows(nblk, bid, row_lo, rb0, rb1);
    f4 v[ROWV];
    { const int r = rb0 + wave < rb1 ? rb0 + wave : (rb1 > rb0 ? rb1 - 1 : rb0); row_load_bf16(X + (size_t)(r < NTOK ? r : NTOK - 1) * DM, lane, v); }
    { constexpr int PARTS = 512 / NE; const int e = tid % NE, part = tid / NE; const int per = (nblk + PARTS - 1) / PARTS; int sb = 0, st = 0;
        for (int k = 0; k < per; k += 4) { int h[4];
#pragma unroll
            for (int q = 0; q < 4; ++q) { const int bb = part * per + k + q; h[q] = HIST[(bb < nblk ? bb : nblk - 1) * NE + e]; }
#pragma unroll
            for (int q = 0; q < 4; ++q) { const int bb = part * per + k + q; if (k + q < per && bb < nblk) { st += h[q]; if (bb < bid) sb += h[q]; } } }
        psum[tid] = sb; psum[512 + tid] = st; }
    __syncthreads();
    if (tid < NE) { int sb = 0, st = 0; for (int part = 0; part < 512 / NE; ++part) { sb += psum[part * NE + tid]; st += psum[512 + part * NE + tid]; } base[tid] = sb; tot[tid] = st; }
    __syncthreads();
    if (tid == 0) { int off = 0, nru = 0;
        for (int e = 0; e < NE; ++e) { pst[e] = off; off += ((tot[e] + MOE_TILE - 1) / MOE_TILE) * MOE_TILE; }
        int nfr = 0, nhr = 0;
        for (int e = 0; e < NE; ++e) { const int n128 = (tot[e] + MOE_TILE - 1) / MOE_TILE; for (int k = 0; k + 1 < n128; k += 2) tab[2 + nfr++] = (pst[e] / MOE_TILE + k) | (e << 16); }
        for (int e = 0; e < NE; ++e) { const int n128 = (tot[e] + MOE_TILE - 1) / MOE_TILE; if (n128 & 1) tab[2 + nfr + nhr++] = (pst[e] / MOE_TILE + n128 - 1) | (e << 16); }
        tab[0] = nfr; tab[1] = nhr; }
#ifndef PR_GATHER
#define PR_GATHER 1
#endif
    __syncthreads();
    for (int rg_ = 0; rg_ < PR_GATHER; ++rg_)
    for (int r = rb0 + wave; r < rb1; r += 8) {
        f4 vn[ROWV]; const int rn = r + 8 < rb1 ? r + 8 : r; row_load_bf16(X + (size_t)rn * DM, lane, vn);
        const int cj = cond_of_row(r);
        row_modulate(v, RSTD[r], I.norm2_g + (size_t)l * DM, MODV(MOD, l, cj, 4), MODV(MOD, l, cj, 3), lane);
        const int e0 = TE[2 * r], e1 = TE[2 * r + 1]; const int s0 = pst[e0] + base[e0] + TP[2 * r], s1 = pst[e1] + base[e1] + TP[2 * r + 1];
        row_store_bf16(Xg + (size_t)s0 * DM, v, lane); row_store_bf16(Xg + (size_t)s1 * DM, v, lane);
        if (lane == 0) { TS[2 * r] = s0; TS[2 * r + 1] = s1; }
#pragma unroll
        for (int j = 0; j < ROWV; ++j) v[j] = vn[j];
    }
}
__device__ __forceinline__ float fsilu(float v) { return v * __builtin_amdgcn_rcpf(1.0f + __expf(-v)); }
__device__ __forceinline__ float fsigm(float v) { return __builtin_amdgcn_rcpf(1.0f + __expf(-v)); }
struct EpiAct {
    static constexpr bool PERM = true, AFTER_DRAIN = false;
    bf16_t* O; int ldc; int ncol;
    __device__ __forceinline__ void operator()(const pg8::f32x4 (&acc)[2][2][4][2], const pg8::Unit& u, int wr, int wc, int fr, int fq) const {
        const int row0 = u.pm * 128 + wr * 64 + fr, col0 = (u.pn % ncol) * 128 + wc * 32 + 8 * fq;
#pragma unroll
        for (int ai = 0; ai < 2; ++ai)
#pragma unroll
            for (int m = 0; m < 4; ++m) { if (ai == 1 && u.half) continue; bf16_t* rowp = O + (size_t)(row0 + ai * 128 + m * 16) * ldc + col0;
                const pg8::f32x4 g0 = acc[ai][0][m][0], g1 = acc[ai][0][m][1], u0 = acc[ai][1][m][0], u1 = acc[ai][1][m][1];
                u4v w; w.x = pk2(fsilu(g0[0]) * u0[0], fsilu(g0[1]) * u0[1]); w.y = pk2(fsilu(g0[2]) * u0[2], fsilu(g0[3]) * u0[3]);
                w.z = pk2(fsilu(g1[0]) * u1[0], fsilu(g1[1]) * u1[1]); w.w = pk2(fsilu(g1[2]) * u1[2], fsilu(g1[3]) * u1[3]);
                *(u4v*)rowp = w; }
    }
};
struct EpiActSc : EpiAct {
    __device__ __forceinline__ void operator()(const pg8::f32x4 (&acc)[2][2][4][2], const pg8::Unit& u, int wr, int wc, int fr, int fq) const {
        const int row0 = u.pm * 128 + wr * 64 + fr, col0 = (u.pn % ncol) * 128 + wc * 32 + 8 * fq;
#pragma unroll
        for (int ai = 0; ai < 2; ++ai)
#pragma unroll
            for (int m = 0; m < 4; ++m) { if (ai == 1 && u.half) continue; bf16_t* rowp = O + (size_t)(row0 + ai * 128 + m * 16) * ldc + col0;
                const pg8::f32x4 g0 = acc[ai][0][m][0], g1 = acc[ai][0][m][1], u0 = acc[ai][1][m][0], u1 = acc[ai][1][m][1];
                const unsigned long long lo = (unsigned long long)pk2(fsilu(g0[0]) * u0[0], fsilu(g0[1]) * u0[1]) | ((unsigned long long)pk2(fsilu(g0[2]) * u0[2], fsilu(g0[3]) * u0[3]) << 32);
                const unsigned long long hi = (unsigned long long)pk2(fsilu(g1[0]) * u1[0], fsilu(g1[1]) * u1[1]) | ((unsigned long long)pk2(fsilu(g1[2]) * u1[2], fsilu(g1[3]) * u1[3]) << 32);
#if defined(HOST_EMU2) || defined(SC1_X2)
                __hip_atomic_store((unsigned long long*)rowp, lo, __ATOMIC_RELAXED, __HIP_MEMORY_SCOPE_AGENT);
                __hip_atomic_store((unsigned long long*)rowp + 1, hi, __ATOMIC_RELAXED, __HIP_MEMORY_SCOPE_AGENT); }
#else
                u4v w; w.x = (unsigned)lo; w.y = (unsigned)(lo >> 32); w.z = (unsigned)hi; w.w = (unsigned)(hi >> 32);
                asm volatile("global_store_dwordx4 %0, %1, off sc1\n\ts_nop 1" :: "v"(rowp), "v"(w) : "memory"); }
#endif
    }
};
struct EpiBf16N {
    static constexpr bool PERM = true, AFTER_DRAIN = false;
    bf16_t* O; int ldc; int ncol;
    __device__ __forceinline__ void operator()(const pg8::f32x4 (&acc)[2][2][4][2], const pg8::Unit& u, int wr, int wc, int fr, int fq) const {
        const int row0 = u.pm * 128 + wr * 64 + fr, col0 = (u.pn % ncol) * 256 + wc * 32 + 8 * fq;
#pragma unroll
        for (int ai = 0; ai < 2; ++ai)
#pragma unroll
            for (int m = 0; m < 4; ++m) { if (ai == 1 && u.half) continue; bf16_t* rowp = O + (size_t)(row0 + ai * 128 + m * 16) * ldc + col0;
#pragma unroll
                for (int bj = 0; bj < 2; ++bj) { const pg8::f32x4 a = acc[ai][bj][m][0], b = acc[ai][bj][m][1];
                    u4v w; w.x = pk2(a[0], a[1]); w.y = pk2(a[2], a[3]); w.z = pk2(b[0], b[1]); w.w = pk2(b[2], b[3]); *(u4v*)(rowp + bj * 128) = w; } }
    }
};
struct EpiGlu {
    static constexpr bool PERM = true, AFTER_DRAIN = false;
    bf16_t* O; int ldc; int ocol; const bf16_t* Zb; int ldz; const float* bias;
    __device__ __forceinline__ void operator()(const pg8::f32x4 (&acc)[2][2][4][2], const pg8::Unit& u, int wr, int wc, int fr, int fq) const {
        const int row0 = u.pm * 128 + wr * 64 + fr, col0 = u.pn * 256 + wc * 32 + 8 * fq;
#pragma unroll
        for (int ai = 0; ai < 2; ++ai)
#pragma unroll
            for (int m = 0; m < 4; ++m) { if (ai == 1 && u.half) continue; const int row = row0 + ai * 128 + m * 16;
#pragma unroll
                for (int bj = 0; bj < 2; ++bj) { const int c = col0 + bj * 128; const u4v z = *(const u4v*)(Zb + (size_t)row * ldz + c);
                    const f4 b0 = *(const f4*)(bias + c), b1 = *(const f4*)(bias + c + 4); const pg8::f32x4 a = acc[ai][bj][m][0], b = acc[ai][bj][m][1];
                    u4v w; w.x = pk2(bflo(z.x) * fsigm(a[0] + b0.x), bfhi(z.x) * fsigm(a[1] + b0.y)); w.y = pk2(bflo(z.y) * fsigm(a[2] + b0.z), bfhi(z.y) * fsigm(a[3] + b0.w));
                    w.z = pk2(bflo(z.z) * fsigm(b[0] + b1.x), bfhi(z.z) * fsigm(b[1] + b1.y)); w.w = pk2(bflo(z.w) * fsigm(b[2] + b1.z), bfhi(z.w) * fsigm(b[3] + b1.w));
                    *(u4v*)(O + (size_t)row * ldc + ocol + c) = w; } }
    }
};
struct EpiResid {
    static constexpr bool PERM = true, AFTER_DRAIN = false;
    bf16_t* Xo; const float* res_ctx; const float* res_lat; const bf16_t* res_b; const float* MOD; int l; int row_base;
    __device__ __forceinline__ void operator()(const pg8::f32x4 (&acc)[2][2][4][2], const pg8::Unit& u, int wr, int wc, int fr, int fq) const {
        const int row0 = row_base + u.pm * 128 + wr * 64 + fr, col0 = u.pn * 256 + wc * 32 + 8 * fq;
#pragma unroll
        for (int ai = 0; ai < 2; ++ai)
#pragma unroll
            for (int m = 0; m < 4; ++m) { if (ai == 1 && u.half) continue; const int row = row0 + ai * 128 + m * 16;
                const float* mp = MODV(MOD, l, cond_of_row(row), 2) + col0;
#pragma unroll
                for (int bj = 0; bj < 2; ++bj) { const int c = col0 + bj * 128; f4 r0, r1;
                    if (res_b) { const u4v w = *(const u4v*)(res_b + (size_t)row * DM + c); r0 = (f4){bflo(w.x), bfhi(w.x), bflo(w.y), bfhi(w.y)}; r1 = (f4){bflo(w.z), bfhi(w.z), bflo(w.w), bfhi(w.w)}; }
                    else { const float* rp = (row < NCTX ? res_ctx + (size_t)row * DM : res_lat + (size_t)(row - NCTX) * DM) + c; r0 = *(const f4*)rp; r1 = *(const f4*)(rp + 4); }
                    const f4 m0 = *(const f4*)(mp + bj * 128), m1 = *(const f4*)(mp + bj * 128 + 4); const pg8::f32x4 a = acc[ai][bj][m][0], b = acc[ai][bj][m][1];
                    u4v o; o.x = pk2(r0.x + m0.x * a[0], r0.y + m0.y * a[1]); o.y = pk2(r0.z + m0.z * a[2], r0.w + m0.w * a[3]);
                    o.z = pk2(r1.x + m1.x * b[0], r1.y + m1.y * b[1]); o.w = pk2(r1.z + m1.z * b[2], r1.w + m1.w * b[3]);
                    *(u4v*)(Xo + (size_t)row * DM + c) = o; } }
    }
};

}
namespace nv {
constexpr int RPAD = 136;
constexpr float LOG2E = 1.4426950408889634f;
__device__ __forceinline__ float shfl_xor_f(float v, int lane, int m) { return __builtin_bit_cast(float, __builtin_amdgcn_ds_bpermute((lane ^ m) << 2, __builtin_bit_cast(int, v))); }

__device__ __forceinline__ void ph_rope_table(float* ROPE, int gtid, int gstride) {
    constexpr int NF = HD / 4;
    for (int idx_ = gtid; idx_ < (SQ * (HD / 2)) * PR_PREP; idx_ += gstride) { const int idx = idx_ % (SQ * (HD / 2));
        const int i = idx % (HD / 2), pos = idx / (HD / 2), rowp = pos / GW, colp = pos % GW, f = i < NF ? i : i - NF;
        const float inv = powf(10000.0f, -(float)f / (float)NF), ang = (i < NF ? (float)rowp : (float)colp) * inv;
        ROPE[2 * idx] = cosf(ang); ROPE[2 * idx + 1] = sinf(ang);
    }
}
struct EpiQKV {
    static constexpr bool PERM = true, AFTER_DRAIN = false;
    bf16_t* O; const float* ROPE;
    __device__ __forceinline__ void operator()(const pg8::f32x4 (&acc)[2][2][4][2], const pg8::Unit& u, int wr, int wc, int fr, int fq) const {
        const int row0 = u.pm * 128 + wr * 64 + fr, col0 = u.pn * 256 + wc * 32 + 8 * fq;
        const int region = (u.pn * 256) / RW;
        const float ksc = region == 1 ? 1.0f / sqrtf((float)HD) : 1.0f;
#pragma unroll
        for (int ai = 0; ai < 2; ++ai)
#pragma unroll
            for (int m = 0; m < 4; ++m) { if (ai == 1 && u.half) continue; const int row = row0 + ai * 128 + m * 16; bf16_t* rowp = O + (size_t)row * INW + col0;
                const bool rope = region < 2 && row >= NCTX; const int pos = rope ? (row - NCTX) % SQ : 0;
#pragma unroll
                for (int bj = 0; bj < 2; ++bj) { pg8::f32x4 a = acc[ai][bj][m][0], b = acc[ai][bj][m][1];
                    if (rope) { const int i0 = ((col0 + bj * 128) % HD) / 2; const f4* rp = (const f4*)(ROPE + ((size_t)pos * (HD / 2) + i0) * 2); const f4 c0 = rp[0], c1 = rp[1];
                        pg8::f32x4 x, y; x[0] = a[0] * c0.x - a[1] * c0.y; x[1] = a[0] * c0.y + a[1] * c0.x; x[2] = a[2] * c0.z - a[3] * c0.w; x[3] = a[2] * c0.w + a[3] * c0.z;
                        y[0] = b[0] * c1.x - b[1] * c1.y; y[1] = b[0] * c1.y + b[1] * c1.x; y[2] = b[2] * c1.z - b[3] * c1.w; y[3] = b[2] * c1.w + b[3] * c1.z; a = x; b = y; }
                    a = a * ksc; b = b * ksc;
                    u4v w; w.x = pk2(a[0], a[1]); w.y = pk2(a[2], a[3]); w.z = pk2(b[0], b[1]); w.w = pk2(b[2], b[3]); *(u4v*)(rowp + bj * 128) = w; } }
    }
};

__device__ __forceinline__ void ph_ret_kv(const In& I, int l, const bf16_t* QKVb, bf16_t* KVT, LAS unsigned char* lds, int bid, int nblk, int tid, int lane, int wave) {
    LAS bf16_t* KTf = (LAS bf16_t*)lds; LAS bf16_t* KTb = KTf + HD * RPAD; LAS bf16_t* VT = KTb + HD * RPAD;
    const int fr = lane & 15, fq = lane >> 4;
    for (int u_ = bid; u_ < NB * NH * NCH * PR_KV; u_ += nblk) { const int u = u_ % (NB * NH * NCH);
        const int n = u % NCH, h = (u / NCH) % NH, b = u / (NCH * NH);
        const float lgf = logg(I, l, 0, h), lgb = logg(I, l, 1, h);
        { const int p = tid & 127, row = row_of(b, n, p); const float wf = expf(lgf * (float)(RC - 1 - p)), wb = expf(lgb * (float)p);
            const bf16_t* kp = QKVb + (size_t)row * INW + RW + h * HD; const bf16_t* vp = QKVb + (size_t)row * INW + 2 * RW + h * HD;
#pragma unroll
            for (int i = 0; i < 4; ++i) { const int dg = (tid >> 7) + 4 * i; const u4v kk = *(const u4v*)(kp + 8 * dg), vv = *(const u4v*)(vp + 8 * dg);
#pragma unroll
                for (int j = 0; j < 8; ++j) { const unsigned kw = kk[j >> 1], vw = vv[j >> 1]; const float kf = (j & 1) ? bfhi(kw) : bflo(kw);
                    KTf[(8 * dg + j) * RPAD + p] = (bf16_t)f2bf_u(kf * wf); KTb[(8 * dg + j) * RPAD + p] = (bf16_t)f2bf_u(kf * wb);
                    VT[(8 * dg + j) * RPAD + p] = (bf16_t)((j & 1) ? (vw >> 16) : (vw & 0xffffu)); } } }
        __syncthreads();
        pg8::f32x4 acc[2][8];
#pragma unroll
        for (int d = 0; d < 2; ++d)
#pragma unroll
            for (int k = 0; k < 8; ++k) acc[d][k] = (pg8::f32x4){0.f, 0.f, 0.f, 0.f};
#pragma unroll
        for (int s = 0; s < 4; ++s) { const s8v bfrag = *(const LAS s8v*)(VT + (16 * wave + fr) * RPAD + 32 * s + 8 * fq);
#pragma unroll
            for (int db = 0; db < 8; ++db) { const s8v af = *(const LAS s8v*)(KTf + (16 * db + fr) * RPAD + 32 * s + 8 * fq), ab = *(const LAS s8v*)(KTb + (16 * db + fr) * RPAD + 32 * s + 8 * fq);
                acc[0][db] = mfma16(af, bfrag, acc[0][db]); acc[1][db] = mfma16(ab, bfrag, acc[1][db]); } }
        const int e = 16 * wave + fr;
#pragma unroll
        for (int d = 0; d < 2; ++d)
#pragma unroll
            for (int db = 0; db < 8; ++db) { u2v w; w.x = pk2(acc[d][db][0], acc[d][db][1]); w.y = pk2(acc[d][db][2], acc[d][db][3]);
                *(u2v*)(KVT + (((((size_t)d * NB + b) * NH + h) * NCH + n) * HD + e) * HD + 16 * db + 4 * fq) = w; }
        __syncthreads();
    }
}
__device__ __forceinline__ void ph_ret_scan(const In& I, int l, const bf16_t* KVT, bf16_t* STT, int gtid, int gstride) {
    for (int idx_ = gtid; idx_ < 2 * NB * NH * HD * (HD / 4) * PR_SCAN; idx_ += gstride) { const int idx = idx_ % (2 * NB * NH * HD * (HD / 4));
        const int ed = idx % (HD * HD / 4); int t = idx / (HD * HD / 4); const int h = t % NH; t /= NH; const int b = t % NB, dir = t / NB;
        const float dec = expf(logg(I, l, dir, h) * (float)RC); f4 s = (f4){0.f, 0.f, 0.f, 0.f};
#pragma unroll 1
        for (int step = 0; step < NCH; ++step) { const int n = chain_chunk(dir, step);
            const size_t o = ((((size_t)dir * NB + b) * NH + h) * NCH + n) * HD * HD + 4 * (size_t)ed;
            u2v w; w.x = pk2(s.x, s.y); w.y = pk2(s.z, s.w); *(u2v*)(STT + o) = w;
            const u2v kw = *(const u2v*)(KVT + o); const f4 kv = (f4){bflo(kw.x), bfhi(kw.x), bflo(kw.y), bfhi(kw.y)}; s = s * dec + kv; }
    }
}
__device__ __forceinline__ void ph_ret_out(const In& I, int l, const bf16_t* QKVb, const bf16_t* STT, bf16_t* MIXb, LAS unsigned char* lds, int n_lo, int bid, int nblk, int tid, int lane, int wave, unsigned* tq, volatile LAS int* slot) {
    LAS bf16_t* Kt = (LAS bf16_t*)lds; LAS bf16_t* VT = Kt + RC * RPAD; LAS bf16_t* ST = VT + HD * RPAD;
    const int fr = lane & 15, fq = lane >> 4, ncn = NCH - n_lo;
    if (tid == 0) slot[0] = (int)xb_add(tq, 1u);
    __syncthreads();
    int u = __builtin_amdgcn_readfirstlane(slot[0]);
    for (int it = 0; u < NB * NH * ncn; ++it) {
        const int n = n_lo + u % ncn, h = (u / ncn) % NH, b = u / (ncn * NH);
        const float lgf = logg(I, l, 0, h), lgb = logg(I, l, 1, h);
#pragma unroll
        for (int i = 0; i < 4; ++i) { const int q = i * 512 + tid, dgq = q & 15, p = q >> 4; const int row = row_of(b, n, p);
            *(LAS u4v*)(Kt + p * RPAD + 8 * dgq) = *(const u4v*)(QKVb + (size_t)row * INW + RW + h * HD + 8 * dgq);
            *(LAS u4v*)(ST + p * RPAD + 8 * dgq) = *(const u4v*)(STT + ((((size_t)0 * NB + b) * NH + h) * NCH + n) * HD * HD + (size_t)p * HD + 8 * dgq); }
        { const int p = tid & 127, row = row_of(b, n, p); const bf16_t* vp = QKVb + (size_t)row * INW + 2 * RW + h * HD;
#pragma unroll
            for (int i = 0; i < 4; ++i) { const int dg = (tid >> 7) + 4 * i; const u4v vv = *(const u4v*)(vp + 8 * dg);
#pragma unroll
                for (int j = 0; j < 8; ++j) { const unsigned vw = vv[j >> 1]; VT[(8 * dg + j) * RPAD + p] = (bf16_t)((j & 1) ? (vw >> 16) : (vw & 0xffffu)); } } }
        if (tid == 0) slot[(it + 1) & 1] = (int)xb_add(tq, 1u);
        __syncthreads();
        const int ipos = 16 * wave + fr, rowq = row_of(b, n, ipos);
        s8v qf[4];
#pragma unroll
        for (int s = 0; s < 4; ++s) qf[s] = *(const s8v*)(QKVb + (size_t)rowq * INW + h * HD + 32 * s + 8 * fq);
        pg8::f32x4 st[8];
#pragma unroll
        for (int jt = 0; jt < 8; ++jt) { st[jt] = (pg8::f32x4){0.f, 0.f, 0.f, 0.f};
#pragma unroll
            for (int s = 0; s < 4; ++s) st[jt] = mfma16(*(const LAS s8v*)(Kt + (16 * jt + fr) * RPAD + 32 * s + 8 * fq), qf[s], st[jt]); }
        const float lf2 = lgf * LOG2E, lb2 = lgb * LOG2E;
#pragma unroll
        for (int jt = 0; jt < 8; ++jt)
#pragma unroll
            for (int r = 0; r < 4; ++r) { const int diff = ipos - (16 * jt + 4 * fq + r); st[jt][r] *= __builtin_amdgcn_exp2f(diff >= 0 ? lf2 * (float)diff : lb2 * (float)(-diff)); }
        s8v pf[4];
#pragma unroll
        for (int s = 0; s < 4; ++s) { u4v w; w.x = pk2(st[2 * s][0], st[2 * s][1]); w.y = pk2(st[2 * s][2], st[2 * s][3]); w.z = pk2(st[2 * s + 1][0], st[2 * s + 1][1]); w.w = pk2(st[2 * s + 1][2], st[2 * s + 1][3]);
            pf[s] = __builtin_bit_cast(s8v, w); }
        pg8::f32x4 o0[8], oF[8], oB[8];
#pragma unroll
        for (int eb = 0; eb < 8; ++eb) { o0[eb] = (pg8::f32x4){0.f, 0.f, 0.f, 0.f}; oF[eb] = o0[eb]; oB[eb] = o0[eb]; }
        const bf16_t* stb = STT + ((((size_t)1 * NB + b) * NH + h) * NCH + n) * HD * HD;
        u4v sb[4];
#pragma unroll
        for (int i = 0; i < 4; ++i) { const int q = i * 512 + tid, dgq = q & 15, e = q >> 4; sb[i] = *(const u4v*)(stb + (size_t)e * HD + 8 * dgq); }
#pragma unroll
        for (int eb = 0; eb < 8; ++eb)
#pragma unroll
            for (int s = 0; s < 4; ++s) { const LAS bf16_t* vr = VT + (16 * eb + fr) * RPAD + 32 * s + 4 * fq; const u2v lo = *(const LAS u2v*)vr, hi = *(const LAS u2v*)(vr + 16);
                u4v a; a.x = lo.x; a.y = lo.y; a.z = hi.x; a.w = hi.y; o0[eb] = mfma16(__builtin_bit_cast(s8v, a), pf[s], o0[eb]);
                oF[eb] = mfma16(*(const LAS s8v*)(ST + (16 * eb + fr) * RPAD + 32 * s + 8 * fq), qf[s], oF[eb]); }
        __syncthreads();
#pragma unroll
        for (int i = 0; i < 4; ++i) { const int q = i * 512 + tid, dgq = q & 15, e = q >> 4; *(LAS u4v*)(ST + e * RPAD + 8 * dgq) = sb[i]; }
        __syncthreads();
#pragma unroll
        for (int eb = 0; eb < 8; ++eb)
#pragma unroll
            for (int s = 0; s < 4; ++s) oB[eb] = mfma16(*(const LAS s8v*)(ST + (16 * eb + fr) * RPAD + 32 * s + 8 * fq), qf[s], oB[eb]);
        const float qwf = expf(lgf * (float)(ipos + 1)), qwb = expf(lgb * (float)(RC - ipos));
        float sum = 0.f;
#pragma unroll
        for (int eb = 0; eb < 8; ++eb) { o0[eb] = o0[eb] + oF[eb] * qwf + oB[eb] * qwb; sum += (o0[eb][0] + o0[eb][1]) + (o0[eb][2] + o0[eb][3]); }
        sum += shfl_xor_f(sum, lane, 16); sum += shfl_xor_f(sum, lane, 32);
        const float mu = sum * (1.0f / HD); float var = 0.f;
#pragma unroll
        for (int eb = 0; eb < 8; ++eb) { o0[eb] = o0[eb] - mu; var += (o0[eb][0] * o0[eb][0] + o0[eb][1] * o0[eb][1]) + (o0[eb][2] * o0[eb][2] + o0[eb][3] * o0[eb][3]); }
        var += shfl_xor_f(var, lane, 16); var += shfl_xor_f(var, lane, 32);
        const float rs = 1.0f / sqrtf(var * (1.0f / HD) + GN_EPS);
        const bf16_t* gp = QKVb + (size_t)rowq * INW + 3 * RW + h * HD + 4 * fq; bf16_t* op = MIXb + (size_t)rowq * DM + h * HD + 4 * fq;
#pragma unroll
        for (int eb = 0; eb < 8; ++eb) { const u2v g = *(const u2v*)(gp + 16 * eb);
            u2v w; w.x = pk2(o0[eb][0] * rs * fsilu(bflo(g.x)), o0[eb][1] * rs * fsilu(bfhi(g.x))); w.y = pk2(o0[eb][2] * rs * fsilu(bflo(g.y)), o0[eb][3] * rs * fsilu(bfhi(g.y)));
            *(u2v*)(op + 16 * eb) = w; }
        __syncthreads();
        u = __builtin_amdgcn_readfirstlane(slot[(it + 1) & 1]);
    }
}
}
namespace nv {
constexpr int MCT = 16;
constexpr int NMC = (CTXL + SQ) / MCT;
constexpr int NTL = NMC / 16;
constexpr int CTL = CTXL / 256;
static_assert(CTXL % 256 == 0 && SQ % 256 == 0 && SG == 16 && SP == 64 && NG % 8 == 0, "S5 phase geometry");
constexpr int UP = 264;
constexpr int S5_LDS_LOC = ((NMC * UP * 2 + 15) / 16) * 16, LOCP = 132, S5_LDS_HIN = S5_LDS_LOC + 2 * 16 * LOCP * 4, S5_LDS_END = S5_LDS_HIN + 2 * 16 * RPAD * 2;
static_assert(S5_LDS_END <= 131072, "S5 LDS map");
__device__ __forceinline__ void ph_s5_prep1(const In& I, float* LAMP, float* BBc, int gtid, int gstride) {
    for (int idx_ = gtid; idx_ < (NL * 2 * NG * SP) * PR_PREP; idx_ += gstride) { const int idx = idx_ % (NL * 2 * NG * SP);
        const int p = idx % SP, g = (idx / SP) % NG, ld = idx / (SP * NG);
        const size_t ia = ((size_t)ld * NG + g) * SP + p;
        const double are = I.s5_a_re[ia], aim = I.s5_a_im[ia], dt = exp((double)I.s5_log_step[(size_t)ld * NG + g]);
        for (int tau = 0; tau <= 16; ++tau) { const double mag = exp(tau * are * dt), ang = tau * aim * dt;
            float* o = LAMP + ((((size_t)ld * NG + g) * 17 + tau) * SP + p) * 2; o[0] = (float)(mag * cos(ang)); o[1] = (float)(mag * sin(ang)); }
        const double mag = exp(are * dt), ang = aim * dt, abr = mag * cos(ang), abi = mag * sin(ang), den = are * are + aim * aim, nr = abr - 1.0;
        const double fr = (nr * are + abi * aim) / den, fi = (abi * are - nr * aim) / den;
        for (int c = 0; c < SG; ++c) { const double br = I.s5_b_re[ia * SG + c], bi = I.s5_b_im[ia * SG + c];
            BBc[(ia * SG + c) * 2] = (float)(fr * br - fi * bi); BBc[(ia * SG + c) * 2 + 1] = (float)(fr * bi + fi * br); }
    }
}
__device__ __forceinline__ void ph_s5_prep2a(const In& I, const float* LAMP, const float* BBc, float* KTAU, int gtid, int gstride) {
    for (int idx_ = gtid; idx_ < NL * 2 * NG * 16 * SG * PR_PREP; idx_ += gstride) { const int idx = idx_ % (NL * 2 * NG * 16 * SG);
        const int co = idx % SG, tau = (idx / SG) % 16, g = (idx / (SG * 16)) % NG, ld = idx / (SG * 16 * NG);
        const float* lam = LAMP + (((size_t)ld * NG + g) * 17 + tau) * SP * 2; const float* bb = BBc + ((size_t)ld * NG + g) * SP * SG * 2;
        const float* cr = I.s5_c_re + (((size_t)ld * NG + g) * SG + co) * SP; const float* cim = I.s5_c_im + (((size_t)ld * NG + g) * SG + co) * SP;
        float acc[SG];
#pragma unroll
        for (int ci = 0; ci < SG; ++ci) acc[ci] = 0.f;
#pragma unroll 2
        for (int p = 0; p < SP; ++p) { const float wr = cr[p] * lam[2 * p] - cim[p] * lam[2 * p + 1], wi = cr[p] * lam[2 * p + 1] + cim[p] * lam[2 * p];
            const f4* b4 = (const f4*)(bb + (size_t)p * SG * 2);
#pragma unroll
            for (int q = 0; q < SG / 2; ++q) { const f4 x = b4[q]; acc[2 * q] += wr * x.x - wi * x.y; acc[2 * q + 1] += wr * x.z - wi * x.w; } }
        f4* o = (f4*)(KTAU + (size_t)idx * SG);
#pragma unroll
        for (int q = 0; q < SG / 4; ++q) o[q] = (f4){acc[4 * q], acc[4 * q + 1], acc[4 * q + 2], acc[4 * q + 3]};
    }
}
__device__ __forceinline__ void ph_s5_prep2b(const In& I, const float* LAMP, const float* BBc, bf16_t* MINT, bf16_t* MOUT, int gtid, int gstride) {
    for (int idx_ = gtid; idx_ < NL * 2 * NG * 128 * 32 * PR_PREP; idx_ += gstride) { const int idx = idx_ % (NL * 2 * NG * 128 * 32);
        const int k8 = idx % 32, n = (idx / 32) % 128, g = (idx / (32 * 128)) % NG, ld = idx / (32 * 128 * NG), dir = ld & 1;
        const int reim = n >> 6, p = n & 63, t = k8 >> 1, ci0 = (k8 & 1) * 8, e = dir == 0 ? 15 - t : t;
        const float* lam = LAMP + ((((size_t)ld * NG + g) * 17 + e) * SP + p) * 2; const f4* b4 = (const f4*)(BBc + ((((size_t)ld * NG + g) * SP + p) * SG + ci0) * 2);
        const float lr = lam[0], li = lam[1]; float v[8];
#pragma unroll
        for (int q = 0; q < 4; ++q) { const f4 x = b4[q]; v[2 * q] = reim ? lr * x.y + li * x.x : lr * x.x - li * x.y; v[2 * q + 1] = reim ? lr * x.w + li * x.z : lr * x.z - li * x.w; }
        u4v w; w.x = pk2(v[0], v[1]); w.y = pk2(v[2], v[3]); w.z = pk2(v[4], v[5]); w.w = pk2(v[6], v[7]);
        *(u4v*)(MINT + (size_t)idx * 8) = w;
    }
    for (int idx_ = gtid; idx_ < NL * 2 * NG * 256 * 16 * PR_PREP; idx_ += gstride) { const int idx = idx_ % (NL * 2 * NG * 256 * 16);
        const int k8 = idx % 16, n2 = (idx / 16) % 256, g = (idx / (16 * 256)) % NG, ld = idx / (16 * 256 * NG), dir = ld & 1;
        const int reim = k8 >> 3, p0 = (k8 & 7) * 8, t = n2 >> 4, co = n2 & 15, f = dir == 0 ? t + 1 : 16 - t;
        const f4* l4 = (const f4*)(LAMP + ((((size_t)ld * NG + g) * 17 + f) * SP + p0) * 2);
        const f4* cr4 = (const f4*)(I.s5_c_re + (((size_t)ld * NG + g) * SG + co) * SP + p0); const f4* ci4 = (const f4*)(I.s5_c_im + (((size_t)ld * NG + g) * SG + co) * SP + p0);
        float crv[8], civ[8], v[8];
#pragma unroll
        for (int q = 0; q < 2; ++q) { const f4 a = cr4[q], b = ci4[q]; crv[4 * q] = a.x; crv[4 * q + 1] = a.y; crv[4 * q + 2] = a.z; crv[4 * q + 3] = a.w; civ[4 * q] = b.x; civ[4 * q + 1] = b.y; civ[4 * q + 2] = b.z; civ[4 * q + 3] = b.w; }
#pragma unroll
        for (int q = 0; q < 4; ++q) { const f4 x = l4[q];
            v[2 * q] = reim ? -(crv[2 * q] * x.y + civ[2 * q] * x.x) : crv[2 * q] * x.x - civ[2 * q] * x.y;
            v[2 * q + 1] = reim ? -(crv[2 * q + 1] * x.w + civ[2 * q + 1] * x.z) : crv[2 * q + 1] * x.z - civ[2 * q + 1] * x.w; }
        u4v w; w.x = pk2(v[0], v[1]); w.y = pk2(v[2], v[3]); w.z = pk2(v[4], v[5]); w.w = pk2(v[6], v[7]);
        *(u4v*)(MOUT + (size_t)idx * 8) = w;
    }
}
__device__ __forceinline__ void ph_s5_prep3(const In& I, const float* KTAU, bf16_t* KTOT, int gtid, int gstride) {
    for (int idx_ = gtid; idx_ < NL * NG * 256 * 32 * PR_PREP; idx_ += gstride) { const int idx = idx_ % (NL * NG * 256 * 32);
        const int k8 = idx % 32, n = (idx / 32) % 256, g = (idx / (32 * 256)) % NG, l = idx / (32 * 256 * NG);
        const int t = n >> 4, co = n & 15, tp = k8 >> 1, ci0 = (k8 & 1) * 8;
        float v[8];
#pragma unroll
        for (int q = 0; q < 8; ++q) v[q] = 0.f;
        if (tp <= t) { const f4* s = (const f4*)(KTAU + (((((size_t)l * 2 + 0) * NG + g) * 16 + (t - tp)) * SG + co) * SG + ci0); const f4 a = s[0], b = s[1];
            v[0] += a.x; v[1] += a.y; v[2] += a.z; v[3] += a.w; v[4] += b.x; v[5] += b.y; v[6] += b.z; v[7] += b.w; }
        if (tp >= t) { const f4* s = (const f4*)(KTAU + (((((size_t)l * 2 + 1) * NG + g) * 16 + (tp - t)) * SG + co) * SG + ci0); const f4 a = s[0], b = s[1];
            v[0] += a.x; v[1] += a.y; v[2] += a.z; v[3] += a.w; v[4] += b.x; v[5] += b.y; v[6] += b.z; v[7] += b.w; }
        if (tp == t && co >= ci0 && co < ci0 + 8) { const float dd = I.s5_d[((size_t)l * NG + g) * SG + co];
#pragma unroll
            for (int q = 0; q < 8; ++q) if (q == co - ci0) v[q] += dd; }
        u4v w; w.x = pk2(v[0], v[1]); w.y = pk2(v[2], v[3]); w.z = pk2(v[4], v[5]); w.w = pk2(v[6], v[7]);
        *(u4v*)(KTOT + (size_t)idx * 8) = w;
    }
}
__device__ __forceinline__ int s5_token(int b, int m, int t) { return m < CTXL / MCT ? b * CTXL + MCT * m + t : NCTX + b * SQ + MCT * (m - CTXL / MCT) + t; }

__device__ __forceinline__ int s5_chain_m(int dir, int c) { return dir == 0 ? c : (c < CTXL / MCT ? CTXL / MCT - 1 - c : NMC - 1 - (c - CTXL / MCT)); }
__device__ __forceinline__ void ph_s5(int l, const bf16_t* QKVb, const float* LAMP, const bf16_t* MINT, const bf16_t* MOUT, const bf16_t* KTOT, bf16_t* Zb, LAS unsigned char* lds,
                      int mt_lo, int bid, int nblk, int tid, int lane, int wave) {
    LAS bf16_t* U = (LAS bf16_t*)lds;
    const int fr = lane & 15, fq = lane >> 4;
    for (int u_ = bid; u_ < NG * NB * PR_S5; u_ += nblk) { const int u = u_ % (NG * NB);
        const int g = (u % 8) + 8 * (u / (8 * NB)), b = (u / 8) % NB;
        for (int q = tid; q < NMC * MCT * 2; q += 512) { const int half = q & 1, tok = q >> 1, m = tok / MCT, t = tok % MCT;
            *(LAS u4v*)(U + m * UP + t * 16 + 8 * half) = *(const u4v*)(QKVb + (size_t)s5_token(b, m, t) * INW + 4 * RW + g * SG + 8 * half); }
        __syncthreads();
        unsigned Lp[NTL][2][2];
        { pg8::f32x4 L[NTL][2];
#pragma unroll
            for (int mt = 0; mt < NTL; ++mt) { L[mt][0] = (pg8::f32x4){0.f, 0.f, 0.f, 0.f}; L[mt][1] = L[mt][0]; }
            const int ldir = wave >> 2; const bf16_t* mi = MINT + ((((size_t)l * 2 + ldir) * NG + g) * 128 + 32 * (wave & 3) + fr) * 256 + 8 * fq;
            s8v q[4][2];
#pragma unroll
            for (int s = 0; s < 4; ++s) { q[s][0] = *(const s8v*)(mi + 32 * s); q[s][1] = *(const s8v*)(mi + 16 * 256 + 32 * s); }
#pragma unroll 1
            for (int h = 0; h < 2; ++h) { s8v n[4][2];
#pragma unroll
                for (int s = 0; s < 4; ++s) { n[s][0] = q[s][0]; n[s][1] = q[s][1]; }
                if (h == 0) {
#pragma unroll
                    for (int s = 0; s < 4; ++s) { n[s][0] = *(const s8v*)(mi + 32 * (4 + s)); n[s][1] = *(const s8v*)(mi + 16 * 256 + 32 * (4 + s)); } }
#pragma unroll
                for (int s = 0; s < 4; ++s) {
#pragma unroll
                    for (int mt = 0; mt < NTL; ++mt) { const s8v a = *(const LAS s8v*)(U + (16 * mt + fr) * UP + 128 * h + 32 * s + 8 * fq); L[mt][0] = mfma16(a, q[s][0], L[mt][0]); L[mt][1] = mfma16(a, q[s][1], L[mt][1]); } }
#pragma unroll
                for (int s = 0; s < 4; ++s) { q[s][0] = n[s][0]; q[s][1] = n[s][1]; } }
#pragma unroll
            for (int mt = 0; mt < NTL; ++mt)
#pragma unroll
                for (int c = 0; c < 2; ++c) { Lp[mt][c][0] = pk2(L[mt][c][0], L[mt][c][1]); Lp[mt][c][1] = pk2(L[mt][c][2], L[mt][c][3]); } }
        pg8::f32x4 Y[NTL][2];
#pragma unroll
        for (int mt = 0; mt < NTL; ++mt) { Y[mt][0] = (pg8::f32x4){0.f, 0.f, 0.f, 0.f}; Y[mt][1] = Y[mt][0]; }
        { const bf16_t* kt = KTOT + (((size_t)l * NG + g) * 256 + 32 * wave + fr) * 256 + 8 * fq;
            s8v q[4][2];
#pragma unroll
            for (int s = 0; s < 4; ++s) { q[s][0] = *(const s8v*)(kt + 32 * s); q[s][1] = *(const s8v*)(kt + 16 * 256 + 32 * s); }
#pragma unroll 1
            for (int h = 0; h < 2; ++h) { s8v n[4][2];
#pragma unroll
                for (int s = 0; s < 4; ++s) { n[s][0] = q[s][0]; n[s][1] = q[s][1]; }
                if (h == 0) {
#pragma unroll
                    for (int s = 0; s < 4; ++s) { n[s][0] = *(const s8v*)(kt + 32 * (4 + s)); n[s][1] = *(const s8v*)(kt + 16 * 256 + 32 * (4 + s)); } }
#pragma unroll
                for (int s = 0; s < 4; ++s) {
#pragma unroll
                    for (int mt = 0; mt < NTL; ++mt) { const s8v a = *(const LAS s8v*)(U + (16 * mt + fr) * UP + 128 * h + 32 * s + 8 * fq); Y[mt][0] = mfma16(a, q[s][0], Y[mt][0]); Y[mt][1] = mfma16(a, q[s][1], Y[mt][1]); } }
#pragma unroll
                for (int s = 0; s < 4; ++s) { q[s][0] = n[s][0]; q[s][1] = n[s][1]; } } }
        __syncthreads();
        int fr2 = fr, fq2 = fq; asm volatile("" : "+v"(fr2), "+v"(fq2));
#pragma unroll
        for (int mt = 0; mt < NTL; ++mt)
#pragma unroll
            for (int c = 0; c < 2; ++c)
#pragma unroll
                for (int r = 0; r < 4; ++r) { const unsigned w = Lp[mt][c][r >> 1]; U[(16 * mt + 4 * fq2 + r) * UP + 32 * wave + 16 * c + fr2] = (bf16_t)((r & 1) ? (w >> 16) : (w & 0xffffu)); }
        __syncthreads();
        int tid2 = tid; asm volatile("" : "+v"(tid2));
        if (tid2 < 128) { const int dir = tid2 >> 6, p = tid2 & 63; const float* lam = LAMP + (((((size_t)l * 2 + dir) * NG + g) * 17 + 16) * SP + p) * 2; const float l16r = lam[0], l16i = lam[1];
            float hre = 0.f, him = 0.f; LAS bf16_t* col = U + dir * 128 + p;
#pragma unroll 1
            for (int c0 = 0; c0 < NMC; c0 += 16) { float lr[16], li[16];
#pragma unroll
                for (int i = 0; i < 16; ++i) { const int m = s5_chain_m(dir, c0 + i); lr[i] = bf2f(col[m * UP]); li[i] = bf2f(col[m * UP + 64]); }
#pragma unroll
                for (int i = 0; i < 16; ++i) { const int m = s5_chain_m(dir, c0 + i); col[m * UP] = (bf16_t)f2bf_u(hre); col[m * UP + 64] = (bf16_t)f2bf_u(him);
                    const float nr = l16r * hre - l16i * him + lr[i], ni = l16r * him + l16i * hre + li[i]; hre = nr; him = ni; } } }
        __syncthreads();
        int fr3 = fr, fq3 = fq; asm volatile("" : "+v"(fr3), "+v"(fq3));
#pragma unroll
        for (int dir = 0; dir < 2; ++dir) { const bf16_t* mo = MOUT + ((((size_t)l * 2 + dir) * NG + g) * 256 + 32 * wave + fr3) * 128 + 8 * fq3;
            s8v bo[4][2];
#pragma unroll
            for (int s = 0; s < 4; ++s) { bo[s][0] = *(const s8v*)(mo + 32 * s); bo[s][1] = *(const s8v*)(mo + 16 * 128 + 32 * s); }
#pragma unroll
            for (int s = 0; s < 4; ++s) {
#pragma unroll
                for (int mt = 0; mt < NTL; ++mt) { const s8v a = *(const LAS s8v*)(U + (16 * mt + fr3) * UP + dir * 128 + 32 * s + 8 * fq3); Y[mt][0] = mfma16(a, bo[s][0], Y[mt][0]); Y[mt][1] = mfma16(a, bo[s][1], Y[mt][1]); } } }
        int fr4 = fr, fq4 = fq; asm volatile("" : "+v"(fr4), "+v"(fq4));
        __syncthreads();
#pragma unroll
        for (int mt = 0; mt < NTL; ++mt)
#pragma unroll
            for (int c = 0; c < 2; ++c)
#pragma unroll
                for (int r = 0; r < 4; ++r) { const float v = Y[mt][c][r], u2 = 1.5957691216057308f * (v + 0.044715f * v * v * v);
                    U[(16 * mt + 4 * fq4 + r) * UP + (2 * wave + c) * 16 + fr4] = (bf16_t)f2bf_u(v * __builtin_amdgcn_rcpf(1.0f + __expf(-u2))); }
        __syncthreads();
        int tid5 = tid; asm volatile("" : "+v"(tid5));
        for (int q = tid5 + 512 * (mt_lo * 16 * MCT * 2 / 512); q < NMC * MCT * 2; q += 512) { const int half = q & 1, tok = q >> 1, m = tok / MCT, t = tok % MCT;
            if (m >= mt_lo * 16) *(u4v*)(Zb + (size_t)s5_token(b, m, t) * SW + g * SG + 8 * half) = *(const LAS u4v*)(U + m * UP + t * 16 + 8 * half); }
        __syncthreads();
    }
}
}
namespace nv {
constexpr int MK_THREADS = 512;
constexpr int MK_LDS_BYTES = 147456;
constexpr int MK_LDS_MISC = 131072;
constexpr int MK_LDS_TAB = MK_LDS_MISC + 64;
constexpr int MK_LDS_PST = MK_LDS_TAB + 1024;

struct EpiF32N {
    static constexpr bool PERM = false, AFTER_DRAIN = false;
    float* C; int ldc; int ncol;
    __device__ __forceinline__ void operator()(const pg8::f32x4 (&acc)[2][2][4][2], const pg8::Unit& u, int wr, int wc, int fr, int fq) const {
        const int row0 = u.pm * 128 + wr * 64 + fr, col0 = (u.pn % ncol) * 256 + wc * 32 + 4 * fq;
#pragma unroll
        for (int ai = 0; ai < 2; ++ai)
#pragma unroll
            for (int m = 0; m < 4; ++m) { if (ai == 1 && u.half) continue; float* rowp = C + (size_t)(row0 + ai * 128 + m * 16) * ldc + col0;
#pragma unroll
                for (int bj = 0; bj < 2; ++bj)
#pragma unroll
                    for (int n = 0; n < 2; ++n) *(pg8::f32x4*)(rowp + bj * 128 + n * 16) = acc[ai][bj][m][n]; }
    }
};
struct MoeOrder {
    static constexpr bool DYN = false, LAZY = false;
    const LAS int* tab; int ncol, G, v, nfu, nhu, exr, nfr, nf, j, nb, p1;
    __device__ __forceinline__ void init(const LAS int* tab_, int ncol_, int G_, int c_) {
        tab = tab_; ncol = ncol_; G = G_; v = (G_ % 8 == 0) ? (c_ % 8) * (G_ / 8) + c_ / 8 : c_;
        nfr = tab_[0]; const int nhr = tab_[1]; int uf = nfr * ncol_, uh = nhr * ncol_; exr = 0;
        { const int a = uf / G_, ex = uf % G_;
          if (ex > 0) { const int keep = 2 * (a + 1) + (uh > 2 * (G_ - ex) ? (uh - 2 * (G_ - ex) + G_ - 1) / G_ : 0), dem = 2 * a + (uh + 2 * ex + G_ - 1) / G_;
              if (dem < keep && !NO_DEMOTE) { exr = ex / ncol_; uf -= ex; uh += 2 * ex; } } }
        nfu = uf; nhu = uh;
        const int r = nfu % G_; nf = nfu / G_ + (v < r ? 1 : 0);
        nb = G_ - r; j = v - r; p1 = 0;
        if (j >= 0) { const int lim = nhu < 2 * nb ? nhu : 2 * nb; p1 = (j < lim ? 1 : 0) + (j + nb < lim ? 1 : 0); }
    }
    __device__ __forceinline__ void half_unit(int hu, pg8::Unit& u) const {
        const int hr = hu / ncol, jc = hu % ncol; int en, part = 0;
        if (hr < 2 * exr) { en = tab[2 + (nfr - exr) + hr / 2]; part = hr & 1; } else en = tab[2 + nfr + (hr - 2 * exr)];
        u.pm = (en & 0xffff) + part; u.pn = ((en >> 16) & 0xff) * ncol + jc; u.half = 1;
    }
    __device__ __forceinline__ bool next(int i, pg8::Unit& u) const {
        if (i < nf) { const int fu = v + i * G; const int en = tab[2 + fu / ncol]; u.pm = en & 0xffff; u.pn = ((en >> 16) & 0xff) * ncol + fu % ncol; u.half = 0; return true; }
        int k = i - nf;
        if (k < p1) { half_unit(j + k * nb, u); return true; }
        k -= p1;
        const int hu = 2 * nb + v + k * G;
        if (nhu > 2 * nb && hu < nhu) { half_unit(hu, u); return true; }
        return false;
    }
    __device__ __forceinline__ void a_ready(const pg8::Unit&) const {}
    __device__ __forceinline__ void done(const pg8::Unit&) const {}
};
constexpr int MQ_STRIDE = 2048, MQ_CNT = 256;
struct MoeOrderSig : MoeOrder {
    static constexpr bool LAZY = true;
    unsigned* cnt; int lane;
    __device__ __forceinline__ void done(const pg8::Unit&) const {}
    __device__ __forceinline__ void done_late(int pm, int half) const {
        if (lane == 0) { (void)xb_add(&cnt[pm], 1u); if (!half) (void)xb_add(&cnt[pm + 1], 1u); }
    }
};
struct MoeDynOrder {
    static constexpr bool DYN = true, LAZY = false;
    const LAS int* tab; int ncol, nfr, nfu, ntot, lane; unsigned need; unsigned* q; unsigned* cnt; unsigned* bar; volatile LAS int* slot;
    __device__ __forceinline__ void init(const LAS int* tab_, int ncol_, unsigned* ctl, unsigned* bar_, volatile LAS int* slot_, unsigned need_, int lane_) {
        tab = tab_; ncol = ncol_; nfr = tab_[0]; nfu = nfr * ncol_; ntot = nfu + tab_[1] * ncol_; q = ctl; cnt = ctl + MQ_CNT / 4; bar = bar_; slot = slot_; need = need_; lane = lane_;
    }
    __device__ __forceinline__ void prefetch(int i, int wid) const { if (wid == 0 && lane == 0) slot[i & 1] = (int)xb_add(q, 1u); }
    __device__ __forceinline__ int take(int wid) const { int t = 0; if (wid == 0 && lane == 0) t = (int)xb_add(q, 1u); return t; }
    __device__ __forceinline__ void publish(int i, int t, int wid) const { if (wid == 0 && lane == 0) slot[i & 1] = t; }
    __device__ __forceinline__ bool next(int i, pg8::Unit& u) const {
        const int qi = __builtin_amdgcn_readfirstlane(slot[i & 1]);
        if (qi >= ntot) return false;
        if (qi < nfu) { const int en = tab[2 + qi / ncol]; u.pm = en & 0xffff; u.pn = ((en >> 16) & 0xff) * ncol + qi % ncol; u.half = 0; }
        else { const int hu = qi - nfu; const int en = tab[2 + nfr + hu / ncol]; u.pm = en & 0xffff; u.pn = ((en >> 16) & 0xff) * ncol + hu % ncol; u.half = 1; }
        return true;
    }
    __device__ __forceinline__ void a_ready(const pg8::Unit& u) const {
        XB_SPIN(xb_ld(&cnt[u.pm]) < need, bar);
        if (!u.half) XB_SPIN(xb_ld(&cnt[u.pm + 1]) < need, bar);
        asm volatile("" ::: "memory");
    }
    __device__ __forceinline__ void done(const pg8::Unit&) const {}
};
constexpr int I_IN = (DM / 64) * (INW / 32), I_GLU = (SW / 64) * (SW / 32), I_OUT = (DM / 64) * (DM / 32), I_G = (DM / 64) * (EFF / 32), I_D = (EFF / 64) * (DM / 32);
constexpr int NITEMS_L = I_IN + I_GLU + I_OUT + NE * (2 * I_G + I_D);
__device__ __forceinline__ void wcvt_item(const In& I, int l, unsigned char* ws, LAS float* scr, int it, int lane) {
    int r = it;
    if (r < I_IN) { p0_transpose_item(I.w_in + (size_t)l * DM * INW, DM, INW, (bf16*)(ws + OFF_WIN + WOFF(l)), 0, scr, r, lane); return; } r -= I_IN;
    if (r < I_GLU) { p0_transpose_item(I.s5_glu_w + (size_t)l * SW * SW, SW, SW, (bf16*)(ws + OFF_WGLU + WOFF(l)), 0, scr, r, lane); return; } r -= I_GLU;
    if (r < I_OUT) { p0_transpose_item(I.w_out + (size_t)l * DM * DM, DM, DM, (bf16*)(ws + OFF_WOUT + WOFF(l)), 0, scr, r, lane); return; } r -= I_OUT;
    const int e = r / (2 * I_G + I_D); r -= e * (2 * I_G + I_D);
    bf16* wgu = (bf16*)(ws + OFF_WGU + WOFF(l)) + (size_t)e * 2 * EFF * DM; bf16* wd = (bf16*)(ws + OFF_WD + WOFF(l)) + (size_t)e * DM * EFF;
    if (r < 2 * I_G) { const int up = r >= I_G ? 1 : 0; r -= up * I_G; const int n0 = 32 * (r % (EFF / 32));
        p0_transpose_item((up ? I.exp_w_up : I.exp_w_gate) + ((size_t)l * NE + e) * DM * EFF, DM, EFF, wgu, (n0 / 128) * 128 + up * 128, scr, r, lane); return; }
    r -= 2 * I_G;
    p0_transpose_item(I.exp_w_down + ((size_t)l * NE + e) * EFF * DM, EFF, DM, wd, 0, scr, r, lane);
}
__device__ __forceinline__ void wcvt_item_l0(const In& I, unsigned char* ws, LAS float* scr, int it, int lane) { wcvt_item(I, 0, ws, scr, it, lane); }
__device__ __forceinline__ int idle_from(int M, int N, int G) { const int nwg = (M / 256) * (N / 256), r = nwg % G; return r == 0 ? G : (2 * r <= G ? 2 * r : r); }
__device__ __forceinline__ void early_counts(int G, int& c1, int& n1, int& c2, int& n2) {
    c1 = idle_from(NTOK, INW, G); c2 = idle_from(NTOK, DM, G);
    n1 = (G - c1) * 8 * EARLY_IN; n2 = (G - c2) * 8 * EARLY_OUT;
    if (NL < 2) { n1 = 0; n2 = 0; }
    if (n1 > NITEMS_L) n1 = NITEMS_L;
    if (n1 + n2 > NITEMS_L) n2 = NITEMS_L - n1;
}
__device__ __forceinline__ void d_wcvt_range(const In& I, int l, unsigned char* ws, LAS unsigned char* lds, int lo, int hi, int w, int nw, int wave, int lane) {
    LAS float* scr = (LAS float*)(lds + wave * 16384);
    for (int it_ = lo + w; it_ < hi; it_ += nw) wcvt_item(I, l, ws, scr, it_, lane);
}
__device__ __forceinline__ void d_wcvt(const In& I, int l, unsigned char* ws, LAS unsigned char* lds, int gw, int ngw, int wave, int lane) {
    int c1, n1, c2, n2; early_counts(ngw / 8, c1, n1, c2, n2);
    d_wcvt_range(I, l, ws, lds, l == 1 ? n1 + n2 : 0, NITEMS_L, gw, ngw, wave, lane);
}

typedef const __attribute__((address_space(4))) Params* KP;
#define KPARAMS() ({ KP kp_ = (KP)__builtin_amdgcn_kernarg_segment_ptr(); asm volatile("" : "+s"(kp_)); kp_; })
#define IN_FIELDS(F) F(x) F(c) F(ctx) F(c_ctx) F(ada_w) F(ada_b) F(norm1_g) F(w_in) F(ret_decay) F(s5_a_re) F(s5_a_im) F(s5_log_step) F(s5_b_re) F(s5_b_im) \
    F(s5_c_re) F(s5_c_im) F(s5_d) F(s5_glu_w) F(s5_glu_b) F(w_out) F(norm2_g) F(router_grp_w) F(router_grp_b) F(router_exp_w) F(router_exp_b) \
    F(exp_w_gate) F(exp_w_up) F(exp_w_down) F(final_g)
__device__ __forceinline__ In load_in(KP kp) { In I;
#define F(n) I.n = kp->I.n;
    IN_FIELDS(F)
#undef F
    return I; }

__global__ void __launch_bounds__(MK_THREADS, 2) k_mega(Params p_unused) {
#ifdef HOST_EMU2
    unsigned char* lds_raw = emu::block_lds();
#else
    extern __shared__ __attribute__((aligned(16))) unsigned char lds_raw[];
#endif
    LAS unsigned char* lds = (LAS unsigned char*)lds_raw;
    const int tid0 = threadIdx.x;
    if (tid0 < 16) ((LAS unsigned*)(lds + MK_LDS_MISC))[tid0] = 0u;
    __syncthreads();
    XcdBarrier bar;
    { KP kp = KPARAMS(); bar = xcd_barrier_post((unsigned*)(kp->ws + OFF_BAR), (volatile LAS unsigned*)(lds + MK_LDS_MISC)); }
    const int bid = blockIdx.x, nblk = gridDim.x, gstride = nblk * MK_THREADS, wave0 = __builtin_amdgcn_readfirstlane(tid0 >> 6);
    const int ngw = nblk * 8;
#define BAR() do { XcdBarrier b_ = bar; asm volatile("" : "+s"(b_.x)); xcd_barrier(b_); } while (0)
#ifdef HOST_EMU2
#define LANE_ID(v) int v = threadIdx.x & 63
#else
#define LANE_ID(v) int v; asm volatile("v_mbcnt_lo_u32_b32 %0, -1, 0\n\tv_mbcnt_hi_u32_b32 %0, -1, %0" : "=v"(v))
#endif
#define PH_BEGIN { KP kp = KPARAMS(); unsigned char* ws = kp->ws; const In I = load_in(kp); (void)I; (void)ws; LANE_ID(lane); \
        const int wave = wave0, tid = wave0 * 64 + lane, gtid = bid * MK_THREADS + tid, gw = bid * 8 + wave; (void)tid; (void)gtid; (void)lane; (void)wave; (void)gw;
#define PH_END }
#define WSF(off) ((float*)(ws + (off)))
#define WSB(off) ((bf16_t*)(ws + (off)))
#define WSI(off) ((int*)(ws + (off)))
#define LTAB ((LAS int*)(lds + MK_LDS_TAB))
#define LPST ((LAS int*)(lds + MK_LDS_PST))
    PH_BEGIN { LAS float* scond = (LAS float*)lds;
        for (int i = tid; i < NCOND * DM; i += MK_THREADS) { const int j = i / DM, k = i % DM; scond[i] = silu_f(j < NB ? I.c[j * DM + k] : I.c_ctx[k]); }
        __syncthreads();
        ph_adaln_part(I, WSF(OFF_PART), scond, gw, ngw, lane);
        asm volatile("s_waitcnt vmcnt(0)" ::: "memory");
        __syncthreads();
        if (tid == 0) (void)xb_add((unsigned*)(ws + OFF_CTL) + 32, 1u); } PH_END
    PH_BEGIN if (wave < 6) { LAS float* scr = (LAS float*)(lds + wave * 16384); for (int it_ = bid * 6 + wave; it_ < NITEMS_L * PR_WCVT; it_ += nblk * 6) wcvt_item_l0(I, ws, scr, it_ % NITEMS_L, lane); }
      else { const int g2 = bid * 128 + (wave - 6) * 64 + lane, s2 = nblk * 128; ph_prep(I, WSF(OFF_RWT), g2, s2); ph_rope_table(WSF(OFF_ROPE), g2, s2); ph_s5_prep1(I, WSF(OFF_LAMP), WSF(OFF_BBC), g2, s2); } PH_END
    PH_BEGIN if (tid == 0) { unsigned* bw_ = (unsigned*)(ws + OFF_BAR); XB_SPIN(xb_ld((unsigned*)(ws + OFF_CTL) + 32) < (unsigned)nblk, bw_); }
      __syncthreads();
      ph_adaln_reduce(I, WSF(OFF_PART), WSF(OFF_MOD), gtid, gstride); PH_END
    BAR();
    PH_BEGIN ph_s5_prep2a(I, WSF(OFF_LAMP), WSF(OFF_BBC), WSF(OFF_KTAU), gtid, gstride); PH_END
    for (int l = 0; l < NL; ++l) {
        const int row_lo = (l == NL - 1) ? NCTX : 0;
        if (l > 0) BAR();
        if (l > 0) { PH_BEGIN d_wcvt(I, l, ws, lds, gw, ngw, wave, lane); PH_END }
        for (int q_ = 0; q_ < PR_BAR; ++q_) BAR();
        if (l == 0) { PH_BEGIN ph_route_prep(I, WSF(OFF_MOD), WSF(OFF_RWT), WSB(OFF_WP), WSB(OFF_WP + SZ_WP / 2), WSF(OFF_CB), gtid, gstride, gw, ngw, lane); PH_END }
        if (l == 0) { PH_BEGIN ph_norm1<0>(I, l, WSF(OFF_MOD), WSB(OFF_X), WSB(OFF_YB), WSI(OFF_TS), WSF(OFF_TG), WSB(OFF_HB), nullptr, gw, ngw, lane); PH_END }
        else        { PH_BEGIN ph_norm1<1>(I, l, WSF(OFF_MOD), WSB(OFF_X), WSB(OFF_YB), WSI(OFF_TS), WSF(OFF_TG), WSB(OFF_HB), nullptr, gw, ngw, lane); PH_END }
        BAR();
        PH_BEGIN pg8::Gemm g{WSB(OFF_HB), WSB(OFF_WIN + WOFF(l)), NTOK, INW, DM}; pg8::StaticOrder S; S.init(NTOK, INW, nblk, bid); EpiQKV E{WSB(OFF_QKVB), WSF(OFF_ROPE)};
          pg8::gemm_phase<EpiQKV, pg8::StaticOrder, true, true>(lds, g, S, E, tid); PH_END
        if (l == 0 && NL > 1) { PH_BEGIN int c1, n1, c2, n2; early_counts(nblk, c1, n1, c2, n2);
            if (bid >= c1) d_wcvt_range(I, 1, ws, lds, 0, n1, (bid - c1) * 8 + wave, (nblk - c1) * 8, wave, lane); PH_END }
        BAR();
        PH_BEGIN ph_ret_kv(I, l, WSB(OFF_QKVB), WSB(OFF_KVT), lds, bid, nblk, tid, lane, wave); PH_END
        if (l == 0) { PH_BEGIN const int nu = NB * NH * NCH, f = nu % nblk == 0 ? 0 : nu % nblk;
            if (bid >= f) { ph_s5_prep2b(I, WSF(OFF_LAMP), WSF(OFF_BBC), WSB(OFF_MINT), WSB(OFF_MOUT), (bid - f) * MK_THREADS + tid, (nblk - f) * MK_THREADS);
                ph_s5_prep3(I, WSF(OFF_KTAU), WSB(OFF_KTOT), (bid - f) * MK_THREADS + tid, (nblk - f) * MK_THREADS); } PH_END }
        BAR();
        PH_BEGIN ph_ret_scan(I, l, WSB(OFF_KVT), WSB(OFF_STT), gtid, gstride); PH_END
        PH_BEGIN ph_s5(l, WSB(OFF_QKVB), WSF(OFF_LAMP), WSB(OFF_MINT), WSB(OFF_MOUT), WSB(OFF_KTOT), WSB(OFF_ZB), lds, (l == NL - 1) ? CTL : 0, bid, nblk, tid, lane, wave); PH_END
        BAR();
        PH_BEGIN pg8::Gemm g{WSB(OFF_ZB), WSB(OFF_WGLU + WOFF(l)), NTOK, SW, SW}; pg8::StaticOrder S; S.init(NTOK, SW, nblk, bid);
          EpiGlu E{WSB(OFF_MIXB), DM, RW, WSB(OFF_ZB), SW, I.s5_glu_b + (size_t)l * SW};
          pg8::gemm_phase<EpiGlu, pg8::StaticOrder, true, true>(lds, g, S, E, tid); PH_END
        PH_BEGIN ph_ret_out(I, l, WSB(OFF_QKVB), WSB(OFF_STT), WSB(OFF_MIXB), lds, (l == NL - 1) ? CC : 0, bid, nblk, tid, lane, wave,
                            (unsigned*)(ws + OFF_CTL + (size_t)l * MQ_STRIDE) + 16, (volatile LAS int*)(lds + MK_LDS_MISC) + 10); PH_END
        BAR();
        PH_BEGIN const int rbase = (l == NL - 1) ? NCTX : 0;
          pg8::Gemm g{WSB(OFF_MIXB) + (size_t)rbase * DM, WSB(OFF_WOUT + WOFF(l)), NTOK - rbase, DM, DM}; pg8::StaticOrder S; S.init(NTOK - rbase, DM, nblk, bid); if (l > 0) S.rep = 1;
          EpiResid E{WSB(OFF_X), I.ctx, I.x, l == 0 ? (const bf16_t*)nullptr : WSB(OFF_X), WSF(OFF_MOD), l, rbase};
          pg8::gemm_phase<EpiResid, pg8::StaticOrder, true, true>(lds, g, S, E, tid); PH_END
        if (l == 0 && NL > 1) { PH_BEGIN int c1, n1, c2, n2; early_counts(nblk, c1, n1, c2, n2);
            if (bid >= c2) d_wcvt_range(I, 1, ws, lds, n1, n1 + n2, (bid - c2) * 8 + wave, (nblk - c2) * 8, wave, lane); PH_END }
        BAR();
        PH_BEGIN ph_route(I, l, WSB(OFF_X), WSB(OFF_WP), WSB(OFF_WP + SZ_WP / 2), WSF(OFF_CB), WSI(OFF_TE), WSF(OFF_TG), WSF(OFF_RSTD), WSI(OFF_TP), WSI(OFF_HIST), lds, row_lo, bid, nblk, tid, lane, wave); PH_END
        BAR();
        PH_BEGIN ph_gather(I, l, WSF(OFF_MOD), WSB(OFF_X), WSF(OFF_RSTD), WSI(OFF_TE), WSI(OFF_TP), WSI(OFF_HIST), WSI(OFF_TS), WSB(OFF_XG), lds, LTAB, LPST, row_lo, bid, nblk, tid, lane, wave); PH_END
        BAR();
#ifdef GU_PLAIN
        PH_BEGIN pg8::Gemm g{WSB(OFF_XG), WSB(OFF_WGU + WOFF(l)), 0, 0, DM}; MoeOrder S; S.init(LTAB, (2 * EFF) / 256, nblk, bid); EpiAct E{WSB(OFF_ACTB), EFF, (2 * EFF) / 256};
          pg8::gemm_phase<EpiAct, MoeOrder, true, true>(lds, g, S, E, tid); PH_END
#else
        PH_BEGIN pg8::Gemm g{WSB(OFF_XG), WSB(OFF_WGU + WOFF(l)), 0, 0, DM}; MoeOrderSig S; S.init(LTAB, (2 * EFF) / 256, nblk, bid); S.cnt = (unsigned*)(ws + OFF_CTL + (size_t)l * MQ_STRIDE + MQ_CNT); S.lane = lane;
          EpiActSc E{{WSB(OFF_ACTB), EFF, (2 * EFF) / 256}};
          pg8::gemm_phase<EpiActSc, MoeOrderSig, true, true>(lds, g, S, E, tid); PH_END
#endif
#ifdef KEEP_BAR
        BAR();
#endif
#ifdef D_STATIC
        PH_BEGIN pg8::Gemm g{WSB(OFF_ACTB), WSB(OFF_WD + WOFF(l)), 0, 0, EFF}; MoeOrder S; S.init(LTAB, DM / 256, nblk, bid); EpiBf16N E{WSB(OFF_YB), DM, DM / 256};
          pg8::gemm_phase<EpiBf16N, MoeOrder, true, true>(lds, g, S, E, tid); PH_END
#else
        PH_BEGIN pg8::Gemm g{WSB(OFF_ACTB), WSB(OFF_WD + WOFF(l)), 0, 0, EFF}; MoeDynOrder S;
          S.init(LTAB, DM / 256, (unsigned*)(ws + OFF_CTL + (size_t)l * MQ_STRIDE), (unsigned*)(ws + OFF_BAR), (volatile LAS int*)(lds + MK_LDS_MISC) + 8, 8u * ((2 * EFF) / 256), lane);
          EpiBf16N E{WSB(OFF_YB), DM, DM / 256};
          pg8::gemm_phase<EpiBf16N, MoeDynOrder, true, true, AUX_D>(lds, g, S, E, tid); PH_END
#endif
    }
    BAR();
    PH_BEGIN ph_norm1<2>(I, NL, WSF(OFF_MOD), WSB(OFF_X), WSB(OFF_YB), WSI(OFF_TS), WSF(OFF_TG), nullptr, kp->out, gw, ngw, lane); PH_END
#undef BAR
}
}
#endif

static nv::Params make_params(void* const* d_in, void* d_out, void* d_ws) {
    nv::Params p{};
    const float** f = (const float**)&p.I;
    for (int i = 0; i < 29; ++i) f[i] = (const float*)d_in[i];
    p.out = (float*)d_out; p.ws = (unsigned char*)d_ws;
    return p;
}

extern "C" void kernel_launch(void* const* d_in, const int* in_sizes, int n_in, void* d_out, int out_size, void* d_ws, size_t ws_size, hipStream_t stream) {
    using namespace nv;
    (void)in_sizes; (void)out_size;
    Params p = make_params(d_in, d_out, d_ws);
#if defined(HOST_EMU2)
    (void)n_in; (void)ws_size; (void)stream;
    memset((char*)d_ws + OFF_CTL, 0, SZ_CTL + SZ_BAR);
    static Params pk; pk = p; emu_kernarg = &pk;
    emu::run_grid([]() { k_mega(pk); }, EMU_GRID, MK_THREADS, MK_LDS_BYTES);
#elif !defined(HOST_EMU)
    static int grid = 0;
    if (grid == 0) {
        if (n_in != 29 || ws_size < WS_NEED) { fprintf(stderr, "kernel_launch: n_in %d ws %zu need %zu\n", n_in, ws_size, (size_t)WS_NEED); grid = -1; return; }
        int dev = 0, cus = 0, per_cu = 0;
        if (hipGetDevice(&dev) != hipSuccess || hipDeviceGetAttribute(&cus, hipDeviceAttributeMultiprocessorCount, dev) != hipSuccess) { grid = -1; return; }
        if (hipFuncSetAttribute((const void*)k_mega, hipFuncAttributeMaxDynamicSharedMemorySize, MK_LDS_BYTES) != hipSuccess) { fprintf(stderr, "kernel_launch: hipFuncSetAttribute failed\n"); grid = -1; return; }
        if (hipOccupancyMaxActiveBlocksPerMultiprocessor(&per_cu, (const void*)k_mega, MK_THREADS, MK_LDS_BYTES) != hipSuccess || per_cu < 1) { fprintf(stderr, "kernel_launch: occupancy query says %d\n", per_cu); grid = -1; (void)hipGetLastError(); return; }
        (void)hipGetLastError();
        grid = cus;
    }
    if (grid < 0) return;
    (void)hipMemsetAsync((char*)d_ws + OFF_CTL, 0, SZ_CTL + SZ_BAR, stream);
    hipLaunchKernelGGL(k_mega, dim3(grid), dim3(MK_THREADS), MK_LDS_BYTES, stream, p);
#endif
}
```
